# Optimizing an MI355X kernel written in HIP

```python
import jax, jax.numpy as jnp
from jax import lax
import numpy as np

D_MODEL = 1024
BATCH = 8
SEQ = 2048
DEPTH = 1
DEC_BATCH = 128
DEC_SEQ = 8
PAST_LEN = 16384
PAGE_SIZE = 128

CONV_W = 4
LRU_WIDTH = D_MODEL
LRU_BLOCKS = 8
LRU_BLOCK = LRU_WIDTH // LRU_BLOCKS
LRU_C = 8.0
GDN_HEADS = 8
GDN_DK = 128
GDN_DV = 128
GDN_KEY_W = GDN_HEADS * GDN_DK
GDN_VAL_W = GDN_HEADS * GDN_DV
GDN_QKV_W = 2 * GDN_KEY_W + GDN_VAL_W
GDN_CHUNK = 64
NORM_EPS = 1e-6
IN_SPLITS = (LRU_WIDTH, LRU_WIDTH, GDN_QKV_W, GDN_VAL_W, GDN_HEADS, GDN_HEADS, D_MODEL, D_MODEL)
IN_WIDTH = sum(IN_SPLITS)

kernel_name = "hawk_gdn_parallel_gated_decoder_step"


def rms_norm(x, gain):
    x32 = x.astype(jnp.float32)
    y = x32 * lax.rsqrt(jnp.mean(x32 * x32, axis=-1, keepdims=True) + NORM_EPS)
    return (y * gain.astype(jnp.float32)).astype(x.dtype)


def l2_normalize(x):
    return x * lax.rsqrt(jnp.sum(x * x, axis=-1, keepdims=True) + NORM_EPS)


def causal_depthwise_conv(x, buf, w):
    T = x.shape[1]
    xp = jnp.concatenate([buf.astype(x.dtype), x], axis=1)
    y = sum(xp[:, i:i + T] * w[i].astype(x.dtype) for i in range(CONV_W))
    return y, xp[:, xp.shape[1] - (CONV_W - 1):]


def rg_lru(xc, h0, reset, wa, ba, wx, bx, a_logit):
    B, T, _ = xc.shape
    x32 = xc.astype(jnp.float32)
    xb = x32.reshape(B, T, LRU_BLOCKS, LRU_BLOCK)
    r = jax.nn.sigmoid(jnp.einsum('btgi,gij->btgj', xb, wa.astype(jnp.float32)).reshape(B, T, LRU_WIDTH) + ba.astype(jnp.float32))
    ig = jax.nn.sigmoid(jnp.einsum('btgi,gij->btgj', xb, wx.astype(jnp.float32)).reshape(B, T, LRU_WIDTH) + bx.astype(jnp.float32))
    log_a = LRU_C * r * jax.nn.log_sigmoid(a_logit.astype(jnp.float32))
    rs = reset[None, :, None]
    a = jnp.where(rs, 0.0, jnp.exp(log_a))
    mult = jnp.where(rs, 1.0, jnp.sqrt(-jnp.expm1(2.0 * log_a)))
    b = mult * ig * x32
    b = b.at[:, 0].add(a[:, 0] * h0)

    def combine(left, right):
        al, bl = left
        ar, br = right
        return al * ar, ar * bl + br

    _, h = lax.associative_scan(combine, (a, b), axis=1)
    return h, h[:, -1]


def gated_delta_rule_chunked(q, k, v, g, beta, S0):
    B, T, H, DK = q.shape
    DV = v.shape[-1]
    C = min(GDN_CHUNK, T)
    n = -(-T // C)
    pad = n * C - T
    if pad:
        def padf(a):
            return jnp.pad(a, [(0, 0), (0, pad)] + [(0, 0)] * (a.ndim - 2))
        q, k, v, g, beta = padf(q), padf(k), padf(v), padf(g), padf(beta)

    def chunks(a):
        a = a.reshape((B, n, C, H) + a.shape[3:])
        return jnp.moveaxis(a, (1, 3), (0, 2))

    qc, kc, vc, bc = chunks(q), chunks(k), chunks(v), chunks(beta)
    gc = jnp.cumsum(chunks(g), axis=-1)
    idx = jnp.arange(C)
    causal = idx[:, None] >= idx[None, :]
    strict = idx[:, None] > idx[None, :]
    diff = gc[..., :, None] - gc[..., None, :]
    decay = jnp.where(causal, jnp.exp(jnp.where(causal, diff, 0.0)), 0.0)
    kb = kc * bc[..., None]
    M = jnp.where(strict, jnp.einsum('nbhik,nbhjk->nbhij', kb, kc) * decay, 0.0)
    P = -M
    Tinv = jnp.broadcast_to(jnp.eye(C, dtype=M.dtype), M.shape)
    for _ in range((C - 1).bit_length()):
        Tinv = Tinv + jnp.einsum('nbhij,nbhjk->nbhik', Tinv, P)
        P = jnp.einsum('nbhij,nbhjk->nbhik', P, P)
    u = jnp.einsum('nbhij,nbhjv->nbhiv', Tinv, vc * bc[..., None])
    w = jnp.einsum('nbhij,nbhjk->nbhik', Tinv, kb * jnp.exp(gc)[..., None])
    a_qk = jnp.where(causal, jnp.einsum('nbhik,nbhjk->nbhij', qc, kc) * decay, 0.0)
    q_dec = qc * jnp.exp(gc)[..., None]
    g_last = gc[..., -1]
    k_dec = kc * jnp.exp(g_last[..., None] - gc)[..., None]

    def step(S, xs):
        q_i, k_i, u_i, w_i, a_i, gl_i = xs
        v_new = u_i - jnp.einsum('bhck,bhkv->bhcv', w_i, S)
        o_i = jnp.einsum('bhck,bhkv->bhcv', q_i, S) + jnp.einsum('bhij,bhjv->bhiv', a_i, v_new)
        S = S * jnp.exp(gl_i)[..., None, None] + jnp.einsum('bhck,bhcv->bhkv', k_i, v_new)
        return S, o_i

    S_final, o = lax.scan(step, S0, (q_dec, k_dec, u, w, a_qk, g_last))
    o = jnp.moveaxis(o, (0, 2), (1, 3)).reshape(B, n * C, H, DV)[:, :T]
    return o, S_final


def hybrid_layer(x, lru_conv_buf, lru_h0, gdn_conv_buf, gdn_S0, start_pos,
                 norm_pre, norm_post, w_in, lru_conv_w, lru_conv_b, lru_wa, lru_ba, lru_wx, lru_bx,
                 lru_a_logit, gdn_conv_w, gdn_A_log, gdn_dt_bias, gdn_norm_w, w_br_lru, w_br_gdn, w_out):
    B, T, _ = x.shape
    u = rms_norm(x, norm_pre)
    z = jnp.einsum('btd,de->bte', u, w_in)
    offsets = np.cumsum(IN_SPLITS)[:-1].tolist()
    lru_x, lru_gate, gdn_qkv, gdn_gate, gdn_b, gdn_a, m_lru, m_gdn = jnp.split(z, offsets, axis=-1)

    lru_xc, lru_conv_new = causal_depthwise_conv(lru_x, lru_conv_buf, lru_conv_w)
    lru_xc = lru_xc + lru_conv_b.astype(x.dtype)
    reset = (jnp.arange(T) + start_pos) == 0
    h, lru_h_new = rg_lru(lru_xc, lru_h0.astype(jnp.float32), reset, lru_wa, lru_ba, lru_wx, lru_bx, lru_a_logit)
    lru_out = h.astype(x.dtype) * jax.nn.silu(lru_gate)

    qkv, gdn_conv_new = causal_depthwise_conv(gdn_qkv, gdn_conv_buf, gdn_conv_w)
    qkv = jax.nn.silu(qkv).astype(jnp.float32)
    q, k, v = jnp.split(qkv, [GDN_KEY_W, 2 * GDN_KEY_W], axis=-1)
    q = l2_normalize(q.reshape(B, T, GDN_HEADS, GDN_DK)) * (GDN_DK ** -0.5)
    k = l2_normalize(k.reshape(B, T, GDN_HEADS, GDN_DK))
    v = v.reshape(B, T, GDN_HEADS, GDN_DV)
    beta = jax.nn.sigmoid(gdn_b.astype(jnp.float32))
    g = -jnp.exp(gdn_A_log.astype(jnp.float32)) * jax.nn.softplus(gdn_a.astype(jnp.float32) + gdn_dt_bias.astype(jnp.float32))
    o, S_new = gated_delta_rule_chunked(q, k, v, g, beta, gdn_S0.astype(jnp.float32))
    o = o * lax.rsqrt(jnp.mean(o * o, axis=-1, keepdims=True) + NORM_EPS) * gdn_norm_w.astype(jnp.float32)
    o = o * jax.nn.silu(gdn_gate.astype(jnp.float32).reshape(B, T, GDN_HEADS, GDN_DV))
    gdn_out = o.reshape(B, T, GDN_VAL_W).astype(x.dtype)

    p_lru = jnp.einsum('bte,ed->btd', lru_out, w_br_lru)
    p_gdn = jnp.einsum('bte,ed->btd', gdn_out, w_br_gdn)
    merged = jax.nn.sigmoid(m_lru) * p_lru + jax.nn.sigmoid(m_gdn) * p_gdn
    y = jnp.einsum('btd,de->bte', merged, w_out)
    x_new = x + rms_norm(y, norm_post)
    return x_new, lru_conv_new, lru_h_new, gdn_conv_new, S_new


def setup_inputs(seed: int = 0) -> dict:
    key = jax.random.key(seed)
    ks = jax.random.split(key, 24)
    f32 = jnp.float32
    nrm = lambda k, shape, s: jax.random.normal(k, shape, f32) * s
    a_u = jax.random.uniform(ks[14], (DEPTH, LRU_WIDTH), f32, 0.9, 0.999)
    dt = jnp.exp(jax.random.uniform(ks[17], (DEPTH, GDN_HEADS), f32, np.log(0.001), np.log(0.1)))
    return {
        "x_prompt": nrm(ks[0], (BATCH, SEQ, D_MODEL), 1.0),
        "x_sample": nrm(ks[1], (DEC_BATCH, DEC_SEQ, D_MODEL), 1.0),
        "state_lru_conv": nrm(ks[2], (DEPTH, DEC_BATCH, CONV_W - 1, LRU_WIDTH), 1.0),
        "state_lru_h": nrm(ks[3], (DEPTH, DEC_BATCH, LRU_WIDTH), 0.5),
        "state_gdn_conv": nrm(ks[4], (DEPTH, DEC_BATCH, CONV_W - 1, GDN_QKV_W), 1.0),
        "state_gdn_S": nrm(ks[5], (DEPTH, DEC_BATCH, GDN_HEADS, GDN_DK, GDN_DV), 0.1),
        "norm_pre": 1.0 + nrm(ks[6], (DEPTH, D_MODEL), 0.05),
        "norm_post": 1.0 + nrm(ks[7], (DEPTH, D_MODEL), 0.05),
        "w_in": nrm(ks[8], (DEPTH, D_MODEL, IN_WIDTH), D_MODEL ** -0.5),
        "lru_conv_w": nrm(ks[9], (DEPTH, CONV_W, LRU_WIDTH), CONV_W ** -0.5),
        "lru_conv_b": nrm(ks[10], (DEPTH, LRU_WIDTH), 0.02),
        "lru_wa": nrm(ks[11], (DEPTH, LRU_BLOCKS, LRU_BLOCK, LRU_BLOCK), LRU_BLOCK ** -0.5),
        "lru_ba": nrm(ks[12], (DEPTH, LRU_WIDTH), 0.02),
        "lru_wx": nrm(ks[13], (DEPTH, LRU_BLOCKS, LRU_BLOCK, LRU_BLOCK), LRU_BLOCK ** -0.5),
        "lru_bx": nrm(ks[15], (DEPTH, LRU_WIDTH), 0.02),
        "lru_a_logit": jnp.log(a_u) - jnp.log1p(-a_u),
        "gdn_conv_w": nrm(ks[16], (DEPTH, CONV_W, GDN_QKV_W), CONV_W ** -0.5),
        "gdn_A_log": jnp.log(jax.random.uniform(ks[18], (DEPTH, GDN_HEADS), f32, 1.0, 16.0)),
        "gdn_dt_bias": dt + jnp.log(-jnp.expm1(-dt)),
        "gdn_norm_w": 1.0 + nrm(ks[19], (DEPTH, GDN_DV), 0.05),
        "w_br_lru": nrm(ks[20], (DEPTH, LRU_WIDTH, D_MODEL), LRU_WIDTH ** -0.5),
        "w_br_gdn": nrm(ks[21], (DEPTH, GDN_VAL_W, D_MODEL), GDN_VAL_W ** -0.5),
        "w_out": nrm(ks[22], (DEPTH, D_MODEL, D_MODEL), D_MODEL ** -0.5),
    }


def reference(x_prompt, x_sample, state_lru_conv, state_lru_h, state_gdn_conv, state_gdn_S,
              norm_pre, norm_post, w_in, lru_conv_w, lru_conv_b, lru_wa, lru_ba, lru_wx, lru_bx,
              lru_a_logit, gdn_conv_w, gdn_A_log, gdn_dt_bias, gdn_norm_w, w_br_lru, w_br_gdn, w_out):
    yp, ys = x_prompt, x_sample
    B = x_prompt.shape[0]
    p_lc, p_lh, p_gc, p_gs = [], [], [], []
    s_lc, s_lh, s_gc, s_gs = [], [], [], []
    for l in range(DEPTH):
        w_l = (norm_pre[l], norm_post[l], w_in[l], lru_conv_w[l], lru_conv_b[l], lru_wa[l], lru_ba[l],
               lru_wx[l], lru_bx[l], lru_a_logit[l], gdn_conv_w[l], gdn_A_log[l], gdn_dt_bias[l],
               gdn_norm_w[l], w_br_lru[l], w_br_gdn[l], w_out[l])
        yp, lc, lh, gc, gs = hybrid_layer(
            yp,
            jnp.zeros((B, CONV_W - 1, LRU_WIDTH), x_prompt.dtype),
            jnp.zeros((B, LRU_WIDTH), jnp.float32),
            jnp.zeros((B, CONV_W - 1, GDN_QKV_W), x_prompt.dtype),
            jnp.zeros((B, GDN_HEADS, GDN_DK, GDN_DV), jnp.float32),
            0, *w_l)
        p_lc.append(lc.astype(state_lru_conv.dtype))
        p_lh.append(lh.astype(state_lru_h.dtype))
        p_gc.append(gc.astype(state_gdn_conv.dtype))
        p_gs.append(gs.astype(state_gdn_S.dtype))
        ys, lc, lh, gc, gs = hybrid_layer(
            ys, state_lru_conv[l], state_lru_h[l], state_gdn_conv[l], state_gdn_S[l], PAST_LEN, *w_l)
        s_lc.append(lc.astype(state_lru_conv.dtype))
        s_lh.append(lh.astype(state_lru_h.dtype))
        s_gc.append(gc.astype(state_gdn_conv.dtype))
        s_gs.append(gs.astype(state_gdn_S.dtype))
    return (yp, ys,
            jnp.stack(p_lc), jnp.stack(p_lh), jnp.stack(p_gc), jnp.stack(p_gs),
            jnp.stack(s_lc), jnp.stack(s_lh), jnp.stack(s_gc), jnp.stack(s_gs))
```

```cpp
#include <hip/hip_runtime.h>
#include <hip/hip_cooperative_groups.h>
#include <cstdio>
#include <cstdint>
namespace cg = cooperative_groups;

#define LAS __attribute__((address_space(3)))
typedef unsigned short bf16_t;
typedef short bf16x8 __attribute__((ext_vector_type(8)));
typedef short s16x4 __attribute__((ext_vector_type(4)));
typedef float f32x4 __attribute__((ext_vector_type(4)));
typedef unsigned u32x4 __attribute__((ext_vector_type(4)));
typedef unsigned u32x2 __attribute__((ext_vector_type(2)));

constexpr int DM = 1024, NROWS = 17408, NPROMPT = 16384, SEQ = 2048;
constexpr int ZW = 4096;
constexpr float EPS = 1e-6f;
constexpr size_t O_Y = 0, O_PLC = 17825792, O_PLH = 17850368, O_PGC = 17858560, O_PGS = 17932288,
                 O_SLC = 18980864, O_SLH = 19374080, O_SGC = 19505152, O_SGS = 20684800;
constexpr size_t MiB = 1u << 20;
constexpr size_t WS_W1T = 0, WS_W2T = 8 * MiB, WS_WBL = 16 * MiB, WS_WBG = 18 * MiB, WS_WO = 20 * MiB, WS_WA = 22 * MiB, WS_WX = 22 * MiB + 262144,
                 WS_BG = 23 * MiB, WS_GC = 25 * MiB, WS_HALO = 26 * MiB, WS_TINV = 31 * MiB, WS_AQK = 48 * MiB, WS_U = 65 * MiB, WS_Z1 = 99 * MiB, WS_BAR = 235 * MiB, WS_END = 236 * MiB;
constexpr int LDS_BYTES = 147456;

struct Args { const float* in[23]; float* out; unsigned char* ws; int ph_lo, ph_hi, flags, pad; };

typedef float f32x2_t __attribute__((ext_vector_type(2)));
typedef __bf16 bf16x2_t __attribute__((ext_vector_type(2)));
__device__ __forceinline__ unsigned cvt_pk_bf16(float lo, float hi) { f32x2_t v = {lo, hi}; bf16x2_t b = __builtin_convertvector(v, bf16x2_t); return __builtin_bit_cast(unsigned, b); }
__device__ __forceinline__ unsigned cvt_pk_bf16_asm(float lo, float hi) { unsigned r; asm volatile("v_cvt_pk_bf16_f32 %0, %1, %2" : "=v"(r) : "v"(lo), "v"(hi)); return r; }
__device__ __forceinline__ float bflo(unsigned w) { return __uint_as_float(w << 16); }
__device__ __forceinline__ float bfhi(unsigned w) { return __uint_as_float(w & 0xffff0000u); }
__device__ __forceinline__ float bf1(bf16_t b) { return __uint_as_float((unsigned)b << 16); }
__device__ __forceinline__ bf16_t f2bf(float f) { return (bf16_t)(cvt_pk_bf16(f, 0.f) & 0xffffu); }
__device__ __forceinline__ float sigmoidf_(float x) { return __builtin_amdgcn_rcpf(1.f + __expf(-x)); }
__device__ __forceinline__ float siluf_(float x) { return x * sigmoidf_(x); }
template <int CTRL> __device__ __forceinline__ float dpp_mov(float v) { return __int_as_float(__builtin_amdgcn_update_dpp(0, __float_as_int(v), CTRL, 0xF, 0xF, true)); }
__device__ __forceinline__ float row16_sum(float v) { v += dpp_mov<0xB1>(v); v += dpp_mov<0x4E>(v); v += dpp_mov<0x141>(v); v += dpp_mov<0x140>(v); return v; }
__device__ __forceinline__ float wave_sum(float v) {
    v = row16_sum(v);
    v += __shfl_xor(v, 16); v += __shfl_xor(v, 32);
    return v;
}
__device__ __forceinline__ void unpack8(const u32x4 w, float* f) {
    f[0] = bflo(w.x); f[1] = bfhi(w.x); f[2] = bflo(w.y); f[3] = bfhi(w.y); f[4] = bflo(w.z); f[5] = bfhi(w.z); f[6] = bflo(w.w); f[7] = bfhi(w.w);
}
__device__ __forceinline__ u32x4 pack8(const float* f) {
    u32x4 w; w.x = cvt_pk_bf16(f[0], f[1]); w.y = cvt_pk_bf16(f[2], f[3]); w.z = cvt_pk_bf16(f[4], f[5]); w.w = cvt_pk_bf16(f[6], f[7]); return w;
}
__device__ __forceinline__ bf16x8 pack_frag(const f32x4 a, const f32x4 b) {
    u32x4 w; w.x = cvt_pk_bf16(a[0], a[1]); w.y = cvt_pk_bf16(a[2], a[3]); w.z = cvt_pk_bf16(b[0], b[1]); w.w = cvt_pk_bf16(b[2], b[3]);
    return __builtin_bit_cast(bf16x8, w);
}
__device__ __forceinline__ bf16x8 lda_perm(const LAS bf16_t* rowp, int s, int fq, bool second) {
    if (second) return *(const LAS bf16x8*)(rowp + 32 * s + 8 * fq);
    const u32x2 lo = *(const LAS u32x2*)(rowp + 32 * s + 8 * fq);
    u32x4 w; w.x = lo.x; w.y = lo.y; w.z = 0u; w.w = 0u; return __builtin_bit_cast(bf16x8, w);
}
__device__ __forceinline__ void st_perm(LAS bf16_t* rowp, int ch, const u32x4 v) {
    const int c4 = ch & 3, f = 32 * (ch >> 2) + (c4 & 1) * 16 + (c4 >> 1) * 4;
    *(LAS u32x2*)(rowp + f) = (u32x2){v.x, v.y};
    *(LAS u32x2*)(rowp + f + 8) = (u32x2){v.z, v.w};
}
__device__ __forceinline__ s16x4 lds_tr(const LAS bf16_t* p) { return __builtin_bit_cast(s16x4, __builtin_amdgcn_ds_read_tr16_b64_v4i16((LAS s16x4*)p)); }

namespace pg8 {
constexpr int BM = 256, BK = 64, HALF = 128, HTB = HALF * BK * 2, STAGE_BYTES = 8 * HTB, NXCD = 8, WGM = 8;
__host__ __device__ __forceinline__ int lds_byte(int r, int c) { const int st = (r >> 4) * 2 + (c >> 5), rr = r & 15, cc = c & 31, ob = rr * 64 + cc * 2; return st * 1024 + (ob ^ (((ob >> 9) & 1) << 5)); }
__host__ __device__ __forceinline__ void stage_rc(int b, int& R, int& C) { const int st = b / 1024, sb = b % 1024, swz = sb ^ (((sb >> 9) & 1) << 5); R = (st >> 1) * 16 + swz / 64; C = (st & 1) * 32 + (swz % 64) / 2; }
__host__ __device__ __forceinline__ int perm32(int rho) { const int n = rho >> 4, i = rho & 15; return 8 * (i >> 2) + 4 * n + (i & 3); }
struct Unit { int pm, pn; };
struct Gemm { const bf16_t* A; const bf16_t* Bt; int M, N, K, lda; };
struct StaticOrder {
    int nM, nN, nwg, G, c;
    __device__ void init(int M, int N, int G_, int c_) { nM = M / BM; nN = N / BM; nwg = nM * nN; G = G_; c = c_; }
    __device__ bool next(int i, Unit& u) const {
        const long L = (long)i * G + c; if (L >= nwg) return false;
        int wgid = (int)L; { const int q = nwg / NXCD, r = nwg % NXCD, xcd = wgid % NXCD, off = wgid / NXCD; wgid = (xcd < r ? xcd * (q + 1) : r * (q + 1) + (xcd - r) * q) + off; }
        const int nig = WGM * nN, gid = wgid / nig, fm = gid * WGM, gsz = (nM - fm) < WGM ? (nM - fm) : WGM;
        u.pm = fm + ((wgid % nig) % gsz); u.pn = (wgid % nig) / gsz; return true;
    }
};
template <int MODE> struct Epi {
    static constexpr bool PERM = true;
    bf16_t* Z1; bf16_t* HALO; float* out;
    __device__ __forceinline__ void operator()(const f32x4 (&acc)[2][2][4][2], const Unit& u, int wr, int wc, int fr, int fq) const {
        const int col0 = u.pn * BM + wc * 32 + 8 * fq;
        if constexpr (MODE == 0 || MODE == 4 || MODE == 5) {
#pragma unroll
        for (int ai = 0; ai < 2; ++ai)
#pragma unroll
            for (int m = 0; m < 4; ++m) {
                const int row = u.pm * BM + ai * HALF + wr * 64 + m * 16 + fr;
                if constexpr (MODE == 0) {
                    bf16_t* rowp = Z1 + (size_t)row * ZW + col0;
                    const bool is_halo = (m == 3) && (fr >= 13) && (row < NPROMPT) && (u.pn >= 4);
                    int cs = -1; float* bl = nullptr; float* bg = nullptr;
                    if (row < NPROMPT) { const int t = row & (SEQ - 1); if (t >= SEQ - 3) { cs = t - (SEQ - 3); const int b = row >> 11; bl = out + O_PLC + (size_t)(b * 3 + cs) * 1024; bg = out + O_PGC + (size_t)(b * 3 + cs) * 3072; } }
                    else { const int t = row & 7; if (t >= 5) { cs = t - 5; const int s = (row - NPROMPT) >> 3; bl = out + O_SLC + (size_t)(s * 3 + cs) * 1024; bg = out + O_SGC + (size_t)(s * 3 + cs) * 3072; } }
#pragma unroll
                    for (int bj = 0; bj < 2; ++bj) {
                        const f32x4 v0 = acc[ai][bj][m][0], v1 = acc[ai][bj][m][1];
                        u32x4 w; w.x = cvt_pk_bf16(v0[0], v0[1]); w.y = cvt_pk_bf16(v0[2], v0[3]); w.z = cvt_pk_bf16(v1[0], v1[1]); w.w = cvt_pk_bf16(v1[2], v1[3]);
                        *(u32x4*)(rowp + bj * HALF) = w;
                        const int col = col0 + bj * HALF;
                        if (is_halo) *(u32x4*)(HALO + (size_t)((row >> 6) * 3 + (fr - 13)) * 3072 + (col - 1024)) = w;
                        if (cs >= 0) { float* d = (u.pn < 4) ? bl + col : bg + (col - 1024); *(f32x4*)d = v0; *(f32x4*)(d + 4) = v1; }
                    }
                } else if constexpr (MODE == 5) {
                    bf16_t* pp = (bf16_t*)out + (size_t)row * 2048 + col0;
#pragma unroll
                    for (int bj = 0; bj < 2; ++bj) {
                        const f32x4 v0 = acc[ai][bj][m][0], v1 = acc[ai][bj][m][1];
                        float o[8] = {v0[0], v0[1], v0[2], v0[3], v1[0], v1[1], v1[2], v1[3]};
#pragma unroll
                        for (int e = 0; e < 8; ++e) o[e] = sigmoidf_(o[e]);
                        *(u32x4*)(pp + bj * HALF) = pack8(o);
                    }
                } else {
                    float* rowp = out + (size_t)row * DM + col0;
#pragma unroll
                    for (int bj = 0; bj < 2; ++bj) { *(f32x4*)(rowp + bj * HALF) = acc[ai][bj][m][0]; *(f32x4*)(rowp + bj * HALF + 4) = acc[ai][bj][m][1]; }
                }
            }
        } else {
            const int cbase = (MODE == 1) ? col0 : 2048 + col0;
            const bool gate = (MODE == 1);
#pragma unroll
            for (int ai = 0; ai < 2; ++ai)
#pragma unroll
                for (int mh = 0; mh < 2; ++mh) {
                    u32x4 tv[2][2], sv[2][2];
#pragma unroll
                    for (int mm = 0; mm < 2; ++mm) {
                        const size_t rowi = (size_t)(u.pm * BM + ai * HALF + wr * 64 + (2 * mh + mm) * 16 + fr);
                        const bf16_t* rowp = Z1 + rowi * ZW + cbase;
                        const bf16_t* parkp = (const bf16_t*)out + rowi * 2048 + col0 + (MODE == 3 ? 1024 : 0);
#pragma unroll
                        for (int bj = 0; bj < 2; ++bj) {
                            if constexpr (MODE == 1) tv[mm][bj] = *(const u32x4*)(rowp + bj * HALF);
                            if constexpr (MODE == 2) tv[mm][bj] = *(const u32x4*)(parkp + bj * HALF);
                            if constexpr (MODE == 3) { tv[mm][bj] = *(const u32x4*)(rowp + bj * HALF); sv[mm][bj] = *(const u32x4*)(parkp + bj * HALF); }
                        }
                    }
#pragma unroll
                    for (int mm = 0; mm < 2; ++mm) {
                        const int m = 2 * mh + mm;
                        bf16_t* rowp = Z1 + (size_t)(u.pm * BM + ai * HALF + wr * 64 + m * 16 + fr) * ZW + cbase;
#pragma unroll
                        for (int bj = 0; bj < 2; ++bj) {
                            const f32x4 v0 = acc[ai][bj][m][0], v1 = acc[ai][bj][m][1];
                            float o[8] = {v0[0], v0[1], v0[2], v0[3], v1[0], v1[1], v1[2], v1[3]};
                            if constexpr (MODE == 1) {
                                if (gate) { float hf[8]; unpack8(tv[mm][bj], hf);
#pragma unroll
                                    for (int e = 0; e < 8; ++e) o[e] = siluf_(o[e]) * hf[e]; }
                                else {
#pragma unroll
                                    for (int e = 0; e < 8; ++e) o[e] = sigmoidf_(o[e]); }
                            } else if constexpr (MODE == 2) { float sf[8]; unpack8(tv[mm][bj], sf);
#pragma unroll
                                for (int e = 0; e < 8; ++e) o[e] *= sf[e];
                            } else { float tf[8], sf[8]; unpack8(tv[mm][bj], tf); unpack8(sv[mm][bj], sf);
#pragma unroll
                                for (int e = 0; e < 8; ++e) o[e] = tf[e] + sf[e] * o[e]; }
                            *(u32x4*)(rowp + bj * HALF) = pack8(o);
                        }
                    }
                }
        }
    }
};

struct SeqOrder {
    int base, step, n, smp;
    __device__ bool next(int i, Unit& u) const {
        if (i >= n) return false;
        const int t = base + i * step;
        if (smp) { u.pm = 64 + (t >> 2); u.pn = t & 3; }
        else { u.pm = (t & 7) * 8 + ((t >> 3) >> 2); u.pn = (t >> 3) & 3; }
        return true;
    }
};
template <class EpiT, class SchedT>
__device__ __forceinline__ void gemm_phase(LAS unsigned char* lds, const Gemm g, const SchedT& S, const EpiT& E) {
    const int tid = threadIdx.x, wid = __builtin_amdgcn_readfirstlane(tid >> 6), lane = tid & 63, wr = wid >> 2, wc = wid & 3, fr = lane & 15, fq = lane >> 4;
    const int K = g.K, nt = K / BK, lda = g.lda;
    unsigned voffA[2], voffB[2];
#pragma unroll
    for (int i = 0; i < 2; ++i) { int R, C; stage_rc(tid * 16 + i * 8192, R, C); const int Rb = EpiT::PERM ? ((R & ~31) + perm32(R & 31)) : R;
        voffA[i] = (unsigned)(R * lda + C) * 2u; voffB[i] = (unsigned)(Rb * K + C) * 2u; }
    const size_t kstep = (size_t)(BK * 2);
    const size_t hsA = (size_t)HALF * lda * 2, hsB = (size_t)HALF * K * 2;
    const size_t tsA = 2 * hsA, tsB = 2 * hsB;
    const unsigned ldsw = (unsigned)wid * 1024u;
    const int aoff = lds_byte(wr * 64 + fr, fq * 8), boff = lds_byte(wc * 32 + fr, fq * 8);
#define PG8_SA(b, h) (((b) * 2 + (h)) * HTB)
#define PG8_SB(b, h) ((4 + (b) * 2 + (h)) * HTB)
#define PG8_STAGE(bufoff, gbase, voff) do { _Pragma("unroll") for (int _i = 0; _i < 2; ++_i) \
        __builtin_amdgcn_global_load_lds((const unsigned*)((const char*)(gbase) + (voff)[_i]), (LAS unsigned*)(lds + (bufoff) + ldsw + _i * 8192), 16, 0, 0); } while (0)
#define PG8_LDA(dst, b, h) do { _Pragma("unroll") for (int m = 0; m < 4; ++m) _Pragma("unroll") for (int k = 0; k < 2; ++k) dst[m][k] = *(const LAS bf16x8*)(lds + PG8_SA(b, h) + aoff + m * 2048 + k * 1024); } while (0)
#define PG8_LDB(dst, b, h) do { _Pragma("unroll") for (int n = 0; n < 2; ++n) _Pragma("unroll") for (int k = 0; k < 2; ++k) dst[n][k] = *(const LAS bf16x8*)(lds + PG8_SB(b, h) + boff + n * 2048 + k * 1024); } while (0)
#define PG8_MMA(ai, bj, At, Bt) do { __builtin_amdgcn_s_setprio(1); _Pragma("unroll") for (int m = 0; m < 4; ++m) _Pragma("unroll") for (int n = 0; n < 2; ++n) _Pragma("unroll") for (int k = 0; k < 2; ++k) \
        acc[ai][bj][m][n] = __builtin_amdgcn_mfma_f32_16x16x32_bf16(Bt[n][k], At[m][k], acc[ai][bj][m][n], 0, 0, 0); __builtin_amdgcn_s_setprio(0); } while (0)
#define PG8_WAIT_V(n) asm volatile("s_waitcnt vmcnt(" #n ")" ::: "memory")
#define PG8_WAIT_L(n) asm volatile("s_waitcnt lgkmcnt(" #n ")" ::: "memory")
#define PG8_BAR __builtin_amdgcn_s_barrier()
#define PG8_SCHED __builtin_amdgcn_sched_barrier(0)
    Unit cur, nxt; int ui = 0;
    if (!S.next(0, cur)) return;
    f32x4 acc[2][2][4][2];
#pragma unroll
    for (int a = 0; a < 2; ++a)
#pragma unroll
        for (int b = 0; b < 2; ++b)
#pragma unroll
            for (int m = 0; m < 4; ++m)
#pragma unroll
                for (int n = 0; n < 2; ++n) acc[a][b][m][n] = (f32x4){0.f, 0.f, 0.f, 0.f};
    bf16x8 At[4][2], B0[2][2], B1[2][2];
    const char* cA = (const char*)g.A + (size_t)cur.pm * tsA; const char* cB = (const char*)g.Bt + (size_t)cur.pn * tsB;
    PG8_STAGE(PG8_SB(0, 0), cB, voffB); PG8_STAGE(PG8_SB(0, 1), cB + hsB, voffB); PG8_STAGE(PG8_SA(0, 0), cA, voffA); PG8_STAGE(PG8_SA(0, 1), cA + hsA, voffA);
    if (wr == 1) PG8_BAR;
    PG8_WAIT_V(2); PG8_BAR;
    PG8_STAGE(PG8_SB(1, 0), cB + kstep, voffB); PG8_STAGE(PG8_SA(1, 0), cA + kstep, voffA); PG8_STAGE(PG8_SB(1, 1), cB + hsB + kstep, voffB);
    PG8_WAIT_V(6); PG8_BAR;
    for (;;) {
        const bool has_next = S.next(ui + 1, nxt);
        const char* nA = has_next ? (const char*)g.A + (size_t)nxt.pm * tsA : cA; const char* nB = has_next ? (const char*)g.Bt + (size_t)nxt.pn * tsB : cB;
        for (int t = 0; t < nt; t += 2) {
            const bool last = (t == nt - 2);
            const char* a1 = cA + (size_t)(t + 1) * kstep;
            const char* a2 = last ? nA : cA + (size_t)(t + 2) * kstep; const char* b2 = last ? nB : cB + (size_t)(t + 2) * kstep;
            const char* a3 = a2 + kstep; const char* b3 = b2 + kstep;
            PG8_LDB(B0, 0, 0); PG8_LDB(B1, 0, 1); PG8_SCHED; PG8_LDA(At, 0, 0); PG8_STAGE(PG8_SA(1, 1), a1 + hsA, voffA);
            PG8_WAIT_V(8); PG8_WAIT_L(0); PG8_BAR; PG8_MMA(0, 0, At, B0); PG8_MMA(0, 1, At, B1); PG8_BAR; PG8_SCHED;
            PG8_LDA(At, 0, 1); PG8_STAGE(PG8_SB(0, 0), b2, voffB); PG8_STAGE(PG8_SB(0, 1), b2 + hsB, voffB); PG8_STAGE(PG8_SA(0, 0), a2, voffA);
            PG8_WAIT_V(8); PG8_WAIT_L(0); PG8_BAR; PG8_MMA(1, 0, At, B0); PG8_MMA(1, 1, At, B1); PG8_BAR; PG8_SCHED;
            PG8_LDB(B0, 1, 0); PG8_LDB(B1, 1, 1); PG8_SCHED; PG8_LDA(At, 1, 0); PG8_STAGE(PG8_SA(0, 1), a2 + hsA, voffA);
            PG8_WAIT_V(8); PG8_WAIT_L(0); PG8_BAR; PG8_MMA(0, 0, At, B0); PG8_MMA(0, 1, At, B1); PG8_BAR; PG8_SCHED;
            PG8_LDA(At, 1, 1); PG8_STAGE(PG8_SB(1, 0), b3, voffB); PG8_STAGE(PG8_SB(1, 1), b3 + hsB, voffB); PG8_STAGE(PG8_SA(1, 0), a3, voffA);
            PG8_WAIT_V(8); PG8_WAIT_L(0); PG8_BAR; PG8_MMA(1, 0, At, B0); PG8_MMA(1, 1, At, B1); PG8_BAR; PG8_SCHED;
        }
        if (wr == 0) PG8_BAR;
        E(acc, cur, wr, wc, fr, fq);
        if (!has_next) break;
#pragma unroll
        for (int a = 0; a < 2; ++a)
#pragma unroll
            for (int b = 0; b < 2; ++b)
#pragma unroll
                for (int m = 0; m < 4; ++m)
#pragma unroll
                    for (int n = 0; n < 2; ++n) acc[a][b][m][n] = (f32x4){0.f, 0.f, 0.f, 0.f};
        cur = nxt; cA = nA; cB = nB; ++ui;
        if (wr == 1) PG8_BAR;
    }
    PG8_WAIT_V(0);
    PG8_BAR;
#undef PG8_SA
#undef PG8_SB
#undef PG8_STAGE
#undef PG8_LDA
#undef PG8_LDB
#undef PG8_MMA
#undef PG8_WAIT_V
#undef PG8_WAIT_L
#undef PG8_BAR
#undef PG8_SCHED
}
}

__device__ __forceinline__ void transpose_item(const float* W, int ldw, int src_col, bf16_t* WTrow, int k0, int lane) {
#pragma unroll
    for (int hf = 0; hf < 2; ++hf) {
        float v[32];
#pragma unroll
        for (int kk = 0; kk < 32; ++kk) v[kk] = W[(size_t)(k0 + hf * 32 + kk) * ldw + src_col + lane];
#pragma unroll
        for (int q = 0; q < 4; ++q) { u32x4 w; w.x = cvt_pk_bf16_asm(v[8 * q], v[8 * q + 1]); w.y = cvt_pk_bf16_asm(v[8 * q + 2], v[8 * q + 3]); w.z = cvt_pk_bf16_asm(v[8 * q + 4], v[8 * q + 5]); w.w = cvt_pk_bf16_asm(v[8 * q + 6], v[8 * q + 7]);
            *(u32x4*)(WTrow + k0 + hf * 32 + 8 * q) = w; }
    }
}
__device__ __forceinline__ void p0_prologue(const Args& a, LAS unsigned char* L) {
    const int tid = threadIdx.x, lane = tid & 63, wave = tid >> 6;
    const int gw = blockIdx.x * 8 + wave, NGW = gridDim.x * 8;
    unsigned char* ws = a.ws;
    const float* w_in = a.in[8];
    for (int it = gw; it < 2880; it += NGW) {
        if (it < 2048) {
            const int which = it >> 10, r = it & 1023, nb = r >> 4, kb = r & 15, n0 = nb * 64;
            int src;
            if (which == 0) src = (n0 < 1024) ? n0 : n0 + 1024;
            else src = (n0 < 1024) ? 1024 + n0 : (n0 < 2048) ? 5120 + (n0 - 1024) : (n0 < 3072) ? 6160 + (n0 - 2048) : 7184 + (n0 - 3072);
            bf16_t* WT = (bf16_t*)(ws + (which ? WS_W2T : WS_W1T));
            transpose_item(w_in, 8208, src, WT + (size_t)(n0 + lane) * 1024, kb * 64, lane);
        } else if (it < 2816) {
            const int r = it - 2048, which = r >> 8, q = r & 255, nb = q >> 4, kb = q & 15;
            const float* W = which == 0 ? a.in[20] : which == 1 ? a.in[21] : a.in[22];
            bf16_t* WT = (bf16_t*)(ws + (which == 0 ? WS_WBL : which == 1 ? WS_WBG : WS_WO));
            transpose_item(W, 1024, nb * 64, WT + (size_t)(nb * 64 + lane) * 1024, kb * 64, lane);
        } else {
            const int r = it - 2816, which = r >> 5, q = r & 31, g = q >> 2, nb = (q >> 1) & 1, kb = q & 1;
            const float* W = (which == 0 ? a.in[11] : a.in[13]) + (size_t)g * 16384;
            bf16_t* WT = (bf16_t*)(ws + (which == 0 ? WS_WA : WS_WX)) + (size_t)g * 16384;
            transpose_item(W, 128, nb * 64, WT + (size_t)(nb * 64 + lane) * 128, kb * 64, lane);
        }
    }
    LAS float* wT = (LAS float*)L;
    for (int idx = tid; idx < 16384; idx += 512) { const int k = idx >> 4, c = idx & 15; wT[c * 1024 + k] = w_in[(size_t)k * 8208 + 6144 + c]; }
    __syncthreads();
    const float* x_p = a.in[0]; const float* x_s = a.in[1]; const float* gain = a.in[6];
    bf16_t* U = (bf16_t*)(ws + WS_U); float* BG = (float*)(ws + WS_BG);
    f32x4 gn[4];
#pragma unroll
    for (int j = 0; j < 4; ++j) gn[j] = ((const f32x4*)gain)[lane + 64 * j];
    for (int m = gw; m < NROWS; m += NGW) {
        const float* xr = (m < NPROMPT) ? x_p + (size_t)m * DM : x_s + (size_t)(m - NPROMPT) * DM;
        f32x4 v[4]; float s = 0.f;
#pragma unroll
        for (int j = 0; j < 4; ++j) { v[j] = ((const f32x4*)xr)[lane + 64 * j]; s += (v[j].x * v[j].x + v[j].y * v[j].y) + (v[j].z * v[j].z + v[j].w * v[j].w); }
        const float rs = rsqrtf(wave_sum(s) * (1.f / DM) + EPS);
#pragma unroll
        for (int j = 0; j < 4; ++j) { v[j] = v[j] * rs * gn[j];
            u32x2 o; o.x = cvt_pk_bf16(v[j].x, v[j].y); o.y = cvt_pk_bf16(v[j].z, v[j].w);
            ((u32x2*)(U + (size_t)m * DM))[lane + 64 * j] = o; }
        float mine = 0.f;
#pragma unroll 1
        for (int c0 = 0; c0 < 16; c0 += 4) {
            float p[4];
#pragma unroll
            for (int cc = 0; cc < 4; ++cc) {
                p[cc] = 0.f;
#pragma unroll
                for (int j = 0; j < 4; ++j) { const f32x4 w = ((const LAS f32x4*)(wT + (c0 + cc) * 1024))[lane + 64 * j]; p[cc] += (v[j].x * w.x + v[j].y * w.y) + (v[j].z * w.z + v[j].w * w.w); }
            }
#pragma unroll
            for (int cc = 0; cc < 4; ++cc) p[cc] = row16_sum(p[cc]);
#pragma unroll
            for (int cc = 0; cc < 4; ++cc) p[cc] += __shfl_xor(p[cc], 16);
#pragma unroll
            for (int cc = 0; cc < 4; ++cc) p[cc] += __shfl_xor(p[cc], 32);
#pragma unroll
            for (int cc = 0; cc < 4; ++cc) if (lane == c0 + cc) mine = p[cc];
        }
        if (lane < 8) BG[(size_t)m * 16 + lane] = 1.f / (1.f + expf(-mine));
        else if (lane < 16) { const int h = lane - 8; const float xx = mine + a.in[18][h]; const float sp = xx > 20.f ? xx : log1pf(expf(xx)); BG[(size_t)m * 16 + lane] = -expf(a.in[17][h]) * sp; }
    }
}

#ifndef DRY_SKIP
#define DRY_SKIP 0
#endif
__device__ __forceinline__ void p2_gdn_local(const Args& a, LAS unsigned char* L, const bool dry) {
    const int tid = threadIdx.x, lane = tid & 63, wave = __builtin_amdgcn_readfirstlane(tid >> 6), fr = lane & 15, fq = lane >> 4;
    LAS bf16_t* QS = (LAS bf16_t*)(L);
    LAS bf16_t* KS = (LAS bf16_t*)(L + 17408);
    LAS float* MS = (LAS float*)(L + 52224);
    LAS bf16_t* AS = (LAS bf16_t*)(L + 68864);
    LAS bf16_t* TS = (LAS bf16_t*)(L + 78080);
    LAS float* GCS = (LAS float*)(L + 87296);
    LAS float* BES = (LAS float*)(L + 87552);
    LAS bf16_t* RAW = (LAS bf16_t*)(L + 87808);
    LAS float* CW = (LAS float*)(L + 140336);
    LAS bf16_t* SH = (LAS bf16_t*)(L + 52224);
    bf16_t* Z1 = (bf16_t*)(a.ws + WS_Z1); const bf16_t* HALO = (const bf16_t*)(a.ws + WS_HALO);
    const float* BG = (const float*)(a.ws + WS_BG); float* GC = (float*)(a.ws + WS_GC);
    bf16_t* TINV = (bf16_t*)(a.ws + WS_TINV); bf16_t* AQK = (bf16_t*)(a.ws + WS_AQK);
    const float* st_gc = a.in[4]; const float* cw = a.in[16];
    u32x4 nr[7];
    int zo[7], lo[7];
#pragma unroll
    for (int k = 0; k < 7; ++k) {
        int q = tid + 512 * k; if (q > 3215) q = 3215;
        const int rr = q / 48, rem = q - rr * 48;
        zo[k] = (rr >= 3 ? rr - 3 : 0) * ZW + (rem >> 4) * 1024 + (rem & 15) * 8;
        lo[k] = rr * 392 + rem * 8;
    }
    const int rr0 = tid / 48;
    const int ho0 = rr0 * 3072 + ((tid - rr0 * 48) >> 4) * 1024 + ((tid - rr0 * 48) & 15) * 8;
    auto prefetch = [&](int u) {
        const int grp = u >> 3, h = u & 7; const bool smp = grp >= 256; const bool nohalo = smp || ((grp & 31) == 0);
        const bf16_t* zb = Z1 + (size_t)grp * 64 * ZW + 1024 + h * 128;
#pragma unroll
        for (int k = 0; k < 7; ++k) {
            const bf16_t* src = zb + zo[k];
            if (k == 0 && rr0 < 3 && !nohalo) src = HALO + (size_t)(grp - 1) * 3 * 3072 + h * 128 + ho0;
            u32x4 v = *(const u32x4*)src;
            if (k == 0 && rr0 < 3 && nohalo) v = (u32x4){0u, 0u, 0u, 0u};
            nr[k] = v;
        }
    };
    int hprev = -1;
    if ((int)blockIdx.x < 2176) prefetch(blockIdx.x);
    for (int u = blockIdx.x; u < 2176; u += gridDim.x) {
        const int grp = u >> 3, h = u & 7; const bool smp = grp >= 256; const int row0 = grp * 64;
        const int t = tid >> 3, p = tid & 7;
        __syncthreads();
#pragma unroll
        for (int k = 0; k < 7; ++k) {
            const int q = tid + 512 * k;
            if (q < 3216) *(LAS u32x4*)(RAW + lo[k]) = nr[k];
        }
        if (h != hprev) {
#pragma unroll
            for (int k = 0; k < 3; ++k) { const int idx = tid + 512 * k, i = idx / 384, c = idx - i * 384; CW[idx] = cw[(size_t)i * 3072 + (c >> 7) * 1024 + h * 128 + (c & 127)]; }
            hprev = h;
        }
        if (smp) {
            for (int idx = tid; idx < 9216; idx += 512) { const int sr = idx / 384, c = idx - sr * 384;
                SH[sr * 392 + c] = f2bf(st_gc[(size_t)((grp - 256) * 24 + sr) * 3072 + (c >> 7) * 1024 + h * 128 + (c & 127)]); }
        }
        if (tid < 64) {
            float g = BG[(size_t)(row0 + tid) * 16 + 8 + h]; const float be = BG[(size_t)(row0 + tid) * 16 + h];
            const int li = smp ? (tid & 7) : tid;
#pragma unroll
            for (int d = 1; d < 64; d <<= 1) { const float o = __shfl_up(g, d); if (li >= d) g += o; }
            GCS[tid] = g; BES[tid] = be; GC[(size_t)(row0 + tid) * 8 + h] = g;
        }
        __syncthreads();
        if (u + (int)gridDim.x < 2176) prefetch(u + gridDim.x);
#pragma unroll 1
        for (int seg = (dry && (DRY_SKIP & 4)) ? 3 : 0; seg < 3; ++seg) {
            float av[16];
#pragma unroll
            for (int e = 0; e < 16; ++e) av[e] = 0.f;
#pragma unroll
            for (int i = 0; i < 4; ++i) {
                const int ts8 = (t & 7) - 3 + i;
                const LAS bf16_t* rp = (smp && ts8 < 0) ? SH + ((t >> 3) * 3 + ts8 + 3) * 392 : RAW + (t + i) * 392;
                rp += seg * 128 + 16 * p;
                float xv[16];
                const u32x4 w0 = *(const LAS u32x4*)rp, w1 = *(const LAS u32x4*)(rp + 8); unpack8(w0, xv); unpack8(w1, xv + 8);
                const LAS float* wp = CW + i * 384 + seg * 128 + 16 * p;
#pragma unroll
                for (int q = 0; q < 4; ++q) { const f32x4 f = *(const LAS f32x4*)(wp + 4 * q); av[4 * q] += f.x * xv[4 * q]; av[4 * q + 1] += f.y * xv[4 * q + 1]; av[4 * q + 2] += f.z * xv[4 * q + 2]; av[4 * q + 3] += f.w * xv[4 * q + 3]; }
            }
            float ss = 0.f;
#pragma unroll
            for (int e = 0; e < 16; ++e) { av[e] = siluf_(av[e]); ss += av[e] * av[e]; }
            ss += __shfl_xor(ss, 1); ss += __shfl_xor(ss, 2); ss += __shfl_xor(ss, 4);
            const float rs = (seg == 2) ? 1.f : rsqrtf(ss + EPS) * (seg == 0 ? 0.08838834764831845f : 1.f);
#pragma unroll
            for (int e = 0; e < 16; ++e) av[e] *= rs;
            LAS bf16_t* d = QS + seg * 8704 + t * 136 + 16 * p;
            *(LAS u32x4*)d = pack8(av); *(LAS u32x4*)(d + 8) = pack8(av + 8);
        }
        __syncthreads();
        if (!dry)
#pragma unroll
        for (int q = 0; q < 6; ++q) {
            const int idx = tid + 512 * q, seg = idx >> 10, r = (idx >> 4) & 63, ch = idx & 15;
            *(u32x4*)(Z1 + (size_t)(row0 + r) * ZW + 1024 + seg * 1024 + h * 128 + ch * 8) = *(const LAS u32x4*)(QS + seg * 8704 + r * 136 + ch * 8);
        }
        if (!(dry && (DRY_SKIP & 2)))
        {
            const int sel = wave >> 2, ti = wave & 3;
            const LAS bf16_t* XA = sel ? QS : KS;
            bf16x8 af[4], bfr[4][4]; float gi[4], bi[4], gj[4];
#pragma unroll
            for (int ks = 0; ks < 4; ++ks) af[ks] = *(const LAS bf16x8*)(XA + (16 * ti + fr) * 136 + 32 * ks + 8 * fq);
#pragma unroll
            for (int tj = 0; tj < 4; ++tj) {
                gj[tj] = GCS[16 * tj + fr];
#pragma unroll
                for (int ks = 0; ks < 4; ++ks) bfr[tj][ks] = *(const LAS bf16x8*)(KS + (16 * tj + fr) * 136 + 32 * ks + 8 * fq);
            }
#pragma unroll
            for (int r = 0; r < 4; ++r) { gi[r] = GCS[16 * ti + 4 * fq + r]; bi[r] = BES[16 * ti + 4 * fq + r]; }
            __builtin_amdgcn_sched_barrier(0);
            f32x4 acc[4];
#pragma unroll
            for (int tj = 0; tj < 4; ++tj) {
                acc[tj] = (f32x4){0.f, 0.f, 0.f, 0.f};
                if (tj <= ti) {
#pragma unroll
                    for (int ks = 0; ks < 4; ++ks) acc[tj] = __builtin_amdgcn_mfma_f32_16x16x32_bf16(af[ks], bfr[tj][ks], acc[tj], 0, 0, 0);
                }
            }
            float ov[4][4];
#pragma unroll
            for (int tj = 0; tj < 4; ++tj)
#pragma unroll
                for (int r = 0; r < 4; ++r) {
                    const int i = 16 * ti + 4 * fq + r, j = 16 * tj + fr;
                    const bool same = smp ? ((i >> 3) == (j >> 3)) : true;
                    const float e = __expf(fminf(gi[r] - gj[tj], 0.f));
                    const bool keep = same && (sel == 0 ? (i > j) : (i >= j));
                    ov[tj][r] = keep ? (sel == 0 ? bi[r] : 1.f) * acc[tj][r] * e : 0.f;
                }
            if (sel == 0) {
#pragma unroll
                for (int tj = 0; tj < 4; ++tj)
#pragma unroll
                    for (int r = 0; r < 4; ++r) MS[(16 * ti + 4 * fq + r) * 65 + 16 * tj + fr] = ov[tj][r];
            } else {
#pragma unroll
                for (int tj = 0; tj < 4; ++tj)
#pragma unroll
                    for (int r = 0; r < 4; ++r) AS[(16 * ti + 4 * fq + r) * 72 + 16 * tj + fr] = f2bf(ov[tj][r]);
            }
        }
        __syncthreads();
        if (!(dry && (DRY_SKIP & 1)))
        {
            float mrow[64];
#pragma unroll
            for (int j = 0; j < 64; ++j) mrow[j] = MS[lane * 65 + j];
            float X[8];
#pragma unroll
            for (int cc = 0; cc < 8; ++cc) X[cc] = (lane == 8 * cc + wave) ? 1.f : 0.f;
#pragma unroll
            for (int j = 0; j < 64; ++j) {
                float sv[8];
#pragma unroll
                for (int cc = 0; cc < 8; ++cc) sv[cc] = (8 * cc <= j) ? __uint_as_float(__builtin_amdgcn_readlane(__float_as_uint(X[cc]), j)) : 0.f;
                const float nm = -mrow[j];
#pragma unroll
                for (int cc = 0; cc < 8; ++cc) if (8 * cc <= j) X[cc] = fmaf(nm, sv[cc], X[cc]);
            }
#pragma unroll
            for (int cc = 0; cc < 8; ++cc) TS[lane * 72 + 8 * cc + wave] = f2bf(X[cc]);
        }
        __syncthreads();
        {
            const int r = tid >> 3, ch = tid & 7;
            const size_t o = ((size_t)u * 64 + r) * 64 + ch * 8;
            *(u32x4*)(TINV + o) = *(const LAS u32x4*)(TS + r * 72 + ch * 8);
            *(u32x4*)(AQK + o) = *(const LAS u32x4*)(AS + r * 72 + ch * 8);
        }
    }
    __syncthreads();
}

__device__ __forceinline__ u32x4 gdn_norm8(const u32x4 o8, const LAS float* part8, const LAS float* nw8) {
    const f32x4 p0 = *(const LAS f32x4*)part8, p1 = *(const LAS f32x4*)(part8 + 4);
    const float tot = ((p0[0] + p0[1]) + (p0[2] + p0[3])) + ((p1[0] + p1[1]) + (p1[2] + p1[3]));
    const float rs = rsqrtf(tot * (1.f / 128.f) + EPS);
    float f[8]; unpack8(o8, f);
#pragma unroll
    for (int e = 0; e < 8; ++e) f[e] = f[e] * rs * nw8[e];
    return pack8(f);
}

template <int MT>
__device__ __forceinline__ void gdn_scan_unit(const Args& a, LAS unsigned char* L, int sq, int h, const bool dry) {
    constexpr bool SMP = (MT == 1);
    constexpr int NR = MT * 16, NS2 = (MT + 1) / 2, NV = SMP ? 8 : 64;
    constexpr int BUFB = 71168;
    const int tid = threadIdx.x, lane = tid & 63, wave = __builtin_amdgcn_readfirstlane(tid >> 6), fr = lane & 15, fq = lane >> 4;
    LAS float* OSS = (LAS float*)(L + 2 * BUFB);
    bf16_t* Z1 = (bf16_t*)(a.ws + WS_Z1);
    const float* BG = (const float*)(a.ws + WS_BG); const float* GC = (const float*)(a.ws + WS_GC);
    const bf16_t* TINV = (const bf16_t*)(a.ws + WS_TINV); const bf16_t* AQK = (const bf16_t*)(a.ws + WS_AQK);
    const int dv = 16 * wave + fr;
    LAS float* NWS = (LAS float*)(L + 2 * BUFB + 2048);
    if (tid < 128) NWS[tid] = a.in[19][tid];
    const LAS float* nw8 = NWS + (tid & 15) * 8;
    f32x4 S[8];
    if (SMP) {
        const float* S0 = a.in[5] + (size_t)(sq * 8 + h) * 16384;
#pragma unroll
        for (int dt = 0; dt < 8; ++dt)
#pragma unroll
            for (int r = 0; r < 4; ++r) S[dt][r] = S0[(size_t)(16 * dt + 4 * fq + r) * 128 + dv];
    } else {
#pragma unroll
        for (int dt = 0; dt < 8; ++dt) S[dt] = (f32x4){0.f, 0.f, 0.f, 0.f};
    }
    const int nch = SMP ? 1 : 32;
    const int o8 = SMP ? (sq & 7) * 8 : 0;
    u32x4 pk[6], pt[2]; float pg = 0.f, pb = 0.f;
    auto load_chunk = [&](int c) {
        const int rowc = SMP ? NPROMPT + sq * 8 : sq * SEQ + 64 * c;
        const int grp = SMP ? 256 + (sq >> 3) : (sq * 32 + c);
#pragma unroll
        for (int q = 0; q < 2; ++q) {
            const int idx = tid + 512 * q, r = idx >> 4, ch = idx & 15;
            const bool ok = SMP ? ((idx < NR * 16) && (r < NV)) : true;
            const int rcl = ok ? r : 0;
#pragma unroll
            for (int seg = 0; seg < 3; ++seg) {
                u32x4 v = *(const u32x4*)(Z1 + (size_t)(rowc + rcl) * ZW + 1024 + seg * 1024 + h * 128 + ch * 8);
                if (!ok) v = (u32x4){0u, 0u, 0u, 0u};
                pk[q * 3 + seg] = v;
            }
        }
        {
            const int r = tid >> 3, ch = tid & 7;
            bool ok; size_t o;
            if (SMP) { ok = (r < 8) && (ch == 0); o = ((size_t)(grp * 8 + h) * 64 + o8 + (ok ? r : 0)) * 64 + o8; }
            else { ok = true; o = ((size_t)(grp * 8 + h) * 64 + r) * 64 + ch * 8; }
            u32x4 v0 = *(const u32x4*)(TINV + o), v1 = *(const u32x4*)(AQK + o);
            if (!ok) { v0 = (u32x4){0u, 0u, 0u, 0u}; v1 = v0; }
            pt[0] = v0; pt[1] = v1;
        }
        if (tid < 64) { const bool ok = tid < NV; const int tc = ok ? tid : 0; pg = GC[(size_t)(rowc + tc) * 8 + h]; pb = BG[(size_t)(rowc + tc) * 16 + h]; if (!ok) { pg = 0.f; pb = 0.f; } }
    };
    auto write_chunk = [&](LAS unsigned char* B) {
        LAS bf16_t* KSb = (LAS bf16_t*)(B); LAS bf16_t* QSb = (LAS bf16_t*)(B + 17408); LAS bf16_t* VSb = (LAS bf16_t*)(B + 34816);
        LAS bf16_t* TSb = (LAS bf16_t*)(B + 52224); LAS bf16_t* ASb = (LAS bf16_t*)(B + 61440);
#pragma unroll
        for (int q = 0; q < 2; ++q) {
            const int idx = tid + 512 * q, r = idx >> 4, ch = idx & 15;
            if (idx < NR * 16) {
                st_perm(QSb + r * 136, ch, pk[q * 3 + 0]);
                st_perm(KSb + r * 136, ch, pk[q * 3 + 1]);
                *(LAS u32x4*)(VSb + r * 136 + ch * 8) = pk[q * 3 + 2];
            }
        }
        { const int r = tid >> 3, ch = tid & 7; if (r < NR) { st_perm(TSb + r * 72, ch, pt[0]); st_perm(ASb + r * 72, ch, pt[1]); } }
        if (tid < 64) { ((LAS float*)(B + 70656))[tid] = pg; ((LAS float*)(B + 70912))[tid] = pb; }
    };
    load_chunk(0);
    write_chunk(L);
    if (nch > 1) load_chunk(1);
#define SB_ __builtin_amdgcn_sched_barrier(0)
    for (int c = 0; c < nch; ++c) {
        const int rowc = SMP ? NPROMPT + sq * 8 : sq * SEQ + 64 * c;
        LAS unsigned char* B = L + (c & 1) * BUFB;
        LAS unsigned char* Bo = L + ((c & 1) ^ 1) * BUFB;
        LAS bf16_t* KS = (LAS bf16_t*)(B); LAS bf16_t* QS = (LAS bf16_t*)(B + 17408); LAS bf16_t* VS = (LAS bf16_t*)(B + 34816);
        LAS bf16_t* TS = (LAS bf16_t*)(B + 52224); LAS bf16_t* AS = (LAS bf16_t*)(B + 61440);
        LAS float* GCS = (LAS float*)(B + 70656); LAS float* BES = (LAS float*)(B + 70912);
        __syncthreads();
        if (c > 0 && !dry) {
            const LAS bf16_t* OSo = (const LAS bf16_t*)(Bo + 17408);
#pragma unroll
            for (int q = 0; q < 2; ++q) {
                const int idx = tid + 512 * q, r = idx >> 4, ch = idx & 15;
                *(u32x4*)(Z1 + (size_t)(rowc - 64 + r) * ZW + 1024 + h * 128 + ch * 8) = gdn_norm8(*(const LAS u32x4*)(OSo + r * 136 + ch * 8), OSS + r * 8, nw8);
            }
        }

        const float gl = GCS[NV - 1];
        bf16x8 Sb[4];
#pragma unroll
        for (int s = 0; s < 4; ++s) Sb[s] = pack_frag(S[2 * s], S[2 * s + 1]);
        f32x4 R[MT], P[MT];
#pragma unroll
        for (int mt = 0; mt < MT; ++mt) {
            bf16x8 fk[4];
#pragma unroll
            for (int s = 0; s < 4; ++s) fk[s] = lda_perm(KS + (16 * mt + fr) * 136, s, fq, true);
            SB_;
            R[mt] = (f32x4){0.f, 0.f, 0.f, 0.f}; P[mt] = (f32x4){0.f, 0.f, 0.f, 0.f};
#pragma unroll
            for (int s = 0; s < 4; ++s) R[mt] = __builtin_amdgcn_mfma_f32_16x16x32_bf16(fk[s], Sb[s], R[mt], 0, 0, 0);
            SB_;
#pragma unroll
            for (int s = 0; s < 4; ++s) fk[s] = lda_perm(QS + (16 * mt + fr) * 136, s, fq, true);
            SB_;
#pragma unroll
            for (int s = 0; s < 4; ++s) P[mt] = __builtin_amdgcn_mfma_f32_16x16x32_bf16(fk[s], Sb[s], P[mt], 0, 0, 0);
            SB_;
        }
        __syncthreads();
        if (c + 1 < nch) write_chunk(Bo);
        SB_;
#pragma unroll
        for (int m0 = 0; m0 < MT; m0 += 2) {
            float gi_[2][4], vi_[2][4], bi_[2][4];
#pragma unroll
            for (int mm = 0; mm < 2; ++mm) if (m0 + mm < MT) {
#pragma unroll
                for (int r = 0; r < 4; ++r) { const int i = 16 * (m0 + mm) + 4 * fq + r; gi_[mm][r] = GCS[i]; bi_[mm][r] = BES[i]; vi_[mm][r] = bf1(VS[i * 136 + dv]); }
            }
            SB_;
#pragma unroll
            for (int mm = 0; mm < 2; ++mm) if (m0 + mm < MT) {
#pragma unroll
                for (int r = 0; r < 4; ++r) {
                    const float e = __expf(gi_[mm][r]);
                    R[m0 + mm][r] = bi_[mm][r] * (vi_[mm][r] - e * R[m0 + mm][r]);
                    P[m0 + mm][r] *= e;
                }
            }
            SB_;
        }
        bf16x8 rb[NS2];
#pragma unroll
        for (int s2 = 0; s2 < NS2; ++s2) rb[s2] = pack_frag(R[2 * s2], (2 * s2 + 1 < MT) ? R[(2 * s2 + 1 < MT) ? 2 * s2 + 1 : 0] : (f32x4){0.f, 0.f, 0.f, 0.f});
        f32x4 Vn[MT];
#pragma unroll
        for (int m0 = 0; m0 < MT; m0 += 2) {
            bf16x8 ft[2][NS2];
#pragma unroll
            for (int mm = 0; mm < 2; ++mm) if (m0 + mm < MT) {
#pragma unroll
                for (int s2 = 0; s2 < NS2; ++s2) ft[mm][s2] = lda_perm(TS + (16 * (m0 + mm) + fr) * 72, s2, fq, 2 * s2 + 1 < MT);
            }
            SB_;
#pragma unroll
            for (int mm = 0; mm < 2; ++mm) if (m0 + mm < MT) {
                Vn[m0 + mm] = (f32x4){0.f, 0.f, 0.f, 0.f};
#pragma unroll
                for (int s2 = 0; s2 < NS2; ++s2) Vn[m0 + mm] = __builtin_amdgcn_mfma_f32_16x16x32_bf16(ft[mm][s2], rb[s2], Vn[m0 + mm], 0, 0, 0);
            }
            SB_;
        }
        const int q4 = fr >> 2, p4 = fr & 3;
        bf16x8 fs[1][2][NS2];
        auto ld_tr = [&](int set, int dt) {
#pragma unroll
            for (int s2 = 0; s2 < NS2; ++s2) {
                const s16x4 lo = lds_tr(KS + (32 * s2 + 4 * fq + q4) * 136 + 32 * (dt >> 1) + 8 * p4 + 4 * (dt & 1));
                s16x4 hi = (s16x4){0, 0, 0, 0};
                if (2 * s2 + 1 < MT) hi = lds_tr(KS + (32 * s2 + 16 + 4 * fq + q4) * 136 + 32 * (dt >> 1) + 8 * p4 + 4 * (dt & 1));
                bf16x8 af; af[0] = lo[0]; af[1] = lo[1]; af[2] = lo[2]; af[3] = lo[3]; af[4] = hi[0]; af[5] = hi[1]; af[6] = hi[2]; af[7] = hi[3];
                fs[set][dt & 1][s2] = af;
            }
        };
        bf16x8 vb[NS2], vdb[NS2];
#pragma unroll
        for (int s2 = 0; s2 < NS2; ++s2) {
            const int m1 = (2 * s2 + 1 < MT) ? 2 * s2 + 1 : 0;
            const f32x4 z = (f32x4){0.f, 0.f, 0.f, 0.f};
            vb[s2] = pack_frag(Vn[2 * s2], (2 * s2 + 1 < MT) ? Vn[m1] : z);
            f32x4 d0, d1;
#pragma unroll
            for (int r = 0; r < 4; ++r) { d0[r] = Vn[2 * s2][r] * __expf(gl - GCS[32 * s2 + 4 * fq + r]); d1[r] = (2 * s2 + 1 < MT) ? Vn[m1][r] * __expf(gl - GCS[32 * s2 + 16 + 4 * fq + r]) : 0.f; }
            vdb[s2] = pack_frag(d0, d1);
        }
#pragma unroll
        for (int m0 = 0; m0 < MT; m0 += 2) {
            bf16x8 fa2[2][NS2];
#pragma unroll
            for (int mm = 0; mm < 2; ++mm) if (m0 + mm < MT) {
#pragma unroll
                for (int s2 = 0; s2 < NS2; ++s2) fa2[mm][s2] = lda_perm(AS + (16 * (m0 + mm) + fr) * 72, s2, fq, 2 * s2 + 1 < MT);
            }
            SB_;
#pragma unroll
            for (int mm = 0; mm < 2; ++mm) if (m0 + mm < MT) {
#pragma unroll
                for (int s2 = 0; s2 < NS2; ++s2) P[m0 + mm] = __builtin_amdgcn_mfma_f32_16x16x32_bf16(fa2[mm][s2], vb[s2], P[m0 + mm], 0, 0, 0);
            }
            SB_;
        }
        {
            const float eg = __expf(gl);
#pragma unroll
            for (int d0 = 0; d0 < 8; d0 += 2) {
                ld_tr(0, d0); ld_tr(0, d0 + 1);
                SB_;
#pragma unroll
                for (int dt = d0; dt < d0 + 2; ++dt) {
                    S[dt] = S[dt] * eg;
#pragma unroll
                    for (int s2 = 0; s2 < NS2; ++s2) S[dt] = __builtin_amdgcn_mfma_f32_16x16x32_bf16(fs[0][dt & 1][s2], vdb[s2], S[dt], 0, 0, 0);
                }
                SB_;
            }
        }
#pragma unroll
        for (int mt = 0; mt < MT; ++mt) {
            f32x4 qv;
#pragma unroll
            for (int r = 0; r < 4; ++r) { qv[r] = row16_sum(P[mt][r] * P[mt][r]); QS[(16 * mt + 4 * fq + r) * 136 + dv] = f2bf(P[mt][r]); }
            if (fr < 4) OSS[(16 * mt + 4 * fq + fr) * 8 + wave] = (fr == 0) ? qv[0] : (fr == 1) ? qv[1] : (fr == 2) ? qv[2] : qv[3];
        }
        if (c + 2 < nch) load_chunk(c + 2);
    }
#undef SB_
    __syncthreads();
    {
        const int rowl = SMP ? NPROMPT + sq * 8 : sq * SEQ + 64 * (nch - 1);
        const LAS bf16_t* OSl = (const LAS bf16_t*)(L + ((nch - 1) & 1) * BUFB + 17408);
#pragma unroll
        for (int q = 0; q < 2; ++q) {
            const int idx = tid + 512 * q, r = idx >> 4, ch = idx & 15;
            if (idx < NR * 16 && r < NV && !dry) *(u32x4*)(Z1 + (size_t)(rowl + r) * ZW + 1024 + h * 128 + ch * 8) = gdn_norm8(*(const LAS u32x4*)(OSl + r * 136 + ch * 8), OSS + r * 8, nw8);
        }
    }
    float* So = a.out + (SMP ? O_SGS : O_PGS) + (size_t)(sq * 8 + h) * 16384;
#pragma unroll
    for (int dt = 0; dt < 8; ++dt)
#pragma unroll
        for (int r = 0; r < 4; ++r) So[(size_t)(16 * dt + 4 * fq + r) * 128 + dv] = S[dt][r];
    __syncthreads();
}

__device__ __forceinline__ void lru_unit(const Args& a, LAS unsigned char* L, bool smp, int bidx, int g, const bool dry) {
    const int tid = threadIdx.x, lane = tid & 63, wave = __builtin_amdgcn_readfirstlane(tid >> 6), fr = lane & 15, fq = lane >> 4;
    LAS float* XC = (LAS float*)(L);
    LAS bf16_t* XB = (LAS bf16_t*)(L + 33792);
    LAS bf16_t* HS = (LAS bf16_t*)(L + 51200);
    LAS bf16_t* RW = (LAS bf16_t*)(L + 68608);
    LAS bf16_t* SH = (LAS bf16_t*)(L + 86832);
    LAS float* CWL = (LAS float*)(L + 93360);
    bf16_t* Z1 = (bf16_t*)(a.ws + WS_Z1);
    const bf16_t* WAT = (const bf16_t*)(a.ws + WS_WA) + (size_t)g * 16384;
    const bf16_t* WXT = (const bf16_t*)(a.ws + WS_WX) + (size_t)g * 16384;
    const float* cw = a.in[9]; const float* cb = a.in[10];
    const int c = 16 * wave + fr, col = g * 128 + c;
    const float ba = a.in[12][col], bx = a.in[14][col];
    const float al = a.in[15][col];
    const float ls = -(al > 0.f ? log1pf(expf(-al)) : (log1pf(expf(al)) - al));
    bf16x8 Bwa[4], Bwx[4];
#pragma unroll
    for (int ks = 0; ks < 4; ++ks) { Bwa[ks] = *(const bf16x8*)(WAT + (size_t)c * 128 + 32 * ks + 8 * fq); Bwx[ks] = *(const bf16x8*)(WXT + (size_t)c * 128 + 32 * ks + 8 * fq); }
    const int ntile = smp ? 1 : 32;
    float carry = 0.f;
    const int t = tid >> 3, p = tid & 7, cc0 = 16 * p, gc0 = g * 128 + cc0;
    for (int idx = tid; idx < 640; idx += 512) { const int i = idx >> 7, cc = idx & 127; CWL[idx] = (i < 4) ? cw[(size_t)i * 1024 + g * 128 + cc] : cb[g * 128 + cc]; }
    if (smp) { for (int idx = tid; idx < 3072; idx += 512) { const int sr = idx >> 7, cc = idx & 127; SH[sr * 136 + cc] = f2bf(a.in[2][(size_t)(bidx * 24 + sr) * 1024 + g * 128 + cc]); } }
    const int row00 = smp ? NPROMPT + bidx * 64 : bidx * SEQ;
    LAS bf16_t* RW2 = (LAS bf16_t*)(L + 95920);
    u32x4 nx0 = *(const u32x4*)(Z1 + (size_t)(row00 + t) * ZW + gc0), nx1 = *(const u32x4*)(Z1 + (size_t)(row00 + t) * ZW + gc0 + 8);
    u32x4 pv0 = (u32x4){0u, 0u, 0u, 0u}, pv1 = pv0;
    *(LAS u32x4*)(RW + (3 + t) * 136 + cc0) = nx0; *(LAS u32x4*)(RW + (3 + t) * 136 + cc0 + 8) = nx1;
    if (t >= 61) { *(LAS u32x4*)(RW + (t - 61) * 136 + cc0) = pv0; *(LAS u32x4*)(RW + (t - 61) * 136 + cc0 + 8) = pv1; }
    pv0 = nx0; pv1 = nx1;
    if (ntile > 1) { nx0 = *(const u32x4*)(Z1 + (size_t)(row00 + 64 + t) * ZW + gc0); nx1 = *(const u32x4*)(Z1 + (size_t)(row00 + 64 + t) * ZW + gc0 + 8); }
    for (int j = 0; j < ntile; ++j) {
        const int rowt = row00 + 64 * j;
        const LAS bf16_t* RWc = (j & 1) ? RW2 : RW;
        __syncthreads();
        {
            float y[16];
#pragma unroll
            for (int q = 0; q < 4; ++q) { const f32x4 f = *(const LAS f32x4*)(CWL + 512 + cc0 + 4 * q); y[4 * q] = f.x; y[4 * q + 1] = f.y; y[4 * q + 2] = f.z; y[4 * q + 3] = f.w; }
#pragma unroll
            for (int i = 0; i < 4; ++i) {
                const int ts8 = (t & 7) - 3 + i;
                const LAS bf16_t* rp = ((smp && ts8 < 0) ? SH + ((t >> 3) * 3 + ts8 + 3) * 136 : RWc + (t + i) * 136) + cc0;
                float xv[16];
                const u32x4 w0 = *(const LAS u32x4*)rp, w1 = *(const LAS u32x4*)(rp + 8); unpack8(w0, xv); unpack8(w1, xv + 8);
#pragma unroll
                for (int q = 0; q < 4; ++q) { const f32x4 f = *(const LAS f32x4*)(CWL + i * 128 + cc0 + 4 * q); y[4 * q] += f.x * xv[4 * q]; y[4 * q + 1] += f.y * xv[4 * q + 1]; y[4 * q + 2] += f.z * xv[4 * q + 2]; y[4 * q + 3] += f.w * xv[4 * q + 3]; }
            }
#pragma unroll
            for (int q = 0; q < 4; ++q) *(LAS f32x4*)(XC + t * 132 + cc0 + 4 * q) = (f32x4){y[4 * q], y[4 * q + 1], y[4 * q + 2], y[4 * q + 3]};
            *(LAS u32x4*)(XB + t * 136 + cc0) = pack8(y); *(LAS u32x4*)(XB + t * 136 + cc0 + 8) = pack8(y + 8);
        }
        if (j > 0 && !dry) {
#pragma unroll
            for (int q = 0; q < 2; ++q) {
                const int idx = tid + 512 * q, r = idx >> 4, ch = idx & 15;
                *(u32x4*)(Z1 + (size_t)(rowt - 64 + r) * ZW + g * 128 + ch * 8) = *(const LAS u32x4*)(HS + r * 136 + ch * 8);
            }
        }
        __syncthreads();
        f32x4 R[4], I[4];
#pragma unroll
        for (int mt = 0; mt < 4; ++mt) {
            bf16x8 fx[4];
#pragma unroll
            for (int ks = 0; ks < 4; ++ks) fx[ks] = *(const LAS bf16x8*)(XB + (16 * mt + fr) * 136 + 32 * ks + 8 * fq);
            __builtin_amdgcn_sched_barrier(0);
            R[mt] = (f32x4){0.f, 0.f, 0.f, 0.f}; I[mt] = (f32x4){0.f, 0.f, 0.f, 0.f};
#pragma unroll
            for (int ks = 0; ks < 4; ++ks) {
                R[mt] = __builtin_amdgcn_mfma_f32_16x16x32_bf16(fx[ks], Bwa[ks], R[mt], 0, 0, 0);
                I[mt] = __builtin_amdgcn_mfma_f32_16x16x32_bf16(fx[ks], Bwx[ks], I[mt], 0, 0, 0);
            }
            __builtin_amdgcn_sched_barrier(0);
        }
        float xc_[4][4];
#pragma unroll
        for (int mt = 0; mt < 4; ++mt)
#pragma unroll
            for (int r = 0; r < 4; ++r) xc_[mt][r] = XC[(16 * mt + 4 * fq + r) * 132 + c];
        __builtin_amdgcn_sched_barrier(0);
        float av[4][4], bv[4][4], Al[4], Bl[4];
#pragma unroll
        for (int mt = 0; mt < 4; ++mt) {
            Al[mt] = 1.f; Bl[mt] = 0.f;
#pragma unroll
            for (int r = 0; r < 4; ++r) {
                const int i = 16 * mt + 4 * fq + r;
                const float rr = sigmoidf_(R[mt][r] + ba);
                const float ig = sigmoidf_(I[mt][r] + bx);
                const float la = 8.f * rr * ls;
                float aa = __expf(la), mult = __builtin_amdgcn_sqrtf(fmaxf(fmaf(-aa, aa, 1.f), 0.f));
                if (!smp && j == 0 && i == 0) { aa = 0.f; mult = 1.f; }
                av[mt][r] = aa; bv[mt][r] = mult * ig * xc_[mt][r];
                Bl[mt] = aa * Bl[mt] + bv[mt][r]; Al[mt] *= aa;
            }
        }
        float Ag[4][4], Bg[4][4];
#pragma unroll
        for (int mt = 0; mt < 4; ++mt)
#pragma unroll
            for (int q = 0; q < 4; ++q) { Ag[mt][q] = __shfl(Al[mt], fr + 16 * q); Bg[mt][q] = __shfl(Bl[mt], fr + 16 * q); }
        float h0v[4] = {0.f, 0.f, 0.f, 0.f};
        if (smp) {
#pragma unroll
            for (int mt = 0; mt < 4; ++mt) h0v[mt] = a.in[3][(size_t)(bidx * 8 + 2 * mt + (fq >> 1)) * 1024 + col];
        }
#pragma unroll
        for (int mt = 0; mt < 4; ++mt) {
            float hin;
            if (smp) {
                hin = h0v[mt];
                const float A_ = (fq == 1) ? Ag[mt][0] : Ag[mt][2], B_ = (fq == 1) ? Bg[mt][0] : Bg[mt][2];
                hin = (fq & 1) ? A_ * hin + B_ : hin;
            } else {
                hin = carry;
#pragma unroll
                for (int q = 0; q < 3; ++q) hin = (q < fq) ? Ag[mt][q] * hin + Bg[mt][q] : hin;
#pragma unroll
                for (int q = 0; q < 4; ++q) carry = Ag[mt][q] * carry + Bg[mt][q];
            }
#pragma unroll
            for (int r = 0; r < 4; ++r) { hin = av[mt][r] * hin + bv[mt][r]; HS[(16 * mt + 4 * fq + r) * 136 + c] = f2bf(hin); }
            if (smp) { if (fq & 1) a.out[O_SLH + (size_t)(bidx * 8 + 2 * mt + (fq >> 1)) * 1024 + col] = hin; }
            else if (j == ntile - 1 && mt == 3 && fq == 3) a.out[O_PLH + (size_t)bidx * 1024 + col] = hin;
        }
        if (j + 1 < ntile) {
            LAS bf16_t* RWn = (j & 1) ? RW : RW2;
            *(LAS u32x4*)(RWn + (3 + t) * 136 + cc0) = nx0; *(LAS u32x4*)(RWn + (3 + t) * 136 + cc0 + 8) = nx1;
            if (t >= 61) { *(LAS u32x4*)(RWn + (t - 61) * 136 + cc0) = pv0; *(LAS u32x4*)(RWn + (t - 61) * 136 + cc0 + 8) = pv1; }
            pv0 = nx0; pv1 = nx1;
            if (j + 2 < ntile) { nx0 = *(const u32x4*)(Z1 + (size_t)(rowt + 128 + t) * ZW + gc0); nx1 = *(const u32x4*)(Z1 + (size_t)(rowt + 128 + t) * ZW + gc0 + 8); }
        }
    }
    __syncthreads();
    {
        const int rowl = row00 + 64 * (ntile - 1);
#pragma unroll
        for (int q = 0; q < 2; ++q) {
            const int idx = tid + 512 * q, r = idx >> 4, ch = idx & 15;
            if (!dry) *(u32x4*)(Z1 + (size_t)(rowl + r) * ZW + g * 128 + ch * 8) = *(const LAS u32x4*)(HS + r * 136 + ch * 8);
        }
    }
    __syncthreads();
}

#ifndef DRY3_SKIP
#define DRY3_SKIP 0
#endif
__device__ __forceinline__ void p3_scans(const Args& a, LAS unsigned char* L, const bool dry) {
    if (!(dry && (DRY3_SKIP & 1))) for (int u = blockIdx.x; u < 64; u += gridDim.x) gdn_scan_unit<4>(a, L, u >> 3, u & 7, dry);
    if (!(dry && (DRY3_SKIP & 2))) for (int u = blockIdx.x; u < 128; u += gridDim.x) if (u >= 64) lru_unit(a, L, false, (u - 64) >> 3, (u - 64) & 7, dry);
    if (gridDim.x >= 256) {
        const int nb = gridDim.x - 128, b = blockIdx.x - 128;
        if (b >= 0) {
            if (!(dry && (DRY3_SKIP & 8))) for (int u = b; u < 128; u += nb) lru_unit(a, L, true, u >> 3, u & 7, dry);
            if (!(dry && (DRY3_SKIP & 4))) for (int u = b; u < 1024; u += nb) gdn_scan_unit<1>(a, L, u >> 3, u & 7, dry);
            pg8::Gemm gm{(const bf16_t*)(a.ws + WS_U), (const bf16_t*)(a.ws + WS_W2T) + (size_t)2048 * 1024, NROWS, 1280, 1024, 1024};
            pg8::StaticOrder Sm; Sm.init(NROWS, 1280, nb, b);
            pg8::Epi<5> Em{nullptr, nullptr, a.out};
            pg8::gemm_phase(L, gm, Sm, Em);
        }
    } else {
        {
            pg8::Gemm gm{(const bf16_t*)(a.ws + WS_U), (const bf16_t*)(a.ws + WS_W2T) + (size_t)2048 * 1024, NROWS, 1280, 1024, 1024};
            pg8::StaticOrder Sm; Sm.init(NROWS, 1280, gridDim.x, blockIdx.x);
            pg8::Epi<5> Em{nullptr, nullptr, a.out};
            pg8::gemm_phase(L, gm, Sm, Em);
        }
        for (int u = blockIdx.x; u < 1152; u += gridDim.x) if (u >= 128) gdn_scan_unit<1>(a, L, (u - 128) >> 3, (u - 128) & 7, dry);
        for (int u = blockIdx.x; u < 1280; u += gridDim.x) if (u >= 1152) lru_unit(a, L, true, (u - 1152) >> 3, (u - 1152) & 7, dry);
    }
}

__device__ __forceinline__ void p7_final(const Args& a, const int row_lo, const int row_hi, const int wblk, const int nblk) {
    const int tid = threadIdx.x, lane = tid & 63, wave = tid >> 6;
    const int gw = row_lo + wblk * 8 + wave, NGW = nblk * 8;
    const float* gain = a.in[7];
    f32x4 gn[4];
#pragma unroll
    for (int j = 0; j < 4; ++j) gn[j] = ((const f32x4*)gain)[lane + 64 * j];
    for (int m = gw; m < row_hi; m += NGW) {
        const float* xr = (m < NPROMPT) ? a.in[0] + (size_t)m * DM : a.in[1] + (size_t)(m - NPROMPT) * DM;
        float* yr = a.out + (size_t)m * DM;
        f32x4 v[4]; float s = 0.f;
#pragma unroll
        for (int j = 0; j < 4; ++j) { v[j] = ((const f32x4*)yr)[lane + 64 * j]; s += (v[j].x * v[j].x + v[j].y * v[j].y) + (v[j].z * v[j].z + v[j].w * v[j].w); }
        const float rs = rsqrtf(wave_sum(s) * (1.f / DM) + EPS);
#pragma unroll
        for (int j = 0; j < 4; ++j) { const f32x4 x = ((const f32x4*)xr)[lane + 64 * j]; ((f32x4*)yr)[lane + 64 * j] = x + v[j] * rs * gn[j]; }
    }
}


#define XB_TMO      128
#define XB_XCNT(j)  (256  + 64 * (j))
#define XB_XSUB(j)  (1280 + 64 * (j))
#define XB_XGEN(j)  (2304 + 64 * (j))
#define XB_TOP      3328
#define XB_TOPGEN   3392
#define XCD_BAR_WORDS 3456
#define XB_SPIN_CAP (1u << 22)
__device__ __forceinline__ unsigned xb_ld(unsigned* p)              { return __hip_atomic_load(p, __ATOMIC_RELAXED, __HIP_MEMORY_SCOPE_AGENT); }
__device__ __forceinline__ unsigned xb_add(unsigned* p, unsigned v) { return __hip_atomic_fetch_add(p, v, __ATOMIC_RELAXED, __HIP_MEMORY_SCOPE_AGENT); }
__device__ __forceinline__ unsigned xb_xcc_id() { return (unsigned)__builtin_amdgcn_s_getreg((3 << 11) | 20) & 0xFu; }
#define XB_SPIN(cond, bar) do { unsigned _sp = 0; while (cond) { __builtin_amdgcn_s_sleep(1); \
    if ((++_sp & 255u) == 0u) { if (xb_ld(&(bar)[XB_TMO])) break; if (_sp > XB_SPIN_CAP) { atomicAdd(&(bar)[XB_TMO], 1u); break; } } } } while (0)
struct XcdBarrier { unsigned* bar; unsigned x; volatile LAS unsigned* st; };
__device__ __forceinline__ XcdBarrier xcd_barrier_post(unsigned* bar, volatile LAS unsigned* st) {
    XcdBarrier b; b.bar = bar; b.x = xb_xcc_id(); b.st = st;
    if (threadIdx.x == 0) (void)xb_add(&bar[XB_XCNT(b.x)], 1u);
    return b;
}
__device__ __forceinline__ void xcd_barrier_complete(unsigned* bar, unsigned x, unsigned& nloc, unsigned& nx) {
    const unsigned G = gridDim.x * gridDim.y * gridDim.z;
    unsigned sum, cnt, mine, sp = 0u;
    for (;;) {
        sum = 0u; cnt = 0u; mine = 0u;
#pragma unroll
        for (unsigned j = 0; j < 16; ++j) { const unsigned c = xb_ld(&bar[XB_XCNT(j)]); sum += c; cnt += (c > 0u) ? 1u : 0u; mine = (j == x) ? c : mine; }
        if (sum == G) break;
        __builtin_amdgcn_s_sleep(1);
        if ((++sp & 255u) == 0u) { if (xb_ld(&bar[XB_TMO])) break; if (sp > XB_SPIN_CAP) { atomicAdd(&bar[XB_TMO], 1u); break; } }
    }
    nloc = mine > 0u ? mine : 1u; nx = cnt > 0u ? cnt : 1u;
}
__device__ __forceinline__ void xcd_barrier(const XcdBarrier& b) {
    asm volatile("s_waitcnt vmcnt(0)" ::: "memory");
    __syncthreads();
    if (threadIdx.x == 0) {
        unsigned* bar = b.bar;
        __builtin_amdgcn_s_waitcnt(0);
        unsigned nloc = b.st[0], nx = b.st[1];
        if (nloc == 0u) { xcd_barrier_complete(bar, b.x, nloc, nx); b.st[0] = nloc; b.st[1] = nx; }
        const unsigned old = xb_add(&bar[XB_XSUB(b.x)], 1u);
        const unsigned gen = old / nloc;
        if (old + 1u == (gen + 1u) * nloc) {
            __builtin_amdgcn_fence(__ATOMIC_RELEASE, "agent");
            asm volatile("s_waitcnt vmcnt(0)" ::: "memory");
            const unsigned og = xb_add(&bar[XB_TOP], 1u);
            const unsigned tg = og / nx;
            if (og + 1u == (tg + 1u) * nx) xb_add(&bar[XB_TOPGEN], 1u);
            else XB_SPIN(xb_ld(&bar[XB_TOPGEN]) == tg, bar);
            __builtin_amdgcn_fence(__ATOMIC_ACQUIRE, "agent");
            xb_add(&bar[XB_XGEN(b.x)], 1u);
            asm volatile("s_waitcnt vmcnt(0)" ::: "memory");
        } else {
            XB_SPIN(xb_ld(&bar[XB_XGEN(b.x)]) == gen, bar);
            __builtin_amdgcn_fence(__ATOMIC_ACQUIRE, "agent");
            asm volatile("s_waitcnt vmcnt(0)" ::: "memory");
        }
    }
    __syncthreads();
}

__global__ void __launch_bounds__(512, 2) hawk_gdn_fwd(Args a) {
    extern __shared__ __attribute__((aligned(16))) unsigned char lds_raw[];
    LAS unsigned char* L = (LAS unsigned char*)lds_raw;
    cg::grid_group grid = cg::this_grid();
    volatile LAS unsigned* xst = (volatile LAS unsigned*)(L + LDS_BYTES - 64);
    if (threadIdx.x < 2) xst[threadIdx.x] = 0u;
    __syncthreads();
    (void)xcd_barrier_post((unsigned*)(a.ws + WS_BAR), xst);
    if (a.flags == 0x7fffffff) grid.sync();
    unsigned char* ws = a.ws;
    bf16_t* Z1 = (bf16_t*)(ws + WS_Z1); bf16_t* U = (bf16_t*)(ws + WS_U);
    const int lo = a.ph_lo, hi = a.ph_hi;
#ifndef PH_MASK
#define PH_MASK 0xff
#endif
#define IN(k) (((PH_MASK >> (k)) & 1) && lo <= (k) && (k) < hi)
#define SEAM(k) do { if (IN(k) && IN((k) + 1)) { XcdBarrier xb_; xb_.bar = (unsigned*)(a.ws + WS_BAR); xb_.x = xb_xcc_id(); xb_.st = (volatile LAS unsigned*)(L + LDS_BYTES - 64); xcd_barrier(xb_); } } while (0)
#ifndef REP0
#define REP0 1
#endif
#ifndef REP1
#define REP1 1
#endif
#ifndef REP6
#define REP6 1
#endif
    if (IN(0)) p0_prologue(a, L);
    SEAM(0);
    if (IN(1)) {
        pg8::Gemm g{U, (const bf16_t*)(ws + WS_W1T), NROWS, 4096, 1024, 1024}; pg8::StaticOrder S; S.init(NROWS, 4096, gridDim.x, blockIdx.x);
        pg8::Epi<0> E{Z1, (bf16_t*)(ws + WS_HALO), a.out};
        pg8::gemm_phase(L, g, S, E);
    }
    SEAM(1);
    if (IN(2)) p2_gdn_local(a, L, false);
    SEAM(2);
    if (IN(3)) p3_scans(a, L, false);
    SEAM(3);
    if (IN(4)) {
        pg8::Gemm g{U, (const bf16_t*)(ws + WS_W2T), NROWS, 2048, 1024, 1024}; pg8::StaticOrder S; S.init(NROWS, 2048, gridDim.x, blockIdx.x);
        pg8::Epi<1> E{Z1, nullptr, a.out};
        pg8::gemm_phase(L, g, S, E);
        if (blockIdx.x >= 32) {
            pg8::Gemm gm{U, (const bf16_t*)(ws + WS_W2T) + (size_t)(2048 + 1280) * 1024, NROWS, 768, 1024, 1024};
            pg8::StaticOrder Sm; Sm.init(NROWS, 768, gridDim.x - 32, blockIdx.x - 32);
            pg8::Epi<5> Em{nullptr, nullptr, (float*)((bf16_t*)a.out + 1280)};
            pg8::gemm_phase(L, gm, Sm, Em);
        }
    }
    SEAM(4);
    const int bid = blockIdx.x;
    const pg8::Gemm gA{Z1, (const bf16_t*)(ws + WS_WBL), NROWS, 1024, 1024, ZW};
    const pg8::Gemm gB{Z1 + 1024, (const bf16_t*)(ws + WS_WBG), NROWS, 1024, 1024, ZW};
    const pg8::Gemm gY{Z1 + 2048, (const bf16_t*)(ws + WS_WO), NROWS, 1024, 1024, ZW};
    const pg8::Epi<2> E2{Z1, nullptr, a.out}; const pg8::Epi<3> E3{Z1, nullptr, a.out}; const pg8::Epi<4> E4{Z1, nullptr, a.out};
    if (IN(5)) {
        const pg8::SeqOrder S{bid, 0, 1, 0};
        pg8::gemm_phase(L, gA, S, E2);
        pg8::gemm_phase(L, gB, S, E3);
    }
    SEAM(5);
    if (IN(6)) {
        if (bid < 16) { const pg8::SeqOrder S{bid, 0, 1, 1}; pg8::gemm_phase(L, gA, S, E2); pg8::gemm_phase(L, gB, S, E3); }
        else { const int d = bid - 16; const pg8::SeqOrder S{d, 240, (d < 16) ? 2 : 1, 0}; pg8::gemm_phase(L, gY, S, E4); }
    }
    SEAM(6);
    if (IN(7)) {
        if (bid < 16) { const pg8::SeqOrder S{bid, 0, 1, 1}; pg8::gemm_phase(L, gY, S, E4); }
        else p7_final(a, 0, NPROMPT, bid - 16, 240);
        { XcdBarrier xb_; xb_.bar = (unsigned*)(a.ws + WS_BAR); xb_.x = xb_xcc_id(); xb_.st = (volatile LAS unsigned*)(L + LDS_BYTES - 64); xcd_barrier(xb_); }
        p7_final(a, NPROMPT, NROWS, bid, 256);
    }
#undef IN
#undef SEAM
}

#ifndef N_LAUNCHES
#define N_LAUNCHES 1
#endif

extern "C" void kernel_launch(void* const* d_in, const int* in_sizes, int n_in, void* d_out, int out_size, void* d_ws, size_t ws_size, hipStream_t stream) {
    static int grid = 0;
    if (grid == 0) {
        if (n_in != 23 || ws_size < WS_END) { fprintf(stderr, "kernel_launch: unexpected inputs (n_in %d, ws %zu)\n", n_in, ws_size); grid = -1; return; }
        int dev = 0, cus = 0, per_cu = 0;
        hipGetDevice(&dev);
        hipDeviceGetAttribute(&cus, hipDeviceAttributeMultiprocessorCount, dev);
        if (hipFuncSetAttribute((const void*)hawk_gdn_fwd, hipFuncAttributeMaxDynamicSharedMemorySize, LDS_BYTES) != hipSuccess) { fprintf(stderr, "kernel_launch: hipFuncSetAttribute failed\n"); }
        if (hipOccupancyMaxActiveBlocksPerMultiprocessor(&per_cu, (const void*)hawk_gdn_fwd, 512, LDS_BYTES) != hipSuccess || per_cu < 1) { fprintf(stderr, "kernel_launch: occupancy query says %d\n", per_cu); per_cu = 1; }
        (void)hipGetLastError();
        grid = 256;
        if (grid <= 0) grid = 256;
    }
    if (grid < 0) return;
    if (hipMemsetAsync((char*)d_ws + WS_BAR, 0, 16384, stream) != hipSuccess) { fprintf(stderr, "kernel_launch: memset of barrier words failed\n"); return; }
    Args a{};
    for (int i = 0; i < 23; ++i) a.in[i] = (const float*)d_in[i];
    a.out = (float*)d_out; a.ws = (unsigned char*)d_ws;
#ifndef PLAN
#define PLAN {0, 8, 0}
#endif
    const int plan[] = PLAN;
    const int nl = (int)(sizeof(plan) / sizeof(int)) / 3;
    for (int li = 0; li < nl; ++li) {
        a.ph_lo = plan[3 * li]; a.ph_hi = plan[3 * li + 1]; a.flags = plan[3 * li + 2];
        void* args[] = {&a};
        hipError_t e = hipLaunchCooperativeKernel((const void*)hawk_gdn_fwd, dim3(grid), dim3(512), args, LDS_BYTES, stream);
        if (e != hipSuccess) { fprintf(stderr, "kernel_launch: cooperative launch failed: %s (grid %d)\n", hipGetErrorString(e), grid); break; }
    }
}
```

```cpp
#include <hip/hip_runtime.h>
#include <hip/hip_cooperative_groups.h>
#include <cstdio>
#include <cstdint>
namespace cg = cooperative_groups;

#define LAS __attribute__((address_space(3)))
typedef unsigned short bf16_t;
typedef short bf16x8 __attribute__((ext_vector_type(8)));
typedef short s16x4 __attribute__((ext_vector_type(4)));
typedef float f32x4 __attribute__((ext_vector_type(4)));
typedef unsigned u32x4 __attribute__((ext_vector_type(4)));
typedef unsigned u32x2 __attribute__((ext_vector_type(2)));

constexpr int DM = 1024, NROWS = 17408, NPROMPT = 16384, SEQ = 2048;
constexpr int ZW = 4096;
constexpr float EPS = 1e-6f;
constexpr size_t O_Y = 0, O_PLC = 17825792, O_PLH = 17850368, O_PGC = 17858560, O_PGS = 17932288,
                 O_SLC = 18980864, O_SLH = 19374080, O_SGC = 19505152, O_SGS = 20684800;
constexpr size_t MiB = 1u << 20;
constexpr size_t WS_W1T = 0, WS_W2T = 8 * MiB, WS_WBL = 16 * MiB, WS_WBG = 18 * MiB, WS_WO = 20 * MiB, WS_WA = 22 * MiB, WS_WX = 22 * MiB + 262144,
                 WS_BG = 23 * MiB, WS_GC = 25 * MiB, WS_HALO = 26 * MiB, WS_TINV = 31 * MiB, WS_AQK = 48 * MiB, WS_U = 65 * MiB, WS_Z1 = 99 * MiB, WS_BAR = 235 * MiB, WS_END = 236 * MiB;
constexpr int LDS_BYTES = 147456;

struct Args { const float* in[23]; float* out; unsigned char* ws; int ph_lo, ph_hi, flags, pad; };

typedef float f32x2_t __attribute__((ext_vector_type(2)));
typedef __bf16 bf16x2_t __attribute__((ext_vector_type(2)));
__device__ __forceinline__ unsigned cvt_pk_bf16(float lo, float hi) { f32x2_t v = {lo, hi}; bf16x2_t b = __builtin_convertvector(v, bf16x2_t); return __builtin_bit_cast(unsigned, b); }
__device__ __forceinline__ unsigned cvt_pk_bf16_asm(float lo, float hi) { unsigned r; asm volatile("v_cvt_pk_bf16_f32 %0, %1, %2" : "=v"(r) : "v"(lo), "v"(hi)); return r; }
__device__ __forceinline__ float bflo(unsigned w) { return __uint_as_float(w << 16); }
__device__ __forceinline__ float bfhi(unsigned w) { return __uint_as_float(w & 0xffff0000u); }
__device__ __forceinline__ float bf1(bf16_t b) { return __uint_as_float((unsigned)b << 16); }
__device__ __forceinline__ bf16_t f2bf(float f) { return (bf16_t)(cvt_pk_bf16(f, 0.f) & 0xffffu); }
__device__ __forceinline__ float sigmoidf_(float x) { return __builtin_amdgcn_rcpf(1.f + __expf(-x)); }
__device__ __forceinline__ float siluf_(float x) { return x * sigmoidf_(x); }
template <int CTRL> __device__ __forceinline__ float dpp_mov(float v) { return __int_as_float(__builtin_amdgcn_update_dpp(0, __float_as_int(v), CTRL, 0xF, 0xF, true)); }
__device__ __forceinline__ float row16_sum(float v) { v += dpp_mov<0xB1>(v); v += dpp_mov<0x4E>(v); v += dpp_mov<0x141>(v); v += dpp_mov<0x140>(v); return v; }
__device__ __forceinline__ float wave_sum(float v) {
    v = row16_sum(v);
    v += __shfl_xor(v, 16); v += __shfl_xor(v, 32);
    return v;
}
__device__ __forceinline__ void unpack8(const u32x4 w, float* f) {
    f[0] = bflo(w.x); f[1] = bfhi(w.x); f[2] = bflo(w.y); f[3] = bfhi(w.y); f[4] = bflo(w.z); f[5] = bfhi(w.z); f[6] = bflo(w.w); f[7] = bfhi(w.w);
}
__device__ __forceinline__ u32x4 pack8(const float* f) {
    u32x4 w; w.x = cvt_pk_bf16(f[0], f[1]); w.y = cvt_pk_bf16(f[2], f[3]); w.z = cvt_pk_bf16(f[4], f[5]); w.w = cvt_pk_bf16(f[6], f[7]); return w;
}
__device__ __forceinline__ bf16x8 pack_frag(const f32x4 a, const f32x4 b) {
    u32x4 w; w.x = cvt_pk_bf16(a[0], a[1]); w.y = cvt_pk_bf16(a[2], a[3]); w.z = cvt_pk_bf16(b[0], b[1]); w.w = cvt_pk_bf16(b[2], b[3]);
    return __builtin_bit_cast(bf16x8, w);
}
__device__ __forceinline__ bf16x8 lda_perm(const LAS bf16_t* rowp, int s, int fq, bool second) {
    if (second) return *(const LAS bf16x8*)(rowp + 32 * s + 8 * fq);
    const u32x2 lo = *(const LAS u32x2*)(rowp + 32 * s + 8 * fq);
    u32x4 w; w.x = lo.x; w.y = lo.y; w.z = 0u; w.w = 0u; return __builtin_bit_cast(bf16x8, w);
}
__device__ __forceinline__ void st_perm(LAS bf16_t* rowp, int ch, const u32x4 v) {
    const int c4 = ch & 3, f = 32 * (ch >> 2) + (c4 & 1) * 16 + (c4 >> 1) * 4;
    *(LAS u32x2*)(rowp + f) = (u32x2){v.x, v.y};
    *(LAS u32x2*)(rowp + f + 8) = (u32x2){v.z, v.w};
}
__device__ __forceinline__ s16x4 lds_tr(const LAS bf16_t* p) { return __builtin_bit_cast(s16x4, __builtin_amdgcn_ds_read_tr16_b64_v4i16((LAS s16x4*)p)); }

namespace pg8 {
constexpr int BM = 256, BK = 64, HALF = 128, HTB = HALF * BK * 2, STAGE_BYTES = 8 * HTB, NXCD = 8, WGM = 8;
__host__ __device__ __forceinline__ int lds_byte(int r, int c) { const int st = (r >> 4) * 2 + (c >> 5), rr = r & 15, cc = c & 31, ob = rr * 64 + cc * 2; return st * 1024 + (ob ^ (((ob >> 9) & 1) << 5)); }
__host__ __device__ __forceinline__ void stage_rc(int b, int& R, int& C) { const int st = b / 1024, sb = b % 1024, swz = sb ^ (((sb >> 9) & 1) << 5); R = (st >> 1) * 16 + swz / 64; C = (st & 1) * 32 + (swz % 64) / 2; }
__host__ __device__ __forceinline__ int perm32(int rho) { const int n = rho >> 4, i = rho & 15; return 8 * (i >> 2) + 4 * n + (i & 3); }
struct Unit { int pm, pn; };
struct Gemm { const bf16_t* A; const bf16_t* Bt; int M, N, K, lda; };
struct StaticOrder {
    int nM, nN, nwg, G, c;
    __device__ void init(int M, int N, int G_, int c_) { nM = M / BM; nN = N / BM; nwg = nM * nN; G = G_; c = c_; }
    __device__ bool next(int i, Unit& u) const {
        const long L = (long)i * G + c; if (L >= nwg) return false;
        int wgid = (int)L; { const int q = nwg / NXCD, r = nwg % NXCD, xcd = wgid % NXCD, off = wgid / NXCD; wgid = (xcd < r ? xcd * (q + 1) : r * (q + 1) + (xcd - r) * q) + off; }
        const int nig = WGM * nN, gid = wgid / nig, fm = gid * WGM, gsz = (nM - fm) < WGM ? (nM - fm) : WGM;
        u.pm = fm + ((wgid % nig) % gsz); u.pn = (wgid % nig) / gsz; return true;
    }
};
template <int MODE> struct Epi {
    static constexpr bool PERM = true;
    bf16_t* Z1; bf16_t* HALO; float* out;
    __device__ __forceinline__ void operator()(const f32x4 (&acc)[2][2][4][2], const Unit& u, int wr, int wc, int fr, int fq) const {
        const int col0 = u.pn * BM + wc * 32 + 8 * fq;
        if constexpr (MODE == 0 || MODE == 4 || MODE == 5) {
#pragma unroll
        for (int ai = 0; ai < 2; ++ai)
#pragma unroll
            for (int m = 0; m < 4; ++m) {
                const int row = u.pm * BM + ai * HALF + wr * 64 + m * 16 + fr;
                if constexpr (MODE == 0) {
                    bf16_t* rowp = Z1 + (size_t)row * ZW + col0;
                    const bool is_halo = (m == 3) && (fr >= 13) && (row < NPROMPT) && (u.pn >= 4);
                    int cs = -1; float* bl = nullptr; float* bg = nullptr;
                    if (row < NPROMPT) { const int t = row & (SEQ - 1); if (t >= SEQ - 3) { cs = t - (SEQ - 3); const int b = row >> 11; bl = out + O_PLC + (size_t)(b * 3 + cs) * 1024; bg = out + O_PGC + (size_t)(b * 3 + cs) * 3072; } }
                    else { const int t = row & 7; if (t >= 5) { cs = t - 5; const int s = (row - NPROMPT) >> 3; bl = out + O_SLC + (size_t)(s * 3 + cs) * 1024; bg = out + O_SGC + (size_t)(s * 3 + cs) * 3072; } }
#pragma unroll
                    for (int bj = 0; bj < 2; ++bj) {
                        const f32x4 v0 = acc[ai][bj][m][0], v1 = acc[ai][bj][m][1];
                        u32x4 w; w.x = cvt_pk_bf16(v0[0], v0[1]); w.y = cvt_pk_bf16(v0[2], v0[3]); w.z = cvt_pk_bf16(v1[0], v1[1]); w.w = cvt_pk_bf16(v1[2], v1[3]);
                        *(u32x4*)(rowp + bj * HALF) = w;
                        const int col = col0 + bj * HALF;
                        if (is_halo) *(u32x4*)(HALO + (size_t)((row >> 6) * 3 + (fr - 13)) * 3072 + (col - 1024)) = w;
                        if (cs >= 0) { float* d = (u.pn < 4) ? bl + col : bg + (col - 1024); *(f32x4*)d = v0; *(f32x4*)(d + 4) = v1; }
                    }
                } else if constexpr (MODE == 5) {
                    bf16_t* pp = (bf16_t*)out + (size_t)row * 2048 + col0;
#pragma unroll
                    for (int bj = 0; bj < 2; ++bj) {
                        const f32x4 v0 = acc[ai][bj][m][0], v1 = acc[ai][bj][m][1];
                        float o[8] = {v0[0], v0[1], v0[2], v0[3], v1[0], v1[1], v1[2], v1[3]};
#pragma unroll
                        for (int e = 0; e < 8; ++e) o[e] = sigmoidf_(o[e]);
                        *(u32x4*)(pp + bj * HALF) = pack8(o);
                    }
                } else {
                    float* rowp = out + (size_t)row * DM + col0;
#pragma unroll
                    for (int bj = 0; bj < 2; ++bj) { *(f32x4*)(rowp + bj * HALF) = acc[ai][bj][m][0]; *(f32x4*)(rowp + bj * HALF + 4) = acc[ai][bj][m][1]; }
                }
            }
        } else {
            const int cbase = (MODE == 1) ? col0 : 2048 + col0;
            const bool gate = (MODE == 1);
#pragma unroll
            for (int ai = 0; ai < 2; ++ai)
#pragma unroll
                for (int mh = 0; mh < 2; ++mh) {
                    u32x4 tv[2][2], sv[2][2];
#pragma unroll
                    for (int mm = 0; mm < 2; ++mm) {
                        const size_t rowi = (size_t)(u.pm * BM + ai * HALF + wr * 64 + (2 * mh + mm) * 16 + fr);
                        const bf16_t* rowp = Z1 + rowi * ZW + cbase;
                        const bf16_t* parkp = (const bf16_t*)out + rowi * 2048 + col0 + (MODE == 3 ? 1024 : 0);
#pragma unroll
                        for (int bj = 0; bj < 2; ++bj) {
                            if constexpr (MODE == 1) tv[mm][bj] = *(const u32x4*)(rowp + bj * HALF);
                            if constexpr (MODE == 2) tv[mm][bj] = *(const u32x4*)(parkp + bj * HALF);
                            if constexpr (MODE == 3) { tv[mm][bj] = *(const u32x4*)(rowp + bj * HALF); sv[mm][bj] = *(const u32x4*)(parkp + bj * HALF); }
                        }
                    }
#pragma unroll
                    for (int mm = 0; mm < 2; ++mm) {
                        const int m = 2 * mh + mm;
                        bf16_t* rowp = Z1 + (size_t)(u.pm * BM + ai * HALF + wr * 64 + m * 16 + fr) * ZW + cbase;
#pragma unroll
                        for (int bj = 0; bj < 2; ++bj) {
                            const f32x4 v0 = acc[ai][bj][m][0], v1 = acc[ai][bj][m][1];
                            float o[8] = {v0[0], v0[1], v0[2], v0[3], v1[0], v1[1], v1[2], v1[3]};
                            if constexpr (MODE == 1) {
                                if (gate) { float hf[8]; unpack8(tv[mm][bj], hf);
#pragma unroll
                                    for (int e = 0; e < 8; ++e) o[e] = siluf_(o[e]) * hf[e]; }
                                else {
#pragma unroll
                                    for (int e = 0; e < 8; ++e) o[e] = sigmoidf_(o[e]); }
                            } else if constexpr (MODE == 2) { float sf[8]; unpack8(tv[mm][bj], sf);
#pragma unroll
                                for (int e = 0; e < 8; ++e) o[e] *= sf[e];
                            } else { float tf[8], sf[8]; unpack8(tv[mm][bj], tf); unpack8(sv[mm][bj], sf);
#pragma unroll
                                for (int e = 0; e < 8; ++e) o[e] = tf[e] + sf[e] * o[e]; }
                            *(u32x4*)(rowp + bj * HALF) = pack8(o);
                        }
                    }
                }
        }
    }
};

struct SeqOrder {
    int base, step, n, smp;
    __device__ bool next(int i, Unit& u) const {
        if (i >= n) return false;
        const int t = base + i * step;
        if (smp == 2) { u.pm = 64 + (t >> 4); u.pn = t & 15; }
        else if (smp) { u.pm = 64 + (t >> 2); u.pn = t & 3; }
        else { u.pm = (t & 7) * 8 + ((t >> 3) >> 2); u.pn = (t >> 3) & 3; }
        return true;
    }
};
template <class EpiT, class SchedT>
__device__ __forceinline__ void gemm_phase(LAS unsigned char* lds, const Gemm g, const SchedT& S, const EpiT& E) {
    const int tid = threadIdx.x, wid = __builtin_amdgcn_readfirstlane(tid >> 6), lane = tid & 63, wr = wid >> 2, wc = wid & 3, fr = lane & 15, fq = lane >> 4;
    const int K = g.K, nt = K / BK, lda = g.lda;
    unsigned voffA[2], voffB[2];
#pragma unroll
    for (int i = 0; i < 2; ++i) { int R, C; stage_rc(tid * 16 + i * 8192, R, C); const int Rb = EpiT::PERM ? ((R & ~31) + perm32(R & 31)) : R;
        voffA[i] = (unsigned)(R * lda + C) * 2u; voffB[i] = (unsigned)(Rb * K + C) * 2u; }
    const size_t kstep = (size_t)(BK * 2);
    const size_t hsA = (size_t)HALF * lda * 2, hsB = (size_t)HALF * K * 2;
    const size_t tsA = 2 * hsA, tsB = 2 * hsB;
    const unsigned ldsw = (unsigned)wid * 1024u;
    const int aoff = lds_byte(wr * 64 + fr, fq * 8), boff = lds_byte(wc * 32 + fr, fq * 8);
#define PG8_SA(b, h) (((b) * 2 + (h)) * HTB)
#define PG8_SB(b, h) ((4 + (b) * 2 + (h)) * HTB)
#define PG8_STAGE(bufoff, gbase, voff) do { _Pragma("unroll") for (int _i = 0; _i < 2; ++_i) \
        __builtin_amdgcn_global_load_lds((const unsigned*)((const char*)(gbase) + (voff)[_i]), (LAS unsigned*)(lds + (bufoff) + ldsw + _i * 8192), 16, 0, 0); } while (0)
#define PG8_LDA(dst, b, h) do { _Pragma("unroll") for (int m = 0; m < 4; ++m) _Pragma("unroll") for (int k = 0; k < 2; ++k) dst[m][k] = *(const LAS bf16x8*)(lds + PG8_SA(b, h) + aoff + m * 2048 + k * 1024); } while (0)
#define PG8_LDB(dst, b, h) do { _Pragma("unroll") for (int n = 0; n < 2; ++n) _Pragma("unroll") for (int k = 0; k < 2; ++k) dst[n][k] = *(const LAS bf16x8*)(lds + PG8_SB(b, h) + boff + n * 2048 + k * 1024); } while (0)
#define PG8_MMA(ai, bj, At, Bt) do { __builtin_amdgcn_s_setprio(1); _Pragma("unroll") for (int m = 0; m < 4; ++m) _Pragma("unroll") for (int n = 0; n < 2; ++n) _Pragma("unroll") for (int k = 0; k < 2; ++k) \
        acc[ai][bj][m][n] = __builtin_amdgcn_mfma_f32_16x16x32_bf16(Bt[n][k], At[m][k], acc[ai][bj][m][n], 0, 0, 0); __builtin_amdgcn_s_setprio(0); } while (0)
#define PG8_WAIT_V(n) asm volatile("s_waitcnt vmcnt(" #n ")" ::: "memory")
#define PG8_WAIT_L(n) asm volatile("s_waitcnt lgkmcnt(" #n ")" ::: "memory")
#define PG8_BAR __builtin_amdgcn_s_barrier()
#define PG8_SCHED __builtin_amdgcn_sched_barrier(0)
    Unit cur, nxt; int ui = 0;
    if (!S.next(0, cur)) return;
    f32x4 acc[2][2][4][2];
#pragma unroll
    for (int a = 0; a < 2; ++a)
#pragma unroll
        for (int b = 0; b < 2; ++b)
#pragma unroll
            for (int m = 0; m < 4; ++m)
#pragma unroll
                for (int n = 0; n < 2; ++n) acc[a][b][m][n] = (f32x4){0.f, 0.f, 0.f, 0.f};
    bf16x8 At[4][2], B0[2][2], B1[2][2];
    const char* cA = (const char*)g.A + (size_t)cur.pm * tsA; const char* cB = (const char*)g.Bt + (size_t)cur.pn * tsB;
    PG8_STAGE(PG8_SB(0, 0), cB, voffB); PG8_STAGE(PG8_SB(0, 1), cB + hsB, voffB); PG8_STAGE(PG8_SA(0, 0), cA, voffA); PG8_STAGE(PG8_SA(0, 1), cA + hsA, voffA);
    if (wr == 1) PG8_BAR;
    PG8_WAIT_V(2); PG8_BAR;
    PG8_STAGE(PG8_SB(1, 0), cB + kstep, voffB); PG8_STAGE(PG8_SA(1, 0), cA + kstep, voffA); PG8_STAGE(PG8_SB(1, 1), cB + hsB + kstep, voffB);
    PG8_WAIT_V(6); PG8_BAR;
    for (;;) {
        const bool has_next = S.next(ui + 1, nxt);
        const char* nA = has_next ? (const char*)g.A + (size_t)nxt.pm * tsA : cA; const char* nB = has_next ? (const char*)g.Bt + (size_t)nxt.pn * tsB : cB;
        for (int t = 0; t < nt; t += 2) {
            const bool last = (t == nt - 2);
            const char* a1 = cA + (size_t)(t + 1) * kstep;
            const char* a2 = last ? nA : cA + (size_t)(t + 2) * kstep; const char* b2 = last ? nB : cB + (size_t)(t + 2) * kstep;
            const char* a3 = a2 + kstep; const char* b3 = b2 + kstep;
            PG8_LDB(B0, 0, 0); PG8_LDB(B1, 0, 1); PG8_SCHED; PG8_LDA(At, 0, 0); PG8_STAGE(PG8_SA(1, 1), a1 + hsA, voffA);
            PG8_WAIT_V(8); PG8_WAIT_L(0); PG8_BAR; PG8_MMA(0, 0, At, B0); PG8_MMA(0, 1, At, B1); PG8_BAR; PG8_SCHED;
            PG8_LDA(At, 0, 1); PG8_STAGE(PG8_SB(0, 0), b2, voffB); PG8_STAGE(PG8_SB(0, 1), b2 + hsB, voffB); PG8_STAGE(PG8_SA(0, 0), a2, voffA);
            PG8_WAIT_V(8); PG8_WAIT_L(0); PG8_BAR; PG8_MMA(1, 0, At, B0); PG8_MMA(1, 1, At, B1); PG8_BAR; PG8_SCHED;
            PG8_LDB(B0, 1, 0); PG8_LDB(B1, 1, 1); PG8_SCHED; PG8_LDA(At, 1, 0); PG8_STAGE(PG8_SA(0, 1), a2 + hsA, voffA);
            PG8_WAIT_V(8); PG8_WAIT_L(0); PG8_BAR; PG8_MMA(0, 0, At, B0); PG8_MMA(0, 1, At, B1); PG8_BAR; PG8_SCHED;
            PG8_LDA(At, 1, 1); PG8_STAGE(PG8_SB(1, 0), b3, voffB); PG8_STAGE(PG8_SB(1, 1), b3 + hsB, voffB); PG8_STAGE(PG8_SA(1, 0), a3, voffA);
            PG8_WAIT_V(8); PG8_WAIT_L(0); PG8_BAR; PG8_MMA(1, 0, At, B0); PG8_MMA(1, 1, At, B1); PG8_BAR; PG8_SCHED;
        }
        if (wr == 0) PG8_BAR;
        E(acc, cur, wr, wc, fr, fq);
        if (!has_next) break;
#pragma unroll
        for (int a = 0; a < 2; ++a)
#pragma unroll
            for (int b = 0; b < 2; ++b)
#pragma unroll
                for (int m = 0; m < 4; ++m)
#pragma unroll
                    for (int n = 0; n < 2; ++n) acc[a][b][m][n] = (f32x4){0.f, 0.f, 0.f, 0.f};
        cur = nxt; cA = nA; cB = nB; ++ui;
        if (wr == 1) PG8_BAR;
    }
    PG8_WAIT_V(0);
    PG8_BAR;
#undef PG8_SA
#undef PG8_SB
#undef PG8_STAGE
#undef PG8_LDA
#undef PG8_LDB
#undef PG8_MMA
#undef PG8_WAIT_V
#undef PG8_WAIT_L
#undef PG8_BAR
#undef PG8_SCHED
}
}

__device__ __forceinline__ void transpose_item(const float* W, int ldw, int src_col, bf16_t* WTrow, int k0, int lane) {
#pragma unroll
    for (int hf = 0; hf < 2; ++hf) {
        float v[32];
#pragma unroll
        for (int kk = 0; kk < 32; ++kk) v[kk] = W[(size_t)(k0 + hf * 32 + kk) * ldw + src_col + lane];
#pragma unroll
        for (int q = 0; q < 4; ++q) { u32x4 w; w.x = cvt_pk_bf16_asm(v[8 * q], v[8 * q + 1]); w.y = cvt_pk_bf16_asm(v[8 * q + 2], v[8 * q + 3]); w.z = cvt_pk_bf16_asm(v[8 * q + 4], v[8 * q + 5]); w.w = cvt_pk_bf16_asm(v[8 * q + 6], v[8 * q + 7]);
            *(u32x4*)(WTrow + k0 + hf * 32 + 8 * q) = w; }
    }
}
__device__ __forceinline__ void p0_prologue(const Args& a, LAS unsigned char* L) {
    const int tid = threadIdx.x, lane = tid & 63, wave = tid >> 6;
    const int gw = blockIdx.x * 8 + wave, NGW = gridDim.x * 8;
    unsigned char* ws = a.ws;
    const float* w_in = a.in[8];
    for (int it = gw; it < 2880; it += NGW) {
        if (it < 2048) {
            const int which = it >> 10, r = it & 1023, nb = r >> 4, kb = r & 15, n0 = nb * 64;
            int src;
            if (which == 0) src = (n0 < 1024) ? n0 : n0 + 1024;
            else src = (n0 < 1024) ? 1024 + n0 : (n0 < 2048) ? 5120 + (n0 - 1024) : (n0 < 3072) ? 6160 + (n0 - 2048) : 7184 + (n0 - 3072);
            bf16_t* WT = (bf16_t*)(ws + (which ? WS_W2T : WS_W1T));
            transpose_item(w_in, 8208, src, WT + (size_t)(n0 + lane) * 1024, kb * 64, lane);
        } else if (it < 2816) {
            const int r = it - 2048, which = r >> 8, q = r & 255, nb = q >> 4, kb = q & 15;
            const float* W = which == 0 ? a.in[20] : which == 1 ? a.in[21] : a.in[22];
            bf16_t* WT = (bf16_t*)(ws + (which == 0 ? WS_WBL : which == 1 ? WS_WBG : WS_WO));
            transpose_item(W, 1024, nb * 64, WT + (size_t)(nb * 64 + lane) * 1024, kb * 64, lane);
        } else {
            const int r = it - 2816, which = r >> 5, q = r & 31, g = q >> 2, nb = (q >> 1) & 1, kb = q & 1;
            const float* W = (which == 0 ? a.in[11] : a.in[13]) + (size_t)g * 16384;
            bf16_t* WT = (bf16_t*)(ws + (which == 0 ? WS_WA : WS_WX)) + (size_t)g * 16384;
            transpose_item(W, 128, nb * 64, WT + (size_t)(nb * 64 + lane) * 128, kb * 64, lane);
        }
    }
    LAS float* wT = (LAS float*)L;
    for (int idx = tid; idx < 16384; idx += 512) { const int k = idx >> 4, c = idx & 15; wT[c * 1024 + k] = w_in[(size_t)k * 8208 + 6144 + c]; }
    __syncthreads();
    const float* x_p = a.in[0]; const float* x_s = a.in[1]; const float* gain = a.in[6];
    bf16_t* U = (bf16_t*)(ws + WS_U); float* BG = (float*)(ws + WS_BG);
    f32x4 gn[4];
#pragma unroll
    for (int j = 0; j < 4; ++j) gn[j] = ((const f32x4*)gain)[lane + 64 * j];
    for (int m = gw; m < NROWS; m += NGW) {
        const float* xr = (m < NPROMPT) ? x_p + (size_t)m * DM : x_s + (size_t)(m - NPROMPT) * DM;
        f32x4 v[4]; float s = 0.f;
#pragma unroll
        for (int j = 0; j < 4; ++j) { v[j] = ((const f32x4*)xr)[lane + 64 * j]; s += (v[j].x * v[j].x + v[j].y * v[j].y) + (v[j].z * v[j].z + v[j].w * v[j].w); }
        const float rs = rsqrtf(wave_sum(s) * (1.f / DM) + EPS);
#pragma unroll
        for (int j = 0; j < 4; ++j) { v[j] = v[j] * rs * gn[j];
            u32x2 o; o.x = cvt_pk_bf16(v[j].x, v[j].y); o.y = cvt_pk_bf16(v[j].z, v[j].w);
            ((u32x2*)(U + (size_t)m * DM))[lane + 64 * j] = o; }
        float mine = 0.f;
#pragma unroll 1
        for (int c0 = 0; c0 < 16; c0 += 4) {
            float p[4];
#pragma unroll
            for (int cc = 0; cc < 4; ++cc) {
                p[cc] = 0.f;
#pragma unroll
                for (int j = 0; j < 4; ++j) { const f32x4 w = ((const LAS f32x4*)(wT + (c0 + cc) * 1024))[lane + 64 * j]; p[cc] += (v[j].x * w.x + v[j].y * w.y) + (v[j].z * w.z + v[j].w * w.w); }
            }
#pragma unroll
            for (int cc = 0; cc < 4; ++cc) p[cc] = row16_sum(p[cc]);
#pragma unroll
            for (int cc = 0; cc < 4; ++cc) p[cc] += __shfl_xor(p[cc], 16);
#pragma unroll
            for (int cc = 0; cc < 4; ++cc) p[cc] += __shfl_xor(p[cc], 32);
#pragma unroll
            for (int cc = 0; cc < 4; ++cc) if (lane == c0 + cc) mine = p[cc];
        }
        if (lane < 8) BG[(size_t)m * 16 + lane] = 1.f / (1.f + expf(-mine));
        else if (lane < 16) { const int h = lane - 8; const float xx = mine + a.in[18][h]; const float sp = xx > 20.f ? xx : log1pf(expf(xx)); BG[(size_t)m * 16 + lane] = -expf(a.in[17][h]) * sp; }
    }
}

#ifndef DRY_SKIP
#define DRY_SKIP 0
#endif
__device__ __forceinline__ void p2_gdn_local(const Args& a, LAS unsigned char* L, const bool dry, const int u0, const int ustep, const int un) {
    const int tid = threadIdx.x, lane = tid & 63, wave = __builtin_amdgcn_readfirstlane(tid >> 6), fr = lane & 15, fq = lane >> 4;
    LAS bf16_t* QS = (LAS bf16_t*)(L);
    LAS bf16_t* KS = (LAS bf16_t*)(L + 17408);
    LAS float* MS = (LAS float*)(L + 52224);
    LAS bf16_t* AS = (LAS bf16_t*)(L + 68864);
    LAS bf16_t* TS = (LAS bf16_t*)(L + 78080);
    LAS float* GCS = (LAS float*)(L + 87296);
    LAS float* BES = (LAS float*)(L + 87552);
    LAS bf16_t* RAW = (LAS bf16_t*)(L + 87808);
    LAS float* CW = (LAS float*)(L + 140336);
    LAS bf16_t* SH = (LAS bf16_t*)(L + 52224);
    bf16_t* Z1 = (bf16_t*)(a.ws + WS_Z1); const bf16_t* HALO = (const bf16_t*)(a.ws + WS_HALO);
    const float* BG = (const float*)(a.ws + WS_BG); float* GC = (float*)(a.ws + WS_GC);
    bf16_t* TINV = (bf16_t*)(a.ws + WS_TINV); bf16_t* AQK = (bf16_t*)(a.ws + WS_AQK);
    const float* st_gc = a.in[4]; const float* cw = a.in[16];
    u32x4 nr[7];
    int zo[7], lo[7];
#pragma unroll
    for (int k = 0; k < 7; ++k) {
        int q = tid + 512 * k; if (q > 3215) q = 3215;
        const int rr = q / 48, rem = q - rr * 48;
        zo[k] = (rr >= 3 ? rr - 3 : 0) * ZW + (rem >> 4) * 1024 + (rem & 15) * 8;
        lo[k] = rr * 392 + rem * 8;
    }
    const int rr0 = tid / 48;
    const int ho0 = rr0 * 3072 + ((tid - rr0 * 48) >> 4) * 1024 + ((tid - rr0 * 48) & 15) * 8;
    auto prefetch = [&](int u) {
        const int grp = u >> 3, h = u & 7; const bool smp = grp >= 256; const bool nohalo = smp || ((grp & 31) == 0);
        const bf16_t* zb = Z1 + (size_t)grp * 64 * ZW + 1024 + h * 128;
#pragma unroll
        for (int k = 0; k < 7; ++k) {
            const bf16_t* src = zb + zo[k];
            if (k == 0 && rr0 < 3 && !nohalo) src = HALO + (size_t)(grp - 1) * 3 * 3072 + h * 128 + ho0;
            u32x4 v = *(const u32x4*)src;
            if (k == 0 && rr0 < 3 && nohalo) v = (u32x4){0u, 0u, 0u, 0u};
            nr[k] = v;
        }
    };
    int hprev = -1;
    if (un > 0) prefetch(u0);
    for (int ui = 0; ui < un; ++ui) {
        const int u = u0 + ui * ustep;
        const int grp = u >> 3, h = u & 7; const bool smp = grp >= 256; const int row0 = grp * 64;
        const int t = tid >> 3, p = tid & 7;
        __syncthreads();
#pragma unroll
        for (int k = 0; k < 7; ++k) {
            const int q = tid + 512 * k;
            if (q < 3216) *(LAS u32x4*)(RAW + lo[k]) = nr[k];
        }
        if (h != hprev) {
#pragma unroll
            for (int k = 0; k < 3; ++k) { const int idx = tid + 512 * k, i = idx / 384, c = idx - i * 384; CW[idx] = cw[(size_t)i * 3072 + (c >> 7) * 1024 + h * 128 + (c & 127)]; }
            hprev = h;
        }
        if (smp) {
            for (int idx = tid; idx < 9216; idx += 512) { const int sr = idx / 384, c = idx - sr * 384;
                SH[sr * 392 + c] = f2bf(st_gc[(size_t)((grp - 256) * 24 + sr) * 3072 + (c >> 7) * 1024 + h * 128 + (c & 127)]); }
        }
        if (tid < 64) {
            float g = BG[(size_t)(row0 + tid) * 16 + 8 + h]; const float be = BG[(size_t)(row0 + tid) * 16 + h];
            const int li = smp ? (tid & 7) : tid;
#pragma unroll
            for (int d = 1; d < 64; d <<= 1) { const float o = __shfl_up(g, d); if (li >= d) g += o; }
            GCS[tid] = g; BES[tid] = be; GC[(size_t)(row0 + tid) * 8 + h] = g;
        }
        __syncthreads();
        if (ui + 1 < un) prefetch(u + ustep);
#pragma unroll 1
        for (int seg = (dry && (DRY_SKIP & 4)) ? 3 : 0; seg < 3; ++seg) {
            float av[16];
#pragma unroll
            for (int e = 0; e < 16; ++e) av[e] = 0.f;
#pragma unroll
            for (int i = 0; i < 4; ++i) {
                const int ts8 = (t & 7) - 3 + i;
                const LAS bf16_t* rp = (smp && ts8 < 0) ? SH + ((t >> 3) * 3 + ts8 + 3) * 392 : RAW + (t + i) * 392;
                rp += seg * 128 + 16 * p;
                float xv[16];
                const u32x4 w0 = *(const LAS u32x4*)rp, w1 = *(const LAS u32x4*)(rp + 8); unpack8(w0, xv); unpack8(w1, xv + 8);
                const LAS float* wp = CW + i * 384 + seg * 128 + 16 * p;
#pragma unroll
                for (int q = 0; q < 4; ++q) { const f32x4 f = *(const LAS f32x4*)(wp + 4 * q); av[4 * q] += f.x * xv[4 * q]; av[4 * q + 1] += f.y * xv[4 * q + 1]; av[4 * q + 2] += f.z * xv[4 * q + 2]; av[4 * q + 3] += f.w * xv[4 * q + 3]; }
            }
            float ss = 0.f;
#pragma unroll
            for (int e = 0; e < 16; ++e) { av[e] = siluf_(av[e]); ss += av[e] * av[e]; }
            ss += __shfl_xor(ss, 1); ss += __shfl_xor(ss, 2); ss += __shfl_xor(ss, 4);
            const float rs = (seg == 2) ? 1.f : rsqrtf(ss + EPS) * (seg == 0 ? 0.08838834764831845f : 1.f);
#pragma unroll
            for (int e = 0; e < 16; ++e) av[e] *= rs;
            LAS bf16_t* d = QS + seg * 8704 + t * 136 + 16 * p;
            *(LAS u32x4*)d = pack8(av); *(LAS u32x4*)(d + 8) = pack8(av + 8);
        }
        __syncthreads();
        if (!dry)
#pragma unroll
        for (int q = 0; q < 6; ++q) {
            const int idx = tid + 512 * q, seg = idx >> 10, r = (idx >> 4) & 63, ch = idx & 15;
            *(u32x4*)(Z1 + (size_t)(row0 + r) * ZW + 1024 + seg * 1024 + h * 128 + ch * 8) = *(const LAS u32x4*)(QS + seg * 8704 + r * 136 + ch * 8);
        }
        if (!(dry && (DRY_SKIP & 2)))
        {
            const int sel = wave >> 2, ti = wave & 3;
            const LAS bf16_t* XA = sel ? QS : KS;
            bf16x8 af[4], bfr[4][4]; float gi[4], bi[4], gj[4];
#pragma unroll
            for (int ks = 0; ks < 4; ++ks) af[ks] = *(const LAS bf16x8*)(XA + (16 * ti + fr) * 136 + 32 * ks + 8 * fq);
#pragma unroll
            for (int tj = 0; tj < 4; ++tj) {
                gj[tj] = GCS[16 * tj + fr];
#pragma unroll
                for (int ks = 0; ks < 4; ++ks) bfr[tj][ks] = *(const LAS bf16x8*)(KS + (16 * tj + fr) * 136 + 32 * ks + 8 * fq);
            }
#pragma unroll
            for (int r = 0; r < 4; ++r) { gi[r] = GCS[16 * ti + 4 * fq + r]; bi[r] = BES[16 * ti + 4 * fq + r]; }
            __builtin_amdgcn_sched_barrier(0);
            f32x4 acc[4];
#pragma unroll
            for (int tj = 0; tj < 4; ++tj) {
                acc[tj] = (f32x4){0.f, 0.f, 0.f, 0.f};
                if (tj <= ti) {
#pragma unroll
                    for (int ks = 0; ks < 4; ++ks) acc[tj] = __builtin_amdgcn_mfma_f32_16x16x32_bf16(af[ks], bfr[tj][ks], acc[tj], 0, 0, 0);
                }
            }
            float ov[4][4];
#pragma unroll
            for (int tj = 0; tj < 4; ++tj)
#pragma unroll
                for (int r = 0; r < 4; ++r) {
                    const int i = 16 * ti + 4 * fq + r, j = 16 * tj + fr;
                    const bool same = smp ? ((i >> 3) == (j >> 3)) : true;
                    const float e = __expf(fminf(gi[r] - gj[tj], 0.f));
                    const bool keep = same && (sel == 0 ? (i > j) : (i >= j));
                    ov[tj][r] = keep ? (sel == 0 ? bi[r] : 1.f) * acc[tj][r] * e : 0.f;
                }
            if (sel == 0) {
#pragma unroll
                for (int tj = 0; tj < 4; ++tj)
#pragma unroll
                    for (int r = 0; r < 4; ++r) MS[(16 * ti + 4 * fq + r) * 65 + 16 * tj + fr] = ov[tj][r];
            } else {
#pragma unroll
                for (int tj = 0; tj < 4; ++tj)
#pragma unroll
                    for (int r = 0; r < 4; ++r) AS[(16 * ti + 4 * fq + r) * 72 + 16 * tj + fr] = f2bf(ov[tj][r]);
            }
        }
        __syncthreads();
        if (!(dry && (DRY_SKIP & 1)))
        {
            float mrow[64];
#pragma unroll
            for (int j = 0; j < 64; ++j) mrow[j] = MS[lane * 65 + j];
            float X[8];
#pragma unroll
            for (int cc = 0; cc < 8; ++cc) X[cc] = (lane == 8 * cc + wave) ? 1.f : 0.f;
#pragma unroll
            for (int j = 0; j < 64; ++j) {
                float sv[8];
#pragma unroll
                for (int cc = 0; cc < 8; ++cc) sv[cc] = (8 * cc <= j) ? __uint_as_float(__builtin_amdgcn_readlane(__float_as_uint(X[cc]), j)) : 0.f;
                const float nm = -mrow[j];
#pragma unroll
                for (int cc = 0; cc < 8; ++cc) if (8 * cc <= j) X[cc] = fmaf(nm, sv[cc], X[cc]);
            }
#pragma unroll
            for (int cc = 0; cc < 8; ++cc) TS[lane * 72 + 8 * cc + wave] = f2bf(X[cc]);
        }
        __syncthreads();
        {
            const int r = tid >> 3, ch = tid & 7;
            const size_t o = ((size_t)u * 64 + r) * 64 + ch * 8;
            *(u32x4*)(TINV + o) = *(const LAS u32x4*)(TS + r * 72 + ch * 8);
            *(u32x4*)(AQK + o) = *(const LAS u32x4*)(AS + r * 72 + ch * 8);
        }
    }
    __syncthreads();
}

__device__ __forceinline__ u32x4 gdn_norm8(const u32x4 o8, const LAS float* part8, const LAS float* nw8) {
    const f32x4 p0 = *(const LAS f32x4*)part8, p1 = *(const LAS f32x4*)(part8 + 4);
    const float tot = ((p0[0] + p0[1]) + (p0[2] + p0[3])) + ((p1[0] + p1[1]) + (p1[2] + p1[3]));
    const float rs = rsqrtf(tot * (1.f / 128.f) + EPS);
    float f[8]; unpack8(o8, f);
#pragma unroll
    for (int e = 0; e < 8; ++e) f[e] = f[e] * rs * nw8[e];
    return pack8(f);
}

template <int MT>
__device__ __forceinline__ void gdn_scan_unit(const Args& a, LAS unsigned char* L, int sq, int h, const bool dry) {
    constexpr bool SMP = (MT == 1);
    constexpr int NR = MT * 16, NS2 = (MT + 1) / 2, NV = SMP ? 8 : 64;
    constexpr int BUFB = 71168;
    const int tid = threadIdx.x, lane = tid & 63, wave = __builtin_amdgcn_readfirstlane(tid >> 6), fr = lane & 15, fq = lane >> 4;
    LAS float* OSS = (LAS float*)(L + 2 * BUFB);
    bf16_t* Z1 = (bf16_t*)(a.ws + WS_Z1);
    const float* BG = (const float*)(a.ws + WS_BG); const float* GC = (const float*)(a.ws + WS_GC);
    const bf16_t* TINV = (const bf16_t*)(a.ws + WS_TINV); const bf16_t* AQK = (const bf16_t*)(a.ws + WS_AQK);
    const int dv = 16 * wave + fr;
    LAS float* NWS = (LAS float*)(L + 2 * BUFB + 2048);
    if (tid < 128) NWS[tid] = a.in[19][tid];
    const LAS float* nw8 = NWS + (tid & 15) * 8;
    f32x4 S[8];
    if (SMP) {
        const float* S0 = a.in[5] + (size_t)(sq * 8 + h) * 16384;
#pragma unroll
        for (int dt = 0; dt < 8; ++dt)
#pragma unroll
            for (int r = 0; r < 4; ++r) S[dt][r] = S0[(size_t)(16 * dt + 4 * fq + r) * 128 + dv];
    } else {
#pragma unroll
        for (int dt = 0; dt < 8; ++dt) S[dt] = (f32x4){0.f, 0.f, 0.f, 0.f};
    }
    const int nch = SMP ? 1 : 32;
    const int o8 = SMP ? (sq & 7) * 8 : 0;
    u32x4 pk[6], pt[2]; float pg = 0.f, pb = 0.f;
    auto load_chunk = [&](int c) {
        const int rowc = SMP ? NPROMPT + sq * 8 : sq * SEQ + 64 * c;
        const int grp = SMP ? 256 + (sq >> 3) : (sq * 32 + c);
#pragma unroll
        for (int q = 0; q < 2; ++q) {
            const int idx = tid + 512 * q, r = idx >> 4, ch = idx & 15;
            const bool ok = SMP ? ((idx < NR * 16) && (r < NV)) : true;
            const int rcl = ok ? r : 0;
#pragma unroll
            for (int seg = 0; seg < 3; ++seg) {
                u32x4 v = *(const u32x4*)(Z1 + (size_t)(rowc + rcl) * ZW + 1024 + seg * 1024 + h * 128 + ch * 8);
                if (!ok) v = (u32x4){0u, 0u, 0u, 0u};
                pk[q * 3 + seg] = v;
            }
        }
        {
            const int r = tid >> 3, ch = tid & 7;
            bool ok; size_t o;
            if (SMP) { ok = (r < 8) && (ch == 0); o = ((size_t)(grp * 8 + h) * 64 + o8 + (ok ? r : 0)) * 64 + o8; }
            else { ok = true; o = ((size_t)(grp * 8 + h) * 64 + r) * 64 + ch * 8; }
            u32x4 v0 = *(const u32x4*)(TINV + o), v1 = *(const u32x4*)(AQK + o);
            if (!ok) { v0 = (u32x4){0u, 0u, 0u, 0u}; v1 = v0; }
            pt[0] = v0; pt[1] = v1;
        }
        if (tid < 64) { const bool ok = tid < NV; const int tc = ok ? tid : 0; pg = GC[(size_t)(rowc + tc) * 8 + h]; pb = BG[(size_t)(rowc + tc) * 16 + h]; if (!ok) { pg = 0.f; pb = 0.f; } }
    };
    auto write_chunk = [&](LAS unsigned char* B) {
        LAS bf16_t* KSb = (LAS bf16_t*)(B); LAS bf16_t* QSb = (LAS bf16_t*)(B + 17408); LAS bf16_t* VSb = (LAS bf16_t*)(B + 34816);
        LAS bf16_t* TSb = (LAS bf16_t*)(B + 52224); LAS bf16_t* ASb = (LAS bf16_t*)(B + 61440);
#pragma unroll
        for (int q = 0; q < 2; ++q) {
            const int idx = tid + 512 * q, r = idx >> 4, ch = idx & 15;
            if (idx < NR * 16) {
                st_perm(QSb + r * 136, ch, pk[q * 3 + 0]);
                st_perm(KSb + r * 136, ch, pk[q * 3 + 1]);
                *(LAS u32x4*)(VSb + r * 136 + ch * 8) = pk[q * 3 + 2];
            }
        }
        { const int r = tid >> 3, ch = tid & 7; if (r < NR) { st_perm(TSb + r * 72, ch, pt[0]); st_perm(ASb + r * 72, ch, pt[1]); } }
        if (tid < 64) { ((LAS float*)(B + 70656))[tid] = pg; ((LAS float*)(B + 70912))[tid] = pb; }
    };
    load_chunk(0);
    write_chunk(L);
    if (nch > 1) load_chunk(1);
#define SB_ __builtin_amdgcn_sched_barrier(0)
    for (int c = 0; c < nch; ++c) {
        const int rowc = SMP ? NPROMPT + sq * 8 : sq * SEQ + 64 * c;
        LAS unsigned char* B = L + (c & 1) * BUFB;
        LAS unsigned char* Bo = L + ((c & 1) ^ 1) * BUFB;
        LAS bf16_t* KS = (LAS bf16_t*)(B); LAS bf16_t* QS = (LAS bf16_t*)(B + 17408); LAS bf16_t* VS = (LAS bf16_t*)(B + 34816);
        LAS bf16_t* TS = (LAS bf16_t*)(B + 52224); LAS bf16_t* AS = (LAS bf16_t*)(B + 61440);
        LAS float* GCS = (LAS float*)(B + 70656); LAS float* BES = (LAS float*)(B + 70912);
        __syncthreads();
        if (c > 0 && !dry) {
            const LAS bf16_t* OSo = (const LAS bf16_t*)(Bo + 17408);
#pragma unroll
            for (int q = 0; q < 2; ++q) {
                const int idx = tid + 512 * q, r = idx >> 4, ch = idx & 15;
                *(u32x4*)(Z1 + (size_t)(rowc - 64 + r) * ZW + 1024 + h * 128 + ch * 8) = gdn_norm8(*(const LAS u32x4*)(OSo + r * 136 + ch * 8), OSS + r * 8, nw8);
            }
        }

        const float gl = GCS[NV - 1];
        bf16x8 Sb[4];
#pragma unroll
        for (int s = 0; s < 4; ++s) Sb[s] = pack_frag(S[2 * s], S[2 * s + 1]);
        f32x4 R[MT], P[MT];
#pragma unroll
        for (int mt = 0; mt < MT; ++mt) {
            bf16x8 fk[4];
#pragma unroll
            for (int s = 0; s < 4; ++s) fk[s] = lda_perm(KS + (16 * mt + fr) * 136, s, fq, true);
            SB_;
            R[mt] = (f32x4){0.f, 0.f, 0.f, 0.f}; P[mt] = (f32x4){0.f, 0.f, 0.f, 0.f};
#pragma unroll
            for (int s = 0; s < 4; ++s) R[mt] = __builtin_amdgcn_mfma_f32_16x16x32_bf16(fk[s], Sb[s], R[mt], 0, 0, 0);
            SB_;
#pragma unroll
            for (int s = 0; s < 4; ++s) fk[s] = lda_perm(QS + (16 * mt + fr) * 136, s, fq, true);
            SB_;
#pragma unroll
            for (int s = 0; s < 4; ++s) P[mt] = __builtin_amdgcn_mfma_f32_16x16x32_bf16(fk[s], Sb[s], P[mt], 0, 0, 0);
            SB_;
        }
        __syncthreads();
        if (c + 1 < nch) write_chunk(Bo);
        SB_;
#pragma unroll
        for (int m0 = 0; m0 < MT; m0 += 2) {
            float gi_[2][4], vi_[2][4], bi_[2][4];
#pragma unroll
            for (int mm = 0; mm < 2; ++mm) if (m0 + mm < MT) {
#pragma unroll
                for (int r = 0; r < 4; ++r) { const int i = 16 * (m0 + mm) + 4 * fq + r; gi_[mm][r] = GCS[i]; bi_[mm][r] = BES[i]; vi_[mm][r] = bf1(VS[i * 136 + dv]); }
            }
            SB_;
#pragma unroll
            for (int mm = 0; mm < 2; ++mm) if (m0 + mm < MT) {
#pragma unroll
                for (int r = 0; r < 4; ++r) {
                    const float e = __expf(gi_[mm][r]);
                    R[m0 + mm][r] = bi_[mm][r] * (vi_[mm][r] - e * R[m0 + mm][r]);
                    P[m0 + mm][r] *= e;
                }
            }
            SB_;
        }
        bf16x8 rb[NS2];
#pragma unroll
        for (int s2 = 0; s2 < NS2; ++s2) rb[s2] = pack_frag(R[2 * s2], (2 * s2 + 1 < MT) ? R[(2 * s2 + 1 < MT) ? 2 * s2 + 1 : 0] : (f32x4){0.f, 0.f, 0.f, 0.f});
        f32x4 Vn[MT];
#pragma unroll
        for (int m0 = 0; m0 < MT; m0 += 2) {
            bf16x8 ft[2][NS2];
#pragma unroll
            for (int mm = 0; mm < 2; ++mm) if (m0 + mm < MT) {
#pragma unroll
                for (int s2 = 0; s2 < NS2; ++s2) ft[mm][s2] = lda_perm(TS + (16 * (m0 + mm) + fr) * 72, s2, fq, 2 * s2 + 1 < MT);
            }
            SB_;
#pragma unroll
            for (int mm = 0; mm < 2; ++mm) if (m0 + mm < MT) {
                Vn[m0 + mm] = (f32x4){0.f, 0.f, 0.f, 0.f};
#pragma unroll
                for (int s2 = 0; s2 < NS2; ++s2) Vn[m0 + mm] = __builtin_amdgcn_mfma_f32_16x16x32_bf16(ft[mm][s2], rb[s2], Vn[m0 + mm], 0, 0, 0);
            }
            SB_;
        }
        const int q4 = fr >> 2, p4 = fr & 3;
        bf16x8 fs[1][2][NS2];
        auto ld_tr = [&](int set, int dt) {
#pragma unroll
            for (int s2 = 0; s2 < NS2; ++s2) {
                const s16x4 lo = lds_tr(KS + (32 * s2 + 4 * fq + q4) * 136 + 32 * (dt >> 1) + 8 * p4 + 4 * (dt & 1));
                s16x4 hi = (s16x4){0, 0, 0, 0};
                if (2 * s2 + 1 < MT) hi = lds_tr(KS + (32 * s2 + 16 + 4 * fq + q4) * 136 + 32 * (dt >> 1) + 8 * p4 + 4 * (dt & 1));
                bf16x8 af; af[0] = lo[0]; af[1] = lo[1]; af[2] = lo[2]; af[3] = lo[3]; af[4] = hi[0]; af[5] = hi[1]; af[6] = hi[2]; af[7] = hi[3];
                fs[set][dt & 1][s2] = af;
            }
        };
        bf16x8 vb[NS2], vdb[NS2];
#pragma unroll
        for (int s2 = 0; s2 < NS2; ++s2) {
            const int m1 = (2 * s2 + 1 < MT) ? 2 * s2 + 1 : 0;
            const f32x4 z = (f32x4){0.f, 0.f, 0.f, 0.f};
            vb[s2] = pack_frag(Vn[2 * s2], (2 * s2 + 1 < MT) ? Vn[m1] : z);
            f32x4 d0, d1;
#pragma unroll
            for (int r = 0; r < 4; ++r) { d0[r] = Vn[2 * s2][r] * __expf(gl - GCS[32 * s2 + 4 * fq + r]); d1[r] = (2 * s2 + 1 < MT) ? Vn[m1][r] * __expf(gl - GCS[32 * s2 + 16 + 4 * fq + r]) : 0.f; }
            vdb[s2] = pack_frag(d0, d1);
        }
#pragma unroll
        for (int m0 = 0; m0 < MT; m0 += 2) {
            bf16x8 fa2[2][NS2];
#pragma unroll
            for (int mm = 0; mm < 2; ++mm) if (m0 + mm < MT) {
#pragma unroll
                for (int s2 = 0; s2 < NS2; ++s2) fa2[mm][s2] = lda_perm(AS + (16 * (m0 + mm) + fr) * 72, s2, fq, 2 * s2 + 1 < MT);
            }
            SB_;
#pragma unroll
            for (int mm = 0; mm < 2; ++mm) if (m0 + mm < MT) {
#pragma unroll
                for (int s2 = 0; s2 < NS2; ++s2) P[m0 + mm] = __builtin_amdgcn_mfma_f32_16x16x32_bf16(fa2[mm][s2], vb[s2], P[m0 + mm], 0, 0, 0);
            }
            SB_;
        }
        {
            const float eg = __expf(gl);
#pragma unroll
            for (int d0 = 0; d0 < 8; d0 += 2) {
                ld_tr(0, d0); ld_tr(0, d0 + 1);
                SB_;
#pragma unroll
                for (int dt = d0; dt < d0 + 2; ++dt) {
                    S[dt] = S[dt] * eg;
#pragma unroll
                    for (int s2 = 0; s2 < NS2; ++s2) S[dt] = __builtin_amdgcn_mfma_f32_16x16x32_bf16(fs[0][dt & 1][s2], vdb[s2], S[dt], 0, 0, 0);
                }
                SB_;
            }
        }
#pragma unroll
        for (int mt = 0; mt < MT; ++mt) {
            f32x4 qv;
#pragma unroll
            for (int r = 0; r < 4; ++r) { qv[r] = row16_sum(P[mt][r] * P[mt][r]); QS[(16 * mt + 4 * fq + r) * 136 + dv] = f2bf(P[mt][r]); }
            if (fr < 4) OSS[(16 * mt + 4 * fq + fr) * 8 + wave] = (fr == 0) ? qv[0] : (fr == 1) ? qv[1] : (fr == 2) ? qv[2] : qv[3];
        }
        if (c + 2 < nch) load_chunk(c + 2);
    }
#undef SB_
    __syncthreads();
    {
        const int rowl = SMP ? NPROMPT + sq * 8 : sq * SEQ + 64 * (nch - 1);
        const LAS bf16_t* OSl = (const LAS bf16_t*)(L + ((nch - 1) & 1) * BUFB + 17408);
#pragma unroll
        for (int q = 0; q < 2; ++q) {
            const int idx = tid + 512 * q, r = idx >> 4, ch = idx & 15;
            if (idx < NR * 16 && r < NV && !dry) *(u32x4*)(Z1 + (size_t)(rowl + r) * ZW + 1024 + h * 128 + ch * 8) = gdn_norm8(*(const LAS u32x4*)(OSl + r * 136 + ch * 8), OSS + r * 8, nw8);
        }
    }
    float* So = a.out + (SMP ? O_SGS : O_PGS) + (size_t)(sq * 8 + h) * 16384;
#pragma unroll
    for (int dt = 0; dt < 8; ++dt)
#pragma unroll
        for (int r = 0; r < 4; ++r) So[(size_t)(16 * dt + 4 * fq + r) * 128 + dv] = S[dt][r];
    __syncthreads();
}

__device__ __forceinline__ void lru_unit(const Args& a, LAS unsigned char* L, bool smp, int bidx, int g, const bool dry) {
    const int tid = threadIdx.x, lane = tid & 63, wave = __builtin_amdgcn_readfirstlane(tid >> 6), fr = lane & 15, fq = lane >> 4;
    LAS float* XC = (LAS float*)(L);
    LAS bf16_t* XB = (LAS bf16_t*)(L + 33792);
    LAS bf16_t* HS = (LAS bf16_t*)(L + 51200);
    LAS bf16_t* RW = (LAS bf16_t*)(L + 68608);
    LAS bf16_t* SH = (LAS bf16_t*)(L + 86832);
    LAS float* CWL = (LAS float*)(L + 93360);
    bf16_t* Z1 = (bf16_t*)(a.ws + WS_Z1);
    const bf16_t* WAT = (const bf16_t*)(a.ws + WS_WA) + (size_t)g * 16384;
    const bf16_t* WXT = (const bf16_t*)(a.ws + WS_WX) + (size_t)g * 16384;
    const float* cw = a.in[9]; const float* cb = a.in[10];
    const int c = 16 * wave + fr, col = g * 128 + c;
    const float ba = a.in[12][col], bx = a.in[14][col];
    const float al = a.in[15][col];
    const float ls = -(al > 0.f ? log1pf(expf(-al)) : (log1pf(expf(al)) - al));
    bf16x8 Bwa[4], Bwx[4];
#pragma unroll
    for (int ks = 0; ks < 4; ++ks) { Bwa[ks] = *(const bf16x8*)(WAT + (size_t)c * 128 + 32 * ks + 8 * fq); Bwx[ks] = *(const bf16x8*)(WXT + (size_t)c * 128 + 32 * ks + 8 * fq); }
    const int ntile = smp ? 1 : 32;
    float carry = 0.f;
    const int t = tid >> 3, p = tid & 7, cc0 = 16 * p, gc0 = g * 128 + cc0;
    for (int idx = tid; idx < 640; idx += 512) { const int i = idx >> 7, cc = idx & 127; CWL[idx] = (i < 4) ? cw[(size_t)i * 1024 + g * 128 + cc] : cb[g * 128 + cc]; }
    if (smp) { for (int idx = tid; idx < 3072; idx += 512) { const int sr = idx >> 7, cc = idx & 127; SH[sr * 136 + cc] = f2bf(a.in[2][(size_t)(bidx * 24 + sr) * 1024 + g * 128 + cc]); } }
    const int row00 = smp ? NPROMPT + bidx * 64 : bidx * SEQ;
    u32x4 nx0 = *(const u32x4*)(Z1 + (size_t)(row00 + t) * ZW + gc0), nx1 = *(const u32x4*)(Z1 + (size_t)(row00 + t) * ZW + gc0 + 8);
    u32x4 pv0 = (u32x4){0u, 0u, 0u, 0u}, pv1 = pv0;
    for (int j = 0; j < ntile; ++j) {
        const int rowt = row00 + 64 * j;
        __syncthreads();
        if (j > 0 && !dry) {
#pragma unroll
            for (int q = 0; q < 2; ++q) {
                const int idx = tid + 512 * q, r = idx >> 4, ch = idx & 15;
                *(u32x4*)(Z1 + (size_t)(rowt - 64 + r) * ZW + g * 128 + ch * 8) = *(const LAS u32x4*)(HS + r * 136 + ch * 8);
            }
        }
        *(LAS u32x4*)(RW + (3 + t) * 136 + cc0) = nx0; *(LAS u32x4*)(RW + (3 + t) * 136 + cc0 + 8) = nx1;
        if (t >= 61) { *(LAS u32x4*)(RW + (t - 61) * 136 + cc0) = pv0; *(LAS u32x4*)(RW + (t - 61) * 136 + cc0 + 8) = pv1; }
        pv0 = nx0; pv1 = nx1;
        __syncthreads();
        if (j + 1 < ntile) { nx0 = *(const u32x4*)(Z1 + (size_t)(rowt + 64 + t) * ZW + gc0); nx1 = *(const u32x4*)(Z1 + (size_t)(rowt + 64 + t) * ZW + gc0 + 8); }
        {
            float y[16];
#pragma unroll
            for (int q = 0; q < 4; ++q) { const f32x4 f = *(const LAS f32x4*)(CWL + 512 + cc0 + 4 * q); y[4 * q] = f.x; y[4 * q + 1] = f.y; y[4 * q + 2] = f.z; y[4 * q + 3] = f.w; }
#pragma unroll
            for (int i = 0; i < 4; ++i) {
                const int ts8 = (t & 7) - 3 + i;
                const LAS bf16_t* rp = ((smp && ts8 < 0) ? SH + ((t >> 3) * 3 + ts8 + 3) * 136 : RW + (t + i) * 136) + cc0;
                float xv[16];
                const u32x4 w0 = *(const LAS u32x4*)rp, w1 = *(const LAS u32x4*)(rp + 8); unpack8(w0, xv); unpack8(w1, xv + 8);
#pragma unroll
                for (int q = 0; q < 4; ++q) { const f32x4 f = *(const LAS f32x4*)(CWL + i * 128 + cc0 + 4 * q); y[4 * q] += f.x * xv[4 * q]; y[4 * q + 1] += f.y * xv[4 * q + 1]; y[4 * q + 2] += f.z * xv[4 * q + 2]; y[4 * q + 3] += f.w * xv[4 * q + 3]; }
            }
#pragma unroll
            for (int q = 0; q < 4; ++q) *(LAS f32x4*)(XC + t * 132 + cc0 + 4 * q) = (f32x4){y[4 * q], y[4 * q + 1], y[4 * q + 2], y[4 * q + 3]};
            *(LAS u32x4*)(XB + t * 136 + cc0) = pack8(y); *(LAS u32x4*)(XB + t * 136 + cc0 + 8) = pack8(y + 8);
        }
        __syncthreads();
        f32x4 R[4], I[4];
#pragma unroll
        for (int mt = 0; mt < 4; ++mt) {
            bf16x8 fx[4];
#pragma unroll
            for (int ks = 0; ks < 4; ++ks) fx[ks] = *(const LAS bf16x8*)(XB + (16 * mt + fr) * 136 + 32 * ks + 8 * fq);
            __builtin_amdgcn_sched_barrier(0);
            R[mt] = (f32x4){0.f, 0.f, 0.f, 0.f}; I[mt] = (f32x4){0.f, 0.f, 0.f, 0.f};
#pragma unroll
            for (int ks = 0; ks < 4; ++ks) {
                R[mt] = __builtin_amdgcn_mfma_f32_16x16x32_bf16(fx[ks], Bwa[ks], R[mt], 0, 0, 0);
                I[mt] = __builtin_amdgcn_mfma_f32_16x16x32_bf16(fx[ks], Bwx[ks], I[mt], 0, 0, 0);
            }
            __builtin_amdgcn_sched_barrier(0);
        }
        float xc_[4][4];
#pragma unroll
        for (int mt = 0; mt < 4; ++mt)
#pragma unroll
            for (int r = 0; r < 4; ++r) xc_[mt][r] = XC[(16 * mt + 4 * fq + r) * 132 + c];
        __builtin_amdgcn_sched_barrier(0);
        float av[4][4], bv[4][4], Al[4], Bl[4];
#pragma unroll
        for (int mt = 0; mt < 4; ++mt) {
            Al[mt] = 1.f; Bl[mt] = 0.f;
#pragma unroll
            for (int r = 0; r < 4; ++r) {
                const int i = 16 * mt + 4 * fq + r;
                const float rr = sigmoidf_(R[mt][r] + ba);
                const float ig = sigmoidf_(I[mt][r] + bx);
                const float la = 8.f * rr * ls;
                float aa = __expf(la), mult = sqrtf(fmaxf(fmaf(-aa, aa, 1.f), 0.f));
                if (!smp && j == 0 && i == 0) { aa = 0.f; mult = 1.f; }
                av[mt][r] = aa; bv[mt][r] = mult * ig * xc_[mt][r];
                Bl[mt] = aa * Bl[mt] + bv[mt][r]; Al[mt] *= aa;
            }
        }
        float Ag[4][4], Bg[4][4];
#pragma unroll
        for (int mt = 0; mt < 4; ++mt)
#pragma unroll
            for (int q = 0; q < 4; ++q) { Ag[mt][q] = __shfl(Al[mt], fr + 16 * q); Bg[mt][q] = __shfl(Bl[mt], fr + 16 * q); }
        float h0v[4] = {0.f, 0.f, 0.f, 0.f};
        if (smp) {
#pragma unroll
            for (int mt = 0; mt < 4; ++mt) h0v[mt] = a.in[3][(size_t)(bidx * 8 + 2 * mt + (fq >> 1)) * 1024 + col];
        }
#pragma unroll
        for (int mt = 0; mt < 4; ++mt) {
            float hin;
            if (smp) {
                hin = h0v[mt];
                const float A_ = (fq == 1) ? Ag[mt][0] : Ag[mt][2], B_ = (fq == 1) ? Bg[mt][0] : Bg[mt][2];
                hin = (fq & 1) ? A_ * hin + B_ : hin;
            } else {
                hin = carry;
#pragma unroll
                for (int q = 0; q < 3; ++q) hin = (q < fq) ? Ag[mt][q] * hin + Bg[mt][q] : hin;
#pragma unroll
                for (int q = 0; q < 4; ++q) carry = Ag[mt][q] * carry + Bg[mt][q];
            }
#pragma unroll
            for (int r = 0; r < 4; ++r) { hin = av[mt][r] * hin + bv[mt][r]; HS[(16 * mt + 4 * fq + r) * 136 + c] = f2bf(hin); }
            if (smp) { if (fq & 1) a.out[O_SLH + (size_t)(bidx * 8 + 2 * mt + (fq >> 1)) * 1024 + col] = hin; }
            else if (j == ntile - 1 && mt == 3 && fq == 3) a.out[O_PLH + (size_t)bidx * 1024 + col] = hin;
        }
    }
    __syncthreads();
    {
        const int rowl = row00 + 64 * (ntile - 1);
#pragma unroll
        for (int q = 0; q < 2; ++q) {
            const int idx = tid + 512 * q, r = idx >> 4, ch = idx & 15;
            if (!dry) *(u32x4*)(Z1 + (size_t)(rowl + r) * ZW + g * 128 + ch * 8) = *(const LAS u32x4*)(HS + r * 136 + ch * 8);
        }
    }
    __syncthreads();
}

#define XB_TMO      128
#define XB_XCNT(j)  (256  + 64 * (j))
#define XB_XSUB(j)  (1280 + 64 * (j))
#define XB_XGEN(j)  (2304 + 64 * (j))
#define XB_TOP      3328
#define XB_TOPGEN   3392
#define XCD_BAR_WORDS 3456
#define XB_SPIN_CAP (1u << 22)
__device__ __forceinline__ unsigned xb_ld(unsigned* p)              { return __hip_atomic_load(p, __ATOMIC_RELAXED, __HIP_MEMORY_SCOPE_AGENT); }
__device__ __forceinline__ unsigned xb_add(unsigned* p, unsigned v) { return __hip_atomic_fetch_add(p, v, __ATOMIC_RELAXED, __HIP_MEMORY_SCOPE_AGENT); }
__device__ __forceinline__ unsigned xb_xcc_id() { return (unsigned)__builtin_amdgcn_s_getreg((3 << 11) | 20) & 0xFu; }
#define XB_SPIN(cond, bar) do { unsigned _sp = 0; while (cond) { __builtin_amdgcn_s_sleep(1); \
    if ((++_sp & 255u) == 0u) { if (xb_ld(&(bar)[XB_TMO])) break; if (_sp > XB_SPIN_CAP) { atomicAdd(&(bar)[XB_TMO], 1u); break; } } } } while (0)
struct XcdBarrier { unsigned* bar; unsigned x; volatile LAS unsigned* st; unsigned G; };
__device__ __forceinline__ XcdBarrier xcd_barrier_post(unsigned* bar, volatile LAS unsigned* st) {
    XcdBarrier b; b.bar = bar; b.x = xb_xcc_id(); b.st = st; b.G = 0u;
    if (threadIdx.x == 0) (void)xb_add(&bar[XB_XCNT(b.x)], 1u);
    return b;
}
__device__ __forceinline__ void xcd_barrier_complete(unsigned* bar, unsigned x, unsigned& nloc, unsigned& nx, const unsigned G) {
    unsigned sum, cnt, mine, sp = 0u;
    for (;;) {
        sum = 0u; cnt = 0u; mine = 0u;
#pragma unroll
        for (unsigned j = 0; j < 16; ++j) { const unsigned c = xb_ld(&bar[XB_XCNT(j)]); sum += c; cnt += (c > 0u) ? 1u : 0u; mine = (j == x) ? c : mine; }
        if (sum == G) break;
        __builtin_amdgcn_s_sleep(1);
        if ((++sp & 255u) == 0u) { if (xb_ld(&bar[XB_TMO])) break; if (sp > XB_SPIN_CAP) { atomicAdd(&bar[XB_TMO], 1u); break; } }
    }
    nloc = mine > 0u ? mine : 1u; nx = cnt > 0u ? cnt : 1u;
}
__device__ __forceinline__ void xcd_barrier(const XcdBarrier& b) {
    asm volatile("s_waitcnt vmcnt(0)" ::: "memory");
    __syncthreads();
    if (threadIdx.x == 0) {
        unsigned* bar = b.bar;
        __builtin_amdgcn_s_waitcnt(0);
        unsigned nloc = b.st[0], nx = b.st[1];
        if (nloc == 0u) { xcd_barrier_complete(bar, b.x, nloc, nx, b.G); b.st[0] = nloc; b.st[1] = nx; }
        const unsigned old = xb_add(&bar[XB_XSUB(b.x)], 1u);
        const unsigned gen = old / nloc;
        if (old + 1u == (gen + 1u) * nloc) {
            __builtin_amdgcn_fence(__ATOMIC_RELEASE, "agent");
            asm volatile("s_waitcnt vmcnt(0)" ::: "memory");
            const unsigned og = xb_add(&bar[XB_TOP], 1u);
            const unsigned tg = og / nx;
            if (og + 1u == (tg + 1u) * nx) xb_add(&bar[XB_TOPGEN], 1u);
            else XB_SPIN(xb_ld(&bar[XB_TOPGEN]) == tg, bar);
            __builtin_amdgcn_fence(__ATOMIC_ACQUIRE, "agent");
            xb_add(&bar[XB_XGEN(b.x)], 1u);
            asm volatile("s_waitcnt vmcnt(0)" ::: "memory");
        } else {
            XB_SPIN(xb_ld(&bar[XB_XGEN(b.x)]) == gen, bar);
            __builtin_amdgcn_fence(__ATOMIC_ACQUIRE, "agent");
            asm volatile("s_waitcnt vmcnt(0)" ::: "memory");
        }
    }
    __syncthreads();
}

#ifndef DRY3_SKIP
#define DRY3_SKIP 0
#endif
__device__ __forceinline__ void p3_scans(const Args& a, LAS unsigned char* L, const bool dry) {
    if (!(dry && (DRY3_SKIP & 1))) for (int u = blockIdx.x; u < 64; u += gridDim.x) gdn_scan_unit<4>(a, L, u >> 3, u & 7, dry);
    if (!(dry && (DRY3_SKIP & 2))) for (int u = blockIdx.x; u < 128; u += gridDim.x) if (u >= 64) lru_unit(a, L, false, (u - 64) >> 3, (u - 64) & 7, dry);
    if (gridDim.x >= 256) {
        const int nb = gridDim.x - 128, b = blockIdx.x - 128;
        if (b >= 0) {
#define SUBBAR() do { XcdBarrier xb_; xb_.bar = (unsigned*)(a.ws + WS_BAR) + 4096; xb_.x = xb_xcc_id(); xb_.st = (volatile LAS unsigned*)(L + LDS_BYTES - 56); xb_.G = 128u; xcd_barrier(xb_); } while (0)
            if (b < 64) {
                const pg8::Gemm g1{(const bf16_t*)(a.ws + WS_U), (const bf16_t*)(a.ws + WS_W1T), NROWS, 4096, 1024, 1024};
                const pg8::Epi<0> E1{(bf16_t*)(a.ws + WS_Z1), (bf16_t*)(a.ws + WS_HALO), a.out};
                const pg8::SeqOrder S1{b, 0, 1, 2};
                pg8::gemm_phase(L, g1, S1, E1);
            }
            SUBBAR();
            p2_gdn_local(a, L, false, 2048 + b, 128, 1);
            SUBBAR();
#undef SUBBAR
            if (!(dry && (DRY3_SKIP & 8))) for (int u = b; u < 128; u += nb) lru_unit(a, L, true, u >> 3, u & 7, dry);
            if (!(dry && (DRY3_SKIP & 4))) for (int u = b; u < 1024; u += nb) gdn_scan_unit<1>(a, L, u >> 3, u & 7, dry);
            pg8::Gemm gm{(const bf16_t*)(a.ws + WS_U), (const bf16_t*)(a.ws + WS_W2T) + (size_t)2048 * 1024, NROWS, 1280, 1024, 1024};
            pg8::StaticOrder Sm; Sm.init(NROWS, 1280, nb, b);
            pg8::Epi<5> Em{nullptr, nullptr, a.out};
            pg8::gemm_phase(L, gm, Sm, Em);
        }
    } else {
        {
            pg8::Gemm gm{(const bf16_t*)(a.ws + WS_U), (const bf16_t*)(a.ws + WS_W2T) + (size_t)2048 * 1024, NROWS, 1280, 1024, 1024};
            pg8::StaticOrder Sm; Sm.init(NROWS, 1280, gridDim.x, blockIdx.x);
            pg8::Epi<5> Em{nullptr, nullptr, a.out};
            pg8::gemm_phase(L, gm, Sm, Em);
        }
        for (int u = blockIdx.x; u < 1152; u += gridDim.x) if (u >= 128) gdn_scan_unit<1>(a, L, (u - 128) >> 3, (u - 128) & 7, dry);
        for (int u = blockIdx.x; u < 1280; u += gridDim.x) if (u >= 1152) lru_unit(a, L, true, (u - 1152) >> 3, (u - 1152) & 7, dry);
    }
}

__device__ __forceinline__ void p7_final(const Args& a, const int row_lo, const int row_hi, const int wblk, const int nblk) {
    const int tid = threadIdx.x, lane = tid & 63, wave = tid >> 6;
    const int gw = row_lo + wblk * 8 + wave, NGW = nblk * 8;
    const float* gain = a.in[7];
    f32x4 gn[4];
#pragma unroll
    for (int j = 0; j < 4; ++j) gn[j] = ((const f32x4*)gain)[lane + 64 * j];
    for (int m = gw; m < row_hi; m += NGW) {
        const float* xr = (m < NPROMPT) ? a.in[0] + (size_t)m * DM : a.in[1] + (size_t)(m - NPROMPT) * DM;
        float* yr = a.out + (size_t)m * DM;
        f32x4 v[4]; float s = 0.f;
#pragma unroll
        for (int j = 0; j < 4; ++j) { v[j] = ((const f32x4*)yr)[lane + 64 * j]; s += (v[j].x * v[j].x + v[j].y * v[j].y) + (v[j].z * v[j].z + v[j].w * v[j].w); }
        const float rs = rsqrtf(wave_sum(s) * (1.f / DM) + EPS);
#pragma unroll
        for (int j = 0; j < 4; ++j) { const f32x4 x = ((const f32x4*)xr)[lane + 64 * j]; ((f32x4*)yr)[lane + 64 * j] = x + v[j] * rs * gn[j]; }
    }
}


__global__ void __launch_bounds__(512, 2) hawk_gdn_fwd(Args a) {
    extern __shared__ __attribute__((aligned(16))) unsigned char lds_raw[];
    LAS unsigned char* L = (LAS unsigned char*)lds_raw;
    cg::grid_group grid = cg::this_grid();
    volatile LAS unsigned* xst = (volatile LAS unsigned*)(L + LDS_BYTES - 64);
    if (threadIdx.x < 4) xst[threadIdx.x] = 0u;
    __syncthreads();
    (void)xcd_barrier_post((unsigned*)(a.ws + WS_BAR), xst);
    if (blockIdx.x >= 128) (void)xcd_barrier_post((unsigned*)(a.ws + WS_BAR) + 4096, xst + 2);
    if (a.flags == 0x7fffffff) grid.sync();
    unsigned char* ws = a.ws;
    bf16_t* Z1 = (bf16_t*)(ws + WS_Z1); bf16_t* U = (bf16_t*)(ws + WS_U);
    const int lo = a.ph_lo, hi = a.ph_hi;
#ifndef PH_MASK
#define PH_MASK 0xff
#endif
#define IN(k) (((PH_MASK >> (k)) & 1) && lo <= (k) && (k) < hi)
#define SEAM(k) do { if (IN(k) && IN((k) + 1)) { XcdBarrier xb_; xb_.bar = (unsigned*)(a.ws + WS_BAR); xb_.x = xb_xcc_id(); xb_.st = (volatile LAS unsigned*)(L + LDS_BYTES - 64); xb_.G = gridDim.x; xcd_barrier(xb_); } } while (0)
#ifndef REP0
#define REP0 1
#endif
#ifndef REP1
#define REP1 1
#endif
#ifndef REP6
#define REP6 1
#endif
    if (IN(0)) p0_prologue(a, L);
    SEAM(0);
    if (IN(1)) {
        pg8::Gemm g{U, (const bf16_t*)(ws + WS_W1T), NROWS, 4096, 1024, 1024}; pg8::StaticOrder S; S.init(NPROMPT, 4096, gridDim.x, blockIdx.x);
        pg8::Epi<0> E{Z1, (bf16_t*)(ws + WS_HALO), a.out};
        pg8::gemm_phase(L, g, S, E);
    }
    SEAM(1);
    if (IN(2)) p2_gdn_local(a, L, false, blockIdx.x, 256, 8);
    SEAM(2);
    if (IN(3)) p3_scans(a, L, false);
    SEAM(3);
    if (IN(4)) {
        pg8::Gemm g{U, (const bf16_t*)(ws + WS_W2T), NROWS, 2048, 1024, 1024}; pg8::StaticOrder S; S.init(NROWS, 2048, gridDim.x, blockIdx.x);
        pg8::Epi<1> E{Z1, nullptr, a.out};
        pg8::gemm_phase(L, g, S, E);
        if (blockIdx.x >= 32) {
            pg8::Gemm gm{U, (const bf16_t*)(ws + WS_W2T) + (size_t)(2048 + 1280) * 1024, NROWS, 768, 1024, 1024};
            pg8::StaticOrder Sm; Sm.init(NROWS, 768, gridDim.x - 32, blockIdx.x - 32);
            pg8::Epi<5> Em{nullptr, nullptr, (float*)((bf16_t*)a.out + 1280)};
            pg8::gemm_phase(L, gm, Sm, Em);
        }
    }
    SEAM(4);
    const int bid = blockIdx.x;
    const pg8::Gemm gA{Z1, (const bf16_t*)(ws + WS_WBL), NROWS, 1024, 1024, ZW};
    const pg8::Gemm gB{Z1 + 1024, (const bf16_t*)(ws + WS_WBG), NROWS, 1024, 1024, ZW};
    const pg8::Gemm gY{Z1 + 2048, (const bf16_t*)(ws + WS_WO), NROWS, 1024, 1024, ZW};
    const pg8::Epi<2> E2{Z1, nullptr, a.out}; const pg8::Epi<3> E3{Z1, nullptr, a.out}; const pg8::Epi<4> E4{Z1, nullptr, a.out};
    if (IN(5)) {
        const pg8::SeqOrder S{bid, 0, 1, 0};
        pg8::gemm_phase(L, gA, S, E2);
        pg8::gemm_phase(L, gB, S, E3);
    }
    SEAM(5);
    if (IN(6)) {
        if (bid < 16) { const pg8::SeqOrder S{bid, 0, 1, 1}; pg8::gemm_phase(L, gA, S, E2); pg8::gemm_phase(L, gB, S, E3); }
        else { const int d = bid - 16; const pg8::SeqOrder S{d, 240, (d < 16) ? 2 : 1, 0}; pg8::gemm_phase(L, gY, S, E4); }
    }
    SEAM(6);
    if (IN(7)) {
        if (bid < 16) { const pg8::SeqOrder S{bid, 0, 1, 1}; pg8::gemm_phase(L, gY, S, E4); }
        else p7_final(a, 0, NPROMPT, bid - 16, 240);
        { XcdBarrier xb_; xb_.bar = (unsigned*)(a.ws + WS_BAR); xb_.x = xb_xcc_id(); xb_.st = (volatile LAS unsigned*)(L + LDS_BYTES - 64); xb_.G = gridDim.x; xcd_barrier(xb_); }
        p7_final(a, NPROMPT, NROWS, bid, 256);
    }
#undef IN
#undef SEAM
}

#ifndef N_LAUNCHES
#define N_LAUNCHES 1
#endif

extern "C" void kernel_launch(void* const* d_in, const int* in_sizes, int n_in, void* d_out, int out_size, void* d_ws, size_t ws_size, hipStream_t stream) {
    static int grid = 0;
    if (grid == 0) {
        if (n_in != 23 || ws_size < WS_END) { fprintf(stderr, "kernel_launch: unexpected inputs (n_in %d, ws %zu)\n", n_in, ws_size); grid = -1; return; }
        int dev = 0, cus = 0, per_cu = 0;
        hipGetDevice(&dev);
        hipDeviceGetAttribute(&cus, hipDeviceAttributeMultiprocessorCount, dev);
        if (hipFuncSetAttribute((const void*)hawk_gdn_fwd, hipFuncAttributeMaxDynamicSharedMemorySize, LDS_BYTES) != hipSuccess) { fprintf(stderr, "kernel_launch: hipFuncSetAttribute failed\n"); }
        if (hipOccupancyMaxActiveBlocksPerMultiprocessor(&per_cu, (const void*)hawk_gdn_fwd, 512, LDS_BYTES) != hipSuccess || per_cu < 1) { fprintf(stderr, "kernel_launch: occupancy query says %d\n", per_cu); per_cu = 1; }
        (void)hipGetLastError();
        grid = 256;
        if (grid <= 0) grid = 256;
    }
    if (grid < 0) return;
    if (hipMemsetAsync((char*)d_ws + WS_BAR, 0, 32768, stream) != hipSuccess) { fprintf(stderr, "kernel_launch: memset of barrier words failed\n"); return; }
    Args a{};
    for (int i = 0; i < 23; ++i) a.in[i] = (const float*)d_in[i];
    a.out = (float*)d_out; a.ws = (unsigned char*)d_ws;
#ifndef PLAN
#define PLAN {0, 8, 0}
#endif
    const int plan[] = PLAN;
    const int nl = (int)(sizeof(plan) / sizeof(int)) / 3;
    for (int li = 0; li < nl; ++li) {
        a.ph_lo = plan[3 * li]; a.ph_hi = plan[3 * li + 1]; a.flags = plan[3 * li + 2];
        void* args[] = {&a};
        hipError_t e = hipLaunchCooperativeKernel((const void*)hawk_gdn_fwd, dim3(grid), dim3(512), args, LDS_BYTES, stream);
        if (e != hipSuccess) { fprintf(stderr, "kernel_launch: cooperative launch failed: %s (grid %d)\n", hipGetErrorString(e), grid); break; }
    }
}
```

```cpp
#include <hip/hip_runtime.h>
#include <hip/hip_cooperative_groups.h>
#include <cstdio>
#include <cstdint>
namespace cg = cooperative_groups;

#define LAS __attribute__((address_space(3)))
typedef unsigned short bf16_t;
typedef short bf16x8 __attribute__((ext_vector_type(8)));
typedef short s16x4 __attribute__((ext_vector_type(4)));
typedef float f32x4 __attribute__((ext_vector_type(4)));
typedef unsigned u32x4 __attribute__((ext_vector_type(4)));
typedef unsigned u32x2 __attribute__((ext_vector_type(2)));

constexpr int DM = 1024, NROWS = 17408, NPROMPT = 16384, SEQ = 2048;
constexpr int ZW = 4096;
constexpr float EPS = 1e-6f;
constexpr size_t O_Y = 0, O_PLC = 17825792, O_PLH = 17850368, O_PGC = 17858560, O_PGS = 17932288,
                 O_SLC = 18980864, O_SLH = 19374080, O_SGC = 19505152, O_SGS = 20684800;
constexpr size_t MiB = 1u << 20;
constexpr size_t WS_W1T = 0, WS_W2T = 8 * MiB, WS_WBL = 16 * MiB, WS_WBG = 18 * MiB, WS_WO = 20 * MiB, WS_WA = 22 * MiB, WS_WX = 22 * MiB + 262144,
                 WS_BG = 23 * MiB, WS_GC = 25 * MiB, WS_HALO = 26 * MiB, WS_TINV = 31 * MiB, WS_AQK = 48 * MiB, WS_U = 65 * MiB, WS_Z1 = 99 * MiB, WS_BAR = 235 * MiB, WS_END = 236 * MiB;
constexpr int LDS_BYTES = 147456;

struct Args { const float* in[23]; float* out; unsigned char* ws; int ph_lo, ph_hi, flags, pad; };

typedef float f32x2_t __attribute__((ext_vector_type(2)));
typedef __bf16 bf16x2_t __attribute__((ext_vector_type(2)));
__device__ __forceinline__ unsigned cvt_pk_bf16(float lo, float hi) { f32x2_t v = {lo, hi}; bf16x2_t b = __builtin_convertvector(v, bf16x2_t); return __builtin_bit_cast(unsigned, b); }
__device__ __forceinline__ unsigned cvt_pk_bf16_asm(float lo, float hi) { unsigned r; asm volatile("v_cvt_pk_bf16_f32 %0, %1, %2" : "=v"(r) : "v"(lo), "v"(hi)); return r; }
__device__ __forceinline__ float bflo(unsigned w) { return __uint_as_float(w << 16); }
__device__ __forceinline__ float bfhi(unsigned w) { return __uint_as_float(w & 0xffff0000u); }
__device__ __forceinline__ float bf1(bf16_t b) { return __uint_as_float((unsigned)b << 16); }
__device__ __forceinline__ bf16_t f2bf(float f) { return (bf16_t)(cvt_pk_bf16(f, 0.f) & 0xffffu); }
__device__ __forceinline__ float sigmoidf_(float x) { return __builtin_amdgcn_rcpf(1.f + __expf(-x)); }
__device__ __forceinline__ float siluf_(float x) { return x * sigmoidf_(x); }
template <int CTRL> __device__ __forceinline__ float dpp_mov(float v) { return __int_as_float(__builtin_amdgcn_update_dpp(0, __float_as_int(v), CTRL, 0xF, 0xF, true)); }
__device__ __forceinline__ float row16_sum(float v) { v += dpp_mov<0xB1>(v); v += dpp_mov<0x4E>(v); v += dpp_mov<0x141>(v); v += dpp_mov<0x140>(v); return v; }
__device__ __forceinline__ float wave_sum(float v) {
    v = row16_sum(v);
    v += __shfl_xor(v, 16); v += __shfl_xor(v, 32);
    return v;
}
__device__ __forceinline__ void unpack8(const u32x4 w, float* f) {
    f[0] = bflo(w.x); f[1] = bfhi(w.x); f[2] = bflo(w.y); f[3] = bfhi(w.y); f[4] = bflo(w.z); f[5] = bfhi(w.z); f[6] = bflo(w.w); f[7] = bfhi(w.w);
}
__device__ __forceinline__ u32x4 pack8(const float* f) {
    u32x4 w; w.x = cvt_pk_bf16(f[0], f[1]); w.y = cvt_pk_bf16(f[2], f[3]); w.z = cvt_pk_bf16(f[4], f[5]); w.w = cvt_pk_bf16(f[6], f[7]); return w;
}
__device__ __forceinline__ bf16x8 pack_frag(const f32x4 a, const f32x4 b) {
    u32x4 w; w.x = cvt_pk_bf16(a[0], a[1]); w.y = cvt_pk_bf16(a[2], a[3]); w.z = cvt_pk_bf16(b[0], b[1]); w.w = cvt_pk_bf16(b[2], b[3]);
    return __builtin_bit_cast(bf16x8, w);
}
__device__ __forceinline__ bf16x8 lda_perm(const LAS bf16_t* rowp, int s, int fq, bool second) {
    if (second) return *(const LAS bf16x8*)(rowp + 32 * s + 8 * fq);
    const u32x2 lo = *(const LAS u32x2*)(rowp + 32 * s + 8 * fq);
    u32x4 w; w.x = lo.x; w.y = lo.y; w.z = 0u; w.w = 0u; return __builtin_bit_cast(bf16x8, w);
}
__device__ __forceinline__ void st_perm(LAS bf16_t* rowp, int ch, const u32x4 v) {
    const int c4 = ch & 3, f = 32 * (ch >> 2) + (c4 & 1) * 16 + (c4 >> 1) * 4;
    *(LAS u32x2*)(rowp + f) = (u32x2){v.x, v.y};
    *(LAS u32x2*)(rowp + f + 8) = (u32x2){v.z, v.w};
}
__device__ __forceinline__ s16x4 lds_tr(const LAS bf16_t* p) { return __builtin_bit_cast(s16x4, __builtin_amdgcn_ds_read_tr16_b64_v4i16((LAS s16x4*)p)); }

namespace pg8 {
constexpr int BM = 256, BK = 64, HALF = 128, HTB = HALF * BK * 2, STAGE_BYTES = 8 * HTB, NXCD = 8, WGM = 8;
__host__ __device__ __forceinline__ int lds_byte(int r, int c) { const int st = (r >> 4) * 2 + (c >> 5), rr = r & 15, cc = c & 31, ob = rr * 64 + cc * 2; return st * 1024 + (ob ^ (((ob >> 9) & 1) << 5)); }
__host__ __device__ __forceinline__ void stage_rc(int b, int& R, int& C) { const int st = b / 1024, sb = b % 1024, swz = sb ^ (((sb >> 9) & 1) << 5); R = (st >> 1) * 16 + swz / 64; C = (st & 1) * 32 + (swz % 64) / 2; }
__host__ __device__ __forceinline__ int perm32(int rho) { const int n = rho >> 4, i = rho & 15; return 8 * (i >> 2) + 4 * n + (i & 3); }
struct Unit { int pm, pn; };
struct Gemm { const bf16_t* A; const bf16_t* Bt; int M, N, K, lda; };
struct StaticOrder {
    int nM, nN, nwg, G, c;
    __device__ void init(int M, int N, int G_, int c_) { nM = M / BM; nN = N / BM; nwg = nM * nN; G = G_; c = c_; }
    __device__ bool next(int i, Unit& u) const {
        const long L = (long)i * G + c; if (L >= nwg) return false;
        int wgid = (int)L; { const int q = nwg / NXCD, r = nwg % NXCD, xcd = wgid % NXCD, off = wgid / NXCD; wgid = (xcd < r ? xcd * (q + 1) : r * (q + 1) + (xcd - r) * q) + off; }
        const int nig = WGM * nN, gid = wgid / nig, fm = gid * WGM, gsz = (nM - fm) < WGM ? (nM - fm) : WGM;
        u.pm = fm + ((wgid % nig) % gsz); u.pn = (wgid % nig) / gsz; return true;
    }
};
template <int MODE> struct Epi {
    static constexpr bool PERM = true;
    bf16_t* Z1; bf16_t* HALO; float* out;
    __device__ __forceinline__ void operator()(const f32x4 (&acc)[2][2][4][2], const Unit& u, int wr, int wc, int fr, int fq) const {
        const int col0 = u.pn * BM + wc * 32 + 8 * fq;
        if constexpr (MODE == 0 || MODE == 4 || MODE == 5) {
#pragma unroll
        for (int ai = 0; ai < 2; ++ai)
#pragma unroll
            for (int m = 0; m < 4; ++m) {
                const int row = u.pm * BM + ai * HALF + wr * 64 + m * 16 + fr;
                if constexpr (MODE == 0) {
                    bf16_t* rowp = Z1 + (size_t)row * ZW + col0;
                    const bool is_halo = (m == 3) && (fr >= 13) && (row < NPROMPT) && (u.pn >= 4);
                    int cs = -1; float* bl = nullptr; float* bg = nullptr;
                    if (row < NPROMPT) { const int t = row & (SEQ - 1); if (t >= SEQ - 3) { cs = t - (SEQ - 3); const int b = row >> 11; bl = out + O_PLC + (size_t)(b * 3 + cs) * 1024; bg = out + O_PGC + (size_t)(b * 3 + cs) * 3072; } }
                    else { const int t = row & 7; if (t >= 5) { cs = t - 5; const int s = (row - NPROMPT) >> 3; bl = out + O_SLC + (size_t)(s * 3 + cs) * 1024; bg = out + O_SGC + (size_t)(s * 3 + cs) * 3072; } }
#pragma unroll
                    for (int bj = 0; bj < 2; ++bj) {
                        const f32x4 v0 = acc[ai][bj][m][0], v1 = acc[ai][bj][m][1];
                        u32x4 w; w.x = cvt_pk_bf16(v0[0], v0[1]); w.y = cvt_pk_bf16(v0[2], v0[3]); w.z = cvt_pk_bf16(v1[0], v1[1]); w.w = cvt_pk_bf16(v1[2], v1[3]);
                        *(u32x4*)(rowp + bj * HALF) = w;
                        const int col = col0 + bj * HALF;
                        if (is_halo) *(u32x4*)(HALO + (size_t)((row >> 6) * 3 + (fr - 13)) * 3072 + (col - 1024)) = w;
                        if (cs >= 0) { float* d = (u.pn < 4) ? bl + col : bg + (col - 1024); *(f32x4*)d = v0; *(f32x4*)(d + 4) = v1; }
                    }
                } else if constexpr (MODE == 5) {
                    bf16_t* pp = (bf16_t*)out + (size_t)row * 2048 + col0;
#pragma unroll
                    for (int bj = 0; bj < 2; ++bj) {
                        const f32x4 v0 = acc[ai][bj][m][0], v1 = acc[ai][bj][m][1];
                        float o[8] = {v0[0], v0[1], v0[2], v0[3], v1[0], v1[1], v1[2], v1[3]};
#pragma unroll
                        for (int e = 0; e < 8; ++e) o[e] = sigmoidf_(o[e]);
                        *(u32x4*)(pp + bj * HALF) = pack8(o);
                    }
                } else {
                    float* rowp = out + (size_t)row * DM + col0;
#pragma unroll
                    for (int bj = 0; bj < 2; ++bj) { *(f32x4*)(rowp + bj * HALF) = acc[ai][bj][m][0]; *(f32x4*)(rowp + bj * HALF + 4) = acc[ai][bj][m][1]; }
                }
            }
        } else {
            const int cbase = (MODE == 1) ? col0 : 2048 + col0;
            const bool gate = (MODE == 1);
#pragma unroll
            for (int ai = 0; ai < 2; ++ai)
#pragma unroll
                for (int mh = 0; mh < 2; ++mh) {
                    u32x4 tv[2][2], sv[2][2];
#pragma unroll
                    for (int mm = 0; mm < 2; ++mm) {
                        const size_t rowi = (size_t)(u.pm * BM + ai * HALF + wr * 64 + (2 * mh + mm) * 16 + fr);
                        const bf16_t* rowp = Z1 + rowi * ZW + cbase;
                        const bf16_t* parkp = (const bf16_t*)out + rowi * 2048 + col0 + (MODE == 3 ? 1024 : 0);
#pragma unroll
                        for (int bj = 0; bj < 2; ++bj) {
                            if constexpr (MODE == 1) tv[mm][bj] = *(const u32x4*)(rowp + bj * HALF);
                            if constexpr (MODE == 2) tv[mm][bj] = *(const u32x4*)(parkp + bj * HALF);
                            if constexpr (MODE == 3) { tv[mm][bj] = *(const u32x4*)(rowp + bj * HALF); sv[mm][bj] = *(const u32x4*)(parkp + bj * HALF); }
                        }
                    }
#pragma unroll
                    for (int mm = 0; mm < 2; ++mm) {
                        const int m = 2 * mh + mm;
                        bf16_t* rowp = Z1 + (size_t)(u.pm * BM + ai * HALF + wr * 64 + m * 16 + fr) * ZW + cbase;
#pragma unroll
                        for (int bj = 0; bj < 2; ++bj) {
                            const f32x4 v0 = acc[ai][bj][m][0], v1 = acc[ai][bj][m][1];
                            float o[8] = {v0[0], v0[1], v0[2], v0[3], v1[0], v1[1], v1[2], v1[3]};
                            if constexpr (MODE == 1) {
                                if (gate) { float hf[8]; unpack8(tv[mm][bj], hf);
#pragma unroll
                                    for (int e = 0; e < 8; ++e) o[e] = siluf_(o[e]) * hf[e]; }
                                else {
#pragma unroll
                                    for (int e = 0; e < 8; ++e) o[e] = sigmoidf_(o[e]); }
                            } else if constexpr (MODE == 2) { float sf[8]; unpack8(tv[mm][bj], sf);
#pragma unroll
                                for (int e = 0; e < 8; ++e) o[e] *= sf[e];
                            } else { float tf[8], sf[8]; unpack8(tv[mm][bj], tf); unpack8(sv[mm][bj], sf);
#pragma unroll
                                for (int e = 0; e < 8; ++e) o[e] = tf[e] + sf[e] * o[e]; }
                            *(u32x4*)(rowp + bj * HALF) = pack8(o);
                        }
                    }
                }
        }
    }
};

struct SeqOrder {
    int base, step, n, smp;
    __device__ bool next(int i, Unit& u) const {
        if (i >= n) return false;
        const int t = base + i * step;
        if (smp == 2) { u.pm = 64 + (t >> 4); u.pn = t & 15; }
        else if (smp) { u.pm = 64 + (t >> 2); u.pn = t & 3; }
        else { u.pm = (t & 7) * 8 + ((t >> 3) >> 2); u.pn = (t >> 3) & 3; }
        return true;
    }
};
template <class EpiT, class SchedT>
__device__ __forceinline__ void gemm_phase(LAS unsigned char* lds, const Gemm g, const SchedT& S, const EpiT& E) {
    const int tid = threadIdx.x, wid = __builtin_amdgcn_readfirstlane(tid >> 6), lane = tid & 63, wr = wid >> 2, wc = wid & 3, fr = lane & 15, fq = lane >> 4;
    const int K = g.K, nt = K / BK, lda = g.lda;
    unsigned voffA[2], voffB[2];
#pragma unroll
    for (int i = 0; i < 2; ++i) { int R, C; stage_rc(tid * 16 + i * 8192, R, C); const int Rb = EpiT::PERM ? ((R & ~31) + perm32(R & 31)) : R;
        voffA[i] = (unsigned)(R * lda + C) * 2u; voffB[i] = (unsigned)(Rb * K + C) * 2u; }
    const size_t kstep = (size_t)(BK * 2);
    const size_t hsA = (size_t)HALF * lda * 2, hsB = (size_t)HALF * K * 2;
    const size_t tsA = 2 * hsA, tsB = 2 * hsB;
    const unsigned ldsw = (unsigned)wid * 1024u;
    const int aoff = lds_byte(wr * 64 + fr, fq * 8), boff = lds_byte(wc * 32 + fr, fq * 8);
#define PG8_SA(b, h) (((b) * 2 + (h)) * HTB)
#define PG8_SB(b, h) ((4 + (b) * 2 + (h)) * HTB)
#define PG8_STAGE(bufoff, gbase, voff) do { _Pragma("unroll") for (int _i = 0; _i < 2; ++_i) \
        __builtin_amdgcn_global_load_lds((const unsigned*)((const char*)(gbase) + (voff)[_i]), (LAS unsigned*)(lds + (bufoff) + ldsw + _i * 8192), 16, 0, 0); } while (0)
#define PG8_LDA(dst, b, h) do { _Pragma("unroll") for (int m = 0; m < 4; ++m) _Pragma("unroll") for (int k = 0; k < 2; ++k) dst[m][k] = *(const LAS bf16x8*)(lds + PG8_SA(b, h) + aoff + m * 2048 + k * 1024); } while (0)
#define PG8_LDB(dst, b, h) do { _Pragma("unroll") for (int n = 0; n < 2; ++n) _Pragma("unroll") for (int k = 0; k < 2; ++k) dst[n][k] = *(const LAS bf16x8*)(lds + PG8_SB(b, h) + boff + n * 2048 + k * 1024); } while (0)
#define PG8_MMA(ai, bj, At, Bt) do { __builtin_amdgcn_s_setprio(1); _Pragma("unroll") for (int m = 0; m < 4; ++m) _Pragma("unroll") for (int n = 0; n < 2; ++n) _Pragma("unroll") for (int k = 0; k < 2; ++k) \
        acc[ai][bj][m][n] = __builtin_amdgcn_mfma_f32_16x16x32_bf16(Bt[n][k], At[m][k], acc[ai][bj][m][n], 0, 0, 0); __builtin_amdgcn_s_setprio(0); } while (0)
#define PG8_WAIT_V(n) asm volatile("s_waitcnt vmcnt(" #n ")" ::: "memory")
#define PG8_WAIT_L(n) asm volatile("s_waitcnt lgkmcnt(" #n ")" ::: "memory")
#define PG8_BAR __builtin_amdgcn_s_barrier()
#define PG8_SCHED __builtin_amdgcn_sched_barrier(0)
    Unit cur, nxt; int ui = 0;
    if (!S.next(0, cur)) return;
    f32x4 acc[2][2][4][2];
#pragma unroll
    for (int a = 0; a < 2; ++a)
#pragma unroll
        for (int b = 0; b < 2; ++b)
#pragma unroll
            for (int m = 0; m < 4; ++m)
#pragma unroll
                for (int n = 0; n < 2; ++n) acc[a][b][m][n] = (f32x4){0.f, 0.f, 0.f, 0.f};
    bf16x8 At[4][2], B0[2][2], B1[2][2];
    const char* cA = (const char*)g.A + (size_t)cur.pm * tsA; const char* cB = (const char*)g.Bt + (size_t)cur.pn * tsB;
    PG8_STAGE(PG8_SB(0, 0), cB, voffB); PG8_STAGE(PG8_SB(0, 1), cB + hsB, voffB); PG8_STAGE(PG8_SA(0, 0), cA, voffA); PG8_STAGE(PG8_SA(0, 1), cA + hsA, voffA);
    if (wr == 1) PG8_BAR;
    PG8_WAIT_V(2); PG8_BAR;
    PG8_STAGE(PG8_SB(1, 0), cB + kstep, voffB); PG8_STAGE(PG8_SA(1, 0), cA + kstep, voffA); PG8_STAGE(PG8_SB(1, 1), cB + hsB + kstep, voffB);
    PG8_WAIT_V(6); PG8_BAR;
    for (;;) {
        const bool has_next = S.next(ui + 1, nxt);
        const char* nA = has_next ? (const char*)g.A + (size_t)nxt.pm * tsA : cA; const char* nB = has_next ? (const char*)g.Bt + (size_t)nxt.pn * tsB : cB;
        for (int t = 0; t < nt; t += 2) {
            const bool last = (t == nt - 2);
            const char* a1 = cA + (size_t)(t + 1) * kstep;
            const char* a2 = last ? nA : cA + (size_t)(t + 2) * kstep; const char* b2 = last ? nB : cB + (size_t)(t + 2) * kstep;
            const char* a3 = a2 + kstep; const char* b3 = b2 + kstep;
            PG8_LDB(B0, 0, 0); PG8_LDB(B1, 0, 1); PG8_SCHED; PG8_LDA(At, 0, 0); PG8_STAGE(PG8_SA(1, 1), a1 + hsA, voffA);
            PG8_WAIT_V(8); PG8_WAIT_L(0); PG8_BAR; PG8_MMA(0, 0, At, B0); PG8_MMA(0, 1, At, B1); PG8_BAR; PG8_SCHED;
            PG8_LDA(At, 0, 1); PG8_STAGE(PG8_SB(0, 0), b2, voffB); PG8_STAGE(PG8_SB(0, 1), b2 + hsB, voffB); PG8_STAGE(PG8_SA(0, 0), a2, voffA);
            PG8_WAIT_V(8); PG8_WAIT_L(0); PG8_BAR; PG8_MMA(1, 0, At, B0); PG8_MMA(1, 1, At, B1); PG8_BAR; PG8_SCHED;
            PG8_LDB(B0, 1, 0); PG8_LDB(B1, 1, 1); PG8_SCHED; PG8_LDA(At, 1, 0); PG8_STAGE(PG8_SA(0, 1), a2 + hsA, voffA);
            PG8_WAIT_V(8); PG8_WAIT_L(0); PG8_BAR; PG8_MMA(0, 0, At, B0); PG8_MMA(0, 1, At, B1); PG8_BAR; PG8_SCHED;
            PG8_LDA(At, 1, 1); PG8_STAGE(PG8_SB(1, 0), b3, voffB); PG8_STAGE(PG8_SB(1, 1), b3 + hsB, voffB); PG8_STAGE(PG8_SA(1, 0), a3, voffA);
            PG8_WAIT_V(8); PG8_WAIT_L(0); PG8_BAR; PG8_MMA(1, 0, At, B0); PG8_MMA(1, 1, At, B1); PG8_BAR; PG8_SCHED;
        }
        if (wr == 0) PG8_BAR;
        E(acc, cur, wr, wc, fr, fq);
        if (!has_next) break;
#pragma unroll
        for (int a = 0; a < 2; ++a)
#pragma unroll
            for (int b = 0; b < 2; ++b)
#pragma unroll
                for (int m = 0; m < 4; ++m)
#pragma unroll
                    for (int n = 0; n < 2; ++n) acc[a][b][m][n] = (f32x4){0.f, 0.f, 0.f, 0.f};
        cur = nxt; cA = nA; cB = nB; ++ui;
        if (wr == 1) PG8_BAR;
    }
    PG8_WAIT_V(0);
    PG8_BAR;
#undef PG8_SA
#undef PG8_SB
#undef PG8_STAGE
#undef PG8_LDA
#undef PG8_LDB
#undef PG8_MMA
#undef PG8_WAIT_V
#undef PG8_WAIT_L
#undef PG8_BAR
#undef PG8_SCHED
}
}

__device__ __forceinline__ void transpose_item(const float* W, int ldw, int src_col, bf16_t* WTrow, int k0, int lane) {
#pragma unroll
    for (int hf = 0; hf < 2; ++hf) {
        float v[32];
#pragma unroll
        for (int kk = 0; kk < 32; ++kk) v[kk] = W[(size_t)(k0 + hf * 32 + kk) * ldw + src_col + lane];
#pragma unroll
        for (int q = 0; q < 4; ++q) { u32x4 w; w.x = cvt_pk_bf16_asm(v[8 * q], v[8 * q + 1]); w.y = cvt_pk_bf16_asm(v[8 * q + 2], v[8 * q + 3]); w.z = cvt_pk_bf16_asm(v[8 * q + 4], v[8 * q + 5]); w.w = cvt_pk_bf16_asm(v[8 * q + 6], v[8 * q + 7]);
            *(u32x4*)(WTrow + k0 + hf * 32 + 8 * q) = w; }
    }
}
__device__ __forceinline__ void p0_prologue(const Args& a, LAS unsigned char* L) {
    const int tid = threadIdx.x, lane = tid & 63, wave = tid >> 6;
    const int gw = blockIdx.x * 8 + wave, NGW = gridDim.x * 8;
    unsigned char* ws = a.ws;
    const float* w_in = a.in[8];
    for (int it = gw; it < 2880; it += NGW) {
        if (it < 2048) {
            const int which = it >> 10, r = it & 1023, nb = r >> 4, kb = r & 15, n0 = nb * 64;
            int src;
            if (which == 0) src = (n0 < 1024) ? n0 : n0 + 1024;
            else src = (n0 < 1024) ? 1024 + n0 : (n0 < 2048) ? 5120 + (n0 - 1024) : (n0 < 3072) ? 6160 + (n0 - 2048) : 7184 + (n0 - 3072);
            bf16_t* WT = (bf16_t*)(ws + (which ? WS_W2T : WS_W1T));
            transpose_item(w_in, 8208, src, WT + (size_t)(n0 + lane) * 1024, kb * 64, lane);
        } else if (it < 2816) {
            const int r = it - 2048, which = r >> 8, q = r & 255, nb = q >> 4, kb = q & 15;
            const float* W = which == 0 ? a.in[20] : which == 1 ? a.in[21] : a.in[22];
            bf16_t* WT = (bf16_t*)(ws + (which == 0 ? WS_WBL : which == 1 ? WS_WBG : WS_WO));
            transpose_item(W, 1024, nb * 64, WT + (size_t)(nb * 64 + lane) * 1024, kb * 64, lane);
        } else {
            const int r = it - 2816, which = r >> 5, q = r & 31, g = q >> 2, nb = (q >> 1) & 1, kb = q & 1;
            const float* W = (which == 0 ? a.in[11] : a.in[13]) + (size_t)g * 16384;
            bf16_t* WT = (bf16_t*)(ws + (which == 0 ? WS_WA : WS_WX)) + (size_t)g * 16384;
            transpose_item(W, 128, nb * 64, WT + (size_t)(nb * 64 + lane) * 128, kb * 64, lane);
        }
    }
    LAS float* wT = (LAS float*)L;
    for (int idx = tid; idx < 16384; idx += 512) { const int k = idx >> 4, c = idx & 15; wT[c * 1024 + k] = w_in[(size_t)k * 8208 + 6144 + c]; }
    __syncthreads();
    const float* x_p = a.in[0]; const float* x_s = a.in[1]; const float* gain = a.in[6];
    bf16_t* U = (bf16_t*)(ws + WS_U); float* BG = (float*)(ws + WS_BG);
    f32x4 gn[4];
#pragma unroll
    for (int j = 0; j < 4; ++j) gn[j] = ((const f32x4*)gain)[lane + 64 * j];
    for (int m = gw; m < NROWS; m += NGW) {
        const float* xr = (m < NPROMPT) ? x_p + (size_t)m * DM : x_s + (size_t)(m - NPROMPT) * DM;
        f32x4 v[4]; float s = 0.f;
#pragma unroll
        for (int j = 0; j < 4; ++j) { v[j] = ((const f32x4*)xr)[lane + 64 * j]; s += (v[j].x * v[j].x + v[j].y * v[j].y) + (v[j].z * v[j].z + v[j].w * v[j].w); }
        const float rs = rsqrtf(wave_sum(s) * (1.f / DM) + EPS);
#pragma unroll
        for (int j = 0; j < 4; ++j) { v[j] = v[j] * rs * gn[j];
            u32x2 o; o.x = cvt_pk_bf16(v[j].x, v[j].y); o.y = cvt_pk_bf16(v[j].z, v[j].w);
            ((u32x2*)(U + (size_t)m * DM))[lane + 64 * j] = o; }
        float mine = 0.f;
#pragma unroll 1
        for (int c0 = 0; c0 < 16; c0 += 4) {
            float p[4];
#pragma unroll
            for (int cc = 0; cc < 4; ++cc) {
                p[cc] = 0.f;
#pragma unroll
                for (int j = 0; j < 4; ++j) { const f32x4 w = ((const LAS f32x4*)(wT + (c0 + cc) * 1024))[lane + 64 * j]; p[cc] += (v[j].x * w.x + v[j].y * w.y) + (v[j].z * w.z + v[j].w * w.w); }
            }
#pragma unroll
            for (int cc = 0; cc < 4; ++cc) p[cc] = row16_sum(p[cc]);
#pragma unroll
            for (int cc = 0; cc < 4; ++cc) p[cc] += __shfl_xor(p[cc], 16);
#pragma unroll
            for (int cc = 0; cc < 4; ++cc) p[cc] += __shfl_xor(p[cc], 32);
#pragma unroll
            for (int cc = 0; cc < 4; ++cc) if (lane == c0 + cc) mine = p[cc];
        }
        if (lane < 8) BG[(size_t)m * 16 + lane] = 1.f / (1.f + expf(-mine));
        else if (lane < 16) { const int h = lane - 8; const float xx = mine + a.in[18][h]; const float sp = xx > 20.f ? xx : log1pf(expf(xx)); BG[(size_t)m * 16 + lane] = -expf(a.in[17][h]) * sp; }
    }
}

#ifndef DRY_SKIP
#define DRY_SKIP 0
#endif
__device__ __forceinline__ void p2_gdn_local(const Args& a, LAS unsigned char* L, const bool dry, const int u0, const int ustep, const int un) {
    const int tid = threadIdx.x, lane = tid & 63, wave = __builtin_amdgcn_readfirstlane(tid >> 6), fr = lane & 15, fq = lane >> 4;
    LAS bf16_t* QS = (LAS bf16_t*)(L);
    LAS bf16_t* KS = (LAS bf16_t*)(L + 17408);
    LAS float* MS = (LAS float*)(L + 52224);
    LAS bf16_t* AS = (LAS bf16_t*)(L + 68864);
    LAS bf16_t* TS = (LAS bf16_t*)(L + 78080);
    LAS float* GCS = (LAS float*)(L + 87296);
    LAS float* BES = (LAS float*)(L + 87552);
    LAS bf16_t* RAW = (LAS bf16_t*)(L + 87808);
    LAS float* CW = (LAS float*)(L + 140336);
    LAS bf16_t* SH = (LAS bf16_t*)(L + 52224);
    bf16_t* Z1 = (bf16_t*)(a.ws + WS_Z1); const bf16_t* HALO = (const bf16_t*)(a.ws + WS_HALO);
    const float* BG = (const float*)(a.ws + WS_BG); float* GC = (float*)(a.ws + WS_GC);
    bf16_t* TINV = (bf16_t*)(a.ws + WS_TINV); bf16_t* AQK = (bf16_t*)(a.ws + WS_AQK);
    const float* st_gc = a.in[4]; const float* cw = a.in[16];
    u32x4 nr[7];
    int zo[7], lo[7];
#pragma unroll
    for (int k = 0; k < 7; ++k) {
        int q = tid + 512 * k; if (q > 3215) q = 3215;
        const int rr = q / 48, rem = q - rr * 48;
        zo[k] = (rr >= 3 ? rr - 3 : 0) * ZW + (rem >> 4) * 1024 + (rem & 15) * 8;
        lo[k] = rr * 392 + rem * 8;
    }
    const int rr0 = tid / 48;
    const int ho0 = rr0 * 3072 + ((tid - rr0 * 48) >> 4) * 1024 + ((tid - rr0 * 48) & 15) * 8;
    auto prefetch = [&](int u) {
        const int grp = u >> 3, h = u & 7; const bool smp = grp >= 256; const bool nohalo = smp || ((grp & 31) == 0);
        const bf16_t* zb = Z1 + (size_t)grp * 64 * ZW + 1024 + h * 128;
#pragma unroll
        for (int k = 0; k < 7; ++k) {
            const bf16_t* src = zb + zo[k];
            if (k == 0 && rr0 < 3 && !nohalo) src = HALO + (size_t)(grp - 1) * 3 * 3072 + h * 128 + ho0;
            u32x4 v = *(const u32x4*)src;
            if (k == 0 && rr0 < 3 && nohalo) v = (u32x4){0u, 0u, 0u, 0u};
            nr[k] = v;
        }
    };
    int hprev = -1;
    if (un > 0) prefetch(u0);
    for (int ui = 0; ui < un; ++ui) {
        const int u = u0 + ui * ustep;
        const int grp = u >> 3, h = u & 7; const bool smp = grp >= 256; const int row0 = grp * 64;
        const int t = tid >> 3, p = tid & 7;
        __syncthreads();
#pragma unroll
        for (int k = 0; k < 7; ++k) {
            const int q = tid + 512 * k;
            if (q < 3216) *(LAS u32x4*)(RAW + lo[k]) = nr[k];
        }
        if (h != hprev) {
#pragma unroll
            for (int k = 0; k < 3; ++k) { const int idx = tid + 512 * k, i = idx / 384, c = idx - i * 384; CW[idx] = cw[(size_t)i * 3072 + (c >> 7) * 1024 + h * 128 + (c & 127)]; }
            hprev = h;
        }
        if (smp) {
            for (int idx = tid; idx < 9216; idx += 512) { const int sr = idx / 384, c = idx - sr * 384;
                SH[sr * 392 + c] = f2bf(st_gc[(size_t)((grp - 256) * 24 + sr) * 3072 + (c >> 7) * 1024 + h * 128 + (c & 127)]); }
        }
        if (tid < 64) {
            float g = BG[(size_t)(row0 + tid) * 16 + 8 + h]; const float be = BG[(size_t)(row0 + tid) * 16 + h];
            const int li = smp ? (tid & 7) : tid;
#pragma unroll
            for (int d = 1; d < 64; d <<= 1) { const float o = __shfl_up(g, d); if (li >= d) g += o; }
            GCS[tid] = g; BES[tid] = be; GC[(size_t)(row0 + tid) * 8 + h] = g;
        }
        __syncthreads();
        if (ui + 1 < un) prefetch(u + ustep);
#pragma unroll 1
        for (int seg = (dry && (DRY_SKIP & 4)) ? 3 : 0; seg < 3; ++seg) {
            float av[16];
#pragma unroll
            for (int e = 0; e < 16; ++e) av[e] = 0.f;
#pragma unroll
            for (int i = 0; i < 4; ++i) {
                const int ts8 = (t & 7) - 3 + i;
                const LAS bf16_t* rp = (smp && ts8 < 0) ? SH + ((t >> 3) * 3 + ts8 + 3) * 392 : RAW + (t + i) * 392;
                rp += seg * 128 + 16 * p;
                float xv[16];
                const u32x4 w0 = *(const LAS u32x4*)rp, w1 = *(const LAS u32x4*)(rp + 8); unpack8(w0, xv); unpack8(w1, xv + 8);
                const LAS float* wp = CW + i * 384 + seg * 128 + 16 * p;
#pragma unroll
                for (int q = 0; q < 4; ++q) { const f32x4 f = *(const LAS f32x4*)(wp + 4 * q); av[4 * q] += f.x * xv[4 * q]; av[4 * q + 1] += f.y * xv[4 * q + 1]; av[4 * q + 2] += f.z * xv[4 * q + 2]; av[4 * q + 3] += f.w * xv[4 * q + 3]; }
            }
            float ss = 0.f;
#pragma unroll
            for (int e = 0; e < 16; ++e) { av[e] = siluf_(av[e]); ss += av[e] * av[e]; }
            ss += __shfl_xor(ss, 1); ss += __shfl_xor(ss, 2); ss += __shfl_xor(ss, 4);
            const float rs = (seg == 2) ? 1.f : rsqrtf(ss + EPS) * (seg == 0 ? 0.08838834764831845f : 1.f);
#pragma unroll
            for (int e = 0; e < 16; ++e) av[e] *= rs;
            LAS bf16_t* d = QS + seg * 8704 + t * 136 + 16 * p;
            *(LAS u32x4*)d = pack8(av); *(LAS u32x4*)(d + 8) = pack8(av + 8);
        }
        __syncthreads();
        if (!dry)
#pragma unroll
        for (int q = 0; q < 6; ++q) {
            const int idx = tid + 512 * q, seg = idx >> 10, r = (idx >> 4) & 63, ch = idx & 15;
            *(u32x4*)(Z1 + (size_t)(row0 + r) * ZW + 1024 + seg * 1024 + h * 128 + ch * 8) = *(const LAS u32x4*)(QS + seg * 8704 + r * 136 + ch * 8);
        }
        if (!(dry && (DRY_SKIP & 2)))
        {
            const int sel = wave >> 2, ti = wave & 3;
            const LAS bf16_t* XA = sel ? QS : KS;
            bf16x8 af[4], bfr[4][4]; float gi[4], bi[4], gj[4];
#pragma unroll
            for (int ks = 0; ks < 4; ++ks) af[ks] = *(const LAS bf16x8*)(XA + (16 * ti + fr) * 136 + 32 * ks + 8 * fq);
#pragma unroll
            for (int tj = 0; tj < 4; ++tj) {
                gj[tj] = GCS[16 * tj + fr];
#pragma unroll
                for (int ks = 0; ks < 4; ++ks) bfr[tj][ks] = *(const LAS bf16x8*)(KS + (16 * tj + fr) * 136 + 32 * ks + 8 * fq);
            }
#pragma unroll
            for (int r = 0; r < 4; ++r) { gi[r] = GCS[16 * ti + 4 * fq + r]; bi[r] = BES[16 * ti + 4 * fq + r]; }
            __builtin_amdgcn_sched_barrier(0);
            f32x4 acc[4];
#pragma unroll
            for (int tj = 0; tj < 4; ++tj) {
                acc[tj] = (f32x4){0.f, 0.f, 0.f, 0.f};
                if (tj <= ti) {
#pragma unroll
                    for (int ks = 0; ks < 4; ++ks) acc[tj] = __builtin_amdgcn_mfma_f32_16x16x32_bf16(af[ks], bfr[tj][ks], acc[tj], 0, 0, 0);
                }
            }
            float ov[4][4];
#pragma unroll
            for (int tj = 0; tj < 4; ++tj)
#pragma unroll
                for (int r = 0; r < 4; ++r) {
                    const int i = 16 * ti + 4 * fq + r, j = 16 * tj + fr;
                    const bool same = smp ? ((i >> 3) == (j >> 3)) : true;
                    const float e = __expf(fminf(gi[r] - gj[tj], 0.f));
                    const bool keep = same && (sel == 0 ? (i > j) : (i >= j));
                    ov[tj][r] = keep ? (sel == 0 ? bi[r] : 1.f) * acc[tj][r] * e : 0.f;
                }
            if (sel == 0) {
#pragma unroll
                for (int tj = 0; tj < 4; ++tj)
#pragma unroll
                    for (int r = 0; r < 4; ++r) MS[(16 * ti + 4 * fq + r) * 65 + 16 * tj + fr] = ov[tj][r];
            } else {
#pragma unroll
                for (int tj = 0; tj < 4; ++tj)
#pragma unroll
                    for (int r = 0; r < 4; ++r) AS[(16 * ti + 4 * fq + r) * 72 + 16 * tj + fr] = f2bf(ov[tj][r]);
            }
        }
        __syncthreads();
        if (!(dry && (DRY_SKIP & 1)))
        {
            float mrow[64];
#pragma unroll
            for (int j = 0; j < 64; ++j) mrow[j] = MS[lane * 65 + j];
            float X[8];
#pragma unroll
            for (int cc = 0; cc < 8; ++cc) X[cc] = (lane == 8 * cc + wave) ? 1.f : 0.f;
#pragma unroll
            for (int j = 0; j < 64; ++j) {
                float sv[8];
#pragma unroll
                for (int cc = 0; cc < 8; ++cc) sv[cc] = (8 * cc <= j) ? __uint_as_float(__builtin_amdgcn_readlane(__float_as_uint(X[cc]), j)) : 0.f;
                const float nm = -mrow[j];
#pragma unroll
                for (int cc = 0; cc < 8; ++cc) if (8 * cc <= j) X[cc] = fmaf(nm, sv[cc], X[cc]);
            }
#pragma unroll
            for (int cc = 0; cc < 8; ++cc) TS[lane * 72 + 8 * cc + wave] = f2bf(X[cc]);
        }
        __syncthreads();
        {
            const int r = tid >> 3, ch = tid & 7;
            const size_t o = ((size_t)u * 64 + r) * 64 + ch * 8;
            *(u32x4*)(TINV + o) = *(const LAS u32x4*)(TS + r * 72 + ch * 8);
            *(u32x4*)(AQK + o) = *(const LAS u32x4*)(AS + r * 72 + ch * 8);
        }
    }
    __syncthreads();
}

__device__ __forceinline__ u32x4 gdn_norm8(const u32x4 o8, const LAS float* part8, const LAS float* nw8) {
    const f32x4 p0 = *(const LAS f32x4*)part8, p1 = *(const LAS f32x4*)(part8 + 4);
    const float tot = ((p0[0] + p0[1]) + (p0[2] + p0[3])) + ((p1[0] + p1[1]) + (p1[2] + p1[3]));
    const float rs = rsqrtf(tot * (1.f / 128.f) + EPS);
    float f[8]; unpack8(o8, f);
#pragma unroll
    for (int e = 0; e < 8; ++e) f[e] = f[e] * rs * nw8[e];
    return pack8(f);
}

template <int MT>
__device__ __forceinline__ void gdn_scan_unit(const Args& a, LAS unsigned char* L, int sq, int h, const bool dry) {
    constexpr bool SMP = (MT == 1);
    constexpr int NR = MT * 16, NS2 = (MT + 1) / 2, NV = SMP ? 8 : 64;
    constexpr int BUFB = 71168;
    const int tid = threadIdx.x, lane = tid & 63, wave = __builtin_amdgcn_readfirstlane(tid >> 6), fr = lane & 15, fq = lane >> 4;
    LAS float* OSS = (LAS float*)(L + 2 * BUFB);
    bf16_t* Z1 = (bf16_t*)(a.ws + WS_Z1);
    const float* BG = (const float*)(a.ws + WS_BG); const float* GC = (const float*)(a.ws + WS_GC);
    const bf16_t* TINV = (const bf16_t*)(a.ws + WS_TINV); const bf16_t* AQK = (const bf16_t*)(a.ws + WS_AQK);
    const int dv = 16 * wave + fr;
    LAS float* NWS = (LAS float*)(L + 2 * BUFB + 2048);
    if (tid < 128) NWS[tid] = a.in[19][tid];
    const LAS float* nw8 = NWS + (tid & 15) * 8;
    f32x4 S[8];
    if (SMP) {
        const float* S0 = a.in[5] + (size_t)(sq * 8 + h) * 16384;
#pragma unroll
        for (int dt = 0; dt < 8; ++dt)
#pragma unroll
            for (int r = 0; r < 4; ++r) S[dt][r] = S0[(size_t)(16 * dt + 4 * fq + r) * 128 + dv];
    } else {
#pragma unroll
        for (int dt = 0; dt < 8; ++dt) S[dt] = (f32x4){0.f, 0.f, 0.f, 0.f};
    }
    const int nch = SMP ? 1 : 32;
    const int o8 = SMP ? (sq & 7) * 8 : 0;
    u32x4 pk[6], pt[2]; float pg = 0.f, pb = 0.f;
    auto load_chunk = [&](int c) {
        const int rowc = SMP ? NPROMPT + sq * 8 : sq * SEQ + 64 * c;
        const int grp = SMP ? 256 + (sq >> 3) : (sq * 32 + c);
#pragma unroll
        for (int q = 0; q < 2; ++q) {
            const int idx = tid + 512 * q, r = idx >> 4, ch = idx & 15;
            const bool ok = SMP ? ((idx < NR * 16) && (r < NV)) : true;
            const int rcl = ok ? r : 0;
#pragma unroll
            for (int seg = 0; seg < 3; ++seg) {
                u32x4 v = *(const u32x4*)(Z1 + (size_t)(rowc + rcl) * ZW + 1024 + seg * 1024 + h * 128 + ch * 8);
                if (!ok) v = (u32x4){0u, 0u, 0u, 0u};
                pk[q * 3 + seg] = v;
            }
        }
        {
            const int r = tid >> 3, ch = tid & 7;
            bool ok; size_t o;
            if (SMP) { ok = (r < 8) && (ch == 0); o = ((size_t)(grp * 8 + h) * 64 + o8 + (ok ? r : 0)) * 64 + o8; }
            else { ok = true; o = ((size_t)(grp * 8 + h) * 64 + r) * 64 + ch * 8; }
            u32x4 v0 = *(const u32x4*)(TINV + o), v1 = *(const u32x4*)(AQK + o);
            if (!ok) { v0 = (u32x4){0u, 0u, 0u, 0u}; v1 = v0; }
            pt[0] = v0; pt[1] = v1;
        }
        if (tid < 64) { const bool ok = tid < NV; const int tc = ok ? tid : 0; pg = GC[(size_t)(rowc + tc) * 8 + h]; pb = BG[(size_t)(rowc + tc) * 16 + h]; if (!ok) { pg = 0.f; pb = 0.f; } }
    };
    auto write_chunk = [&](LAS unsigned char* B) {
        LAS bf16_t* KSb = (LAS bf16_t*)(B); LAS bf16_t* QSb = (LAS bf16_t*)(B + 17408); LAS bf16_t* VSb = (LAS bf16_t*)(B + 34816);
        LAS bf16_t* TSb = (LAS bf16_t*)(B + 52224); LAS bf16_t* ASb = (LAS bf16_t*)(B + 61440);
#pragma unroll
        for (int q = 0; q < 2; ++q) {
            const int idx = tid + 512 * q, r = idx >> 4, ch = idx & 15;
            if (idx < NR * 16) {
                st_perm(QSb + r * 136, ch, pk[q * 3 + 0]);
                st_perm(KSb + r * 136, ch, pk[q * 3 + 1]);
                *(LAS u32x4*)(VSb + r * 136 + ch * 8) = pk[q * 3 + 2];
            }
        }
        { const int r = tid >> 3, ch = tid & 7; if (r < NR) { st_perm(TSb + r * 72, ch, pt[0]); st_perm(ASb + r * 72, ch, pt[1]); } }
        if (tid < 64) { ((LAS float*)(B + 70656))[tid] = pg; ((LAS float*)(B + 70912))[tid] = pb; }
    };
    load_chunk(0);
    write_chunk(L);
    if (nch > 1) load_chunk(1);
#define SB_ __builtin_amdgcn_sched_barrier(0)
    for (int c = 0; c < nch; ++c) {
        const int rowc = SMP ? NPROMPT + sq * 8 : sq * SEQ + 64 * c;
        LAS unsigned char* B = L + (c & 1) * BUFB;
        LAS unsigned char* Bo = L + ((c & 1) ^ 1) * BUFB;
        LAS bf16_t* KS = (LAS bf16_t*)(B); LAS bf16_t* QS = (LAS bf16_t*)(B + 17408); LAS bf16_t* VS = (LAS bf16_t*)(B + 34816);
        LAS bf16_t* TS = (LAS bf16_t*)(B + 52224); LAS bf16_t* AS = (LAS bf16_t*)(B + 61440);
        LAS float* GCS = (LAS float*)(B + 70656); LAS float* BES = (LAS float*)(B + 70912);
        __syncthreads();
        if (c > 0 && !dry) {
            const LAS bf16_t* OSo = (const LAS bf16_t*)(Bo + 17408);
#pragma unroll
            for (int q = 0; q < 2; ++q) {
                const int idx = tid + 512 * q, r = idx >> 4, ch = idx & 15;
                *(u32x4*)(Z1 + (size_t)(rowc - 64 + r) * ZW + 1024 + h * 128 + ch * 8) = gdn_norm8(*(const LAS u32x4*)(OSo + r * 136 + ch * 8), OSS + r * 8, nw8);
            }
        }

        const float gl = GCS[NV - 1];
        bf16x8 Sb[4];
#pragma unroll
        for (int s = 0; s < 4; ++s) Sb[s] = pack_frag(S[2 * s], S[2 * s + 1]);
        f32x4 R[MT], P[MT];
#pragma unroll
        for (int mt = 0; mt < MT; ++mt) {
            bf16x8 fk[4];
#pragma unroll
            for (int s = 0; s < 4; ++s) fk[s] = lda_perm(KS + (16 * mt + fr) * 136, s, fq, true);
            SB_;
            R[mt] = (f32x4){0.f, 0.f, 0.f, 0.f}; P[mt] = (f32x4){0.f, 0.f, 0.f, 0.f};
#pragma unroll
            for (int s = 0; s < 4; ++s) R[mt] = __builtin_amdgcn_mfma_f32_16x16x32_bf16(fk[s], Sb[s], R[mt], 0, 0, 0);
            SB_;
#pragma unroll
            for (int s = 0; s < 4; ++s) fk[s] = lda_perm(QS + (16 * mt + fr) * 136, s, fq, true);
            SB_;
#pragma unroll
            for (int s = 0; s < 4; ++s) P[mt] = __builtin_amdgcn_mfma_f32_16x16x32_bf16(fk[s], Sb[s], P[mt], 0, 0, 0);
            SB_;
        }
        __syncthreads();
        if (c + 1 < nch) write_chunk(Bo);
        SB_;
#pragma unroll
        for (int m0 = 0; m0 < MT; m0 += 2) {
            float gi_[2][4], vi_[2][4], bi_[2][4];
#pragma unroll
            for (int mm = 0; mm < 2; ++mm) if (m0 + mm < MT) {
#pragma unroll
                for (int r = 0; r < 4; ++r) { const int i = 16 * (m0 + mm) + 4 * fq + r; gi_[mm][r] = GCS[i]; bi_[mm][r] = BES[i]; vi_[mm][r] = bf1(VS[i * 136 + dv]); }
            }
            SB_;
#pragma unroll
            for (int mm = 0; mm < 2; ++mm) if (m0 + mm < MT) {
#pragma unroll
                for (int r = 0; r < 4; ++r) {
                    const float e = __expf(gi_[mm][r]);
                    R[m0 + mm][r] = bi_[mm][r] * (vi_[mm][r] - e * R[m0 + mm][r]);
                    P[m0 + mm][r] *= e;
                }
            }
            SB_;
        }
        bf16x8 rb[NS2];
#pragma unroll
        for (int s2 = 0; s2 < NS2; ++s2) rb[s2] = pack_frag(R[2 * s2], (2 * s2 + 1 < MT) ? R[(2 * s2 + 1 < MT) ? 2 * s2 + 1 : 0] : (f32x4){0.f, 0.f, 0.f, 0.f});
        f32x4 Vn[MT];
#pragma unroll
        for (int m0 = 0; m0 < MT; m0 += 2) {
            bf16x8 ft[2][NS2];
#pragma unroll
            for (int mm = 0; mm < 2; ++mm) if (m0 + mm < MT) {
#pragma unroll
                for (int s2 = 0; s2 < NS2; ++s2) ft[mm][s2] = lda_perm(TS + (16 * (m0 + mm) + fr) * 72, s2, fq, 2 * s2 + 1 < MT);
            }
            SB_;
#pragma unroll
            for (int mm = 0; mm < 2; ++mm) if (m0 + mm < MT) {
                Vn[m0 + mm] = (f32x4){0.f, 0.f, 0.f, 0.f};
#pragma unroll
                for (int s2 = 0; s2 < NS2; ++s2) Vn[m0 + mm] = __builtin_amdgcn_mfma_f32_16x16x32_bf16(ft[mm][s2], rb[s2], Vn[m0 + mm], 0, 0, 0);
            }
            SB_;
        }
        const int q4 = fr >> 2, p4 = fr & 3;
        bf16x8 fs[1][2][NS2];
        auto ld_tr = [&](int set, int dt) {
#pragma unroll
            for (int s2 = 0; s2 < NS2; ++s2) {
                const s16x4 lo = lds_tr(KS + (32 * s2 + 4 * fq + q4) * 136 + 32 * (dt >> 1) + 8 * p4 + 4 * (dt & 1));
                s16x4 hi = (s16x4){0, 0, 0, 0};
                if (2 * s2 + 1 < MT) hi = lds_tr(KS + (32 * s2 + 16 + 4 * fq + q4) * 136 + 32 * (dt >> 1) + 8 * p4 + 4 * (dt & 1));
                bf16x8 af; af[0] = lo[0]; af[1] = lo[1]; af[2] = lo[2]; af[3] = lo[3]; af[4] = hi[0]; af[5] = hi[1]; af[6] = hi[2]; af[7] = hi[3];
                fs[set][dt & 1][s2] = af;
            }
        };
        bf16x8 vb[NS2], vdb[NS2];
#pragma unroll
        for (int s2 = 0; s2 < NS2; ++s2) {
            const int m1 = (2 * s2 + 1 < MT) ? 2 * s2 + 1 : 0;
            const f32x4 z = (f32x4){0.f, 0.f, 0.f, 0.f};
            vb[s2] = pack_frag(Vn[2 * s2], (2 * s2 + 1 < MT) ? Vn[m1] : z);
            f32x4 d0, d1;
#pragma unroll
            for (int r = 0; r < 4; ++r) { d0[r] = Vn[2 * s2][r] * __expf(gl - GCS[32 * s2 + 4 * fq + r]); d1[r] = (2 * s2 + 1 < MT) ? Vn[m1][r] * __expf(gl - GCS[32 * s2 + 16 + 4 * fq + r]) : 0.f; }
            vdb[s2] = pack_frag(d0, d1);
        }
#pragma unroll
        for (int m0 = 0; m0 < MT; m0 += 2) {
            bf16x8 fa2[2][NS2];
#pragma unroll
            for (int mm = 0; mm < 2; ++mm) if (m0 + mm < MT) {
#pragma unroll
                for (int s2 = 0; s2 < NS2; ++s2) fa2[mm][s2] = lda_perm(AS + (16 * (m0 + mm) + fr) * 72, s2, fq, 2 * s2 + 1 < MT);
            }
            SB_;
#pragma unroll
            for (int mm = 0; mm < 2; ++mm) if (m0 + mm < MT) {
#pragma unroll
                for (int s2 = 0; s2 < NS2; ++s2) P[m0 + mm] = __builtin_amdgcn_mfma_f32_16x16x32_bf16(fa2[mm][s2], vb[s2], P[m0 + mm], 0, 0, 0);
            }
            SB_;
        }
        {
            const float eg = __expf(gl);
#pragma unroll
            for (int d0 = 0; d0 < 8; d0 += 2) {
                ld_tr(0, d0); ld_tr(0, d0 + 1);
                SB_;
#pragma unroll
                for (int dt = d0; dt < d0 + 2; ++dt) {
                    S[dt] = S[dt] * eg;
#pragma unroll
                    for (int s2 = 0; s2 < NS2; ++s2) S[dt] = __builtin_amdgcn_mfma_f32_16x16x32_bf16(fs[0][dt & 1][s2], vdb[s2], S[dt], 0, 0, 0);
                }
                SB_;
            }
        }
#pragma unroll
        for (int mt = 0; mt < MT; ++mt) {
            f32x4 qv;
#pragma unroll
            for (int r = 0; r < 4; ++r) { qv[r] = row16_sum(P[mt][r] * P[mt][r]); QS[(16 * mt + 4 * fq + r) * 136 + dv] = f2bf(P[mt][r]); }
            if (fr < 4) OSS[(16 * mt + 4 * fq + fr) * 8 + wave] = (fr == 0) ? qv[0] : (fr == 1) ? qv[1] : (fr == 2) ? qv[2] : qv[3];
        }
        if (c + 2 < nch) load_chunk(c + 2);
    }
#undef SB_
    __syncthreads();
    {
        const int rowl = SMP ? NPROMPT + sq * 8 : sq * SEQ + 64 * (nch - 1);
        const LAS bf16_t* OSl = (const LAS bf16_t*)(L + ((nch - 1) & 1) * BUFB + 17408);
#pragma unroll
        for (int q = 0; q < 2; ++q) {
            const int idx = tid + 512 * q, r = idx >> 4, ch = idx & 15;
            if (idx < NR * 16 && r < NV && !dry) *(u32x4*)(Z1 + (size_t)(rowl + r) * ZW + 1024 + h * 128 + ch * 8) = gdn_norm8(*(const LAS u32x4*)(OSl + r * 136 + ch * 8), OSS + r * 8, nw8);
        }
    }
    float* So = a.out + (SMP ? O_SGS : O_PGS) + (size_t)(sq * 8 + h) * 16384;
#pragma unroll
    for (int dt = 0; dt < 8; ++dt)
#pragma unroll
        for (int r = 0; r < 4; ++r) So[(size_t)(16 * dt + 4 * fq + r) * 128 + dv] = S[dt][r];
    __syncthreads();
}

__device__ __forceinline__ void lru_unit(const Args& a, LAS unsigned char* L, bool smp, int bidx, int g, const bool dry) {
    const int tid = threadIdx.x, lane = tid & 63, wave = __builtin_amdgcn_readfirstlane(tid >> 6), fr = lane & 15, fq = lane >> 4;
    LAS float* XC = (LAS float*)(L);
    LAS bf16_t* XB = (LAS bf16_t*)(L + 33792);
    LAS bf16_t* HS = (LAS bf16_t*)(L + 51200);
    LAS bf16_t* RW = (LAS bf16_t*)(L + 68608);
    LAS bf16_t* SH = (LAS bf16_t*)(L + 86832);
    LAS float* CWL = (LAS float*)(L + 93360);
    bf16_t* Z1 = (bf16_t*)(a.ws + WS_Z1);
    const bf16_t* WAT = (const bf16_t*)(a.ws + WS_WA) + (size_t)g * 16384;
    const bf16_t* WXT = (const bf16_t*)(a.ws + WS_WX) + (size_t)g * 16384;
    const float* cw = a.in[9]; const float* cb = a.in[10];
    const int c = 16 * wave + fr, col = g * 128 + c;
    const float ba = a.in[12][col], bx = a.in[14][col];
    const float al = a.in[15][col];
    const float ls = -(al > 0.f ? log1pf(expf(-al)) : (log1pf(expf(al)) - al));
    bf16x8 Bwa[4], Bwx[4];
#pragma unroll
    for (int ks = 0; ks < 4; ++ks) { Bwa[ks] = *(const bf16x8*)(WAT + (size_t)c * 128 + 32 * ks + 8 * fq); Bwx[ks] = *(const bf16x8*)(WXT + (size_t)c * 128 + 32 * ks + 8 * fq); }
    const int ntile = smp ? 1 : 32;
    float carry = 0.f;
    const int t = tid >> 3, p = tid & 7, cc0 = 16 * p, gc0 = g * 128 + cc0;
    for (int idx = tid; idx < 640; idx += 512) { const int i = idx >> 7, cc = idx & 127; CWL[idx] = (i < 4) ? cw[(size_t)i * 1024 + g * 128 + cc] : cb[g * 128 + cc]; }
    if (smp) { for (int idx = tid; idx < 3072; idx += 512) { const int sr = idx >> 7, cc = idx & 127; SH[sr * 136 + cc] = f2bf(a.in[2][(size_t)(bidx * 24 + sr) * 1024 + g * 128 + cc]); } }
    const int row00 = smp ? NPROMPT + bidx * 64 : bidx * SEQ;
    LAS bf16_t* RW2 = (LAS bf16_t*)(L + 95920);
    u32x4 nx0 = *(const u32x4*)(Z1 + (size_t)(row00 + t) * ZW + gc0), nx1 = *(const u32x4*)(Z1 + (size_t)(row00 + t) * ZW + gc0 + 8);
    u32x4 pv0 = (u32x4){0u, 0u, 0u, 0u}, pv1 = pv0;
    *(LAS u32x4*)(RW + (3 + t) * 136 + cc0) = nx0; *(LAS u32x4*)(RW + (3 + t) * 136 + cc0 + 8) = nx1;
    if (t >= 61) { *(LAS u32x4*)(RW + (t - 61) * 136 + cc0) = pv0; *(LAS u32x4*)(RW + (t - 61) * 136 + cc0 + 8) = pv1; }
    pv0 = nx0; pv1 = nx1;
    if (ntile > 1) { nx0 = *(const u32x4*)(Z1 + (size_t)(row00 + 64 + t) * ZW + gc0); nx1 = *(const u32x4*)(Z1 + (size_t)(row00 + 64 + t) * ZW + gc0 + 8); }
    for (int j = 0; j < ntile; ++j) {
        const int rowt = row00 + 64 * j;
        const LAS bf16_t* RWc = (j & 1) ? RW2 : RW;
        __syncthreads();
        {
            float y[16];
#pragma unroll
            for (int q = 0; q < 4; ++q) { const f32x4 f = *(const LAS f32x4*)(CWL + 512 + cc0 + 4 * q); y[4 * q] = f.x; y[4 * q + 1] = f.y; y[4 * q + 2] = f.z; y[4 * q + 3] = f.w; }
#pragma unroll
            for (int i = 0; i < 4; ++i) {
                const int ts8 = (t & 7) - 3 + i;
                const LAS bf16_t* rp = ((smp && ts8 < 0) ? SH + ((t >> 3) * 3 + ts8 + 3) * 136 : RWc + (t + i) * 136) + cc0;
                float xv[16];
                const u32x4 w0 = *(const LAS u32x4*)rp, w1 = *(const LAS u32x4*)(rp + 8); unpack8(w0, xv); unpack8(w1, xv + 8);
#pragma unroll
                for (int q = 0; q < 4; ++q) { const f32x4 f = *(const LAS f32x4*)(CWL + i * 128 + cc0 + 4 * q); y[4 * q] += f.x * xv[4 * q]; y[4 * q + 1] += f.y * xv[4 * q + 1]; y[4 * q + 2] += f.z * xv[4 * q + 2]; y[4 * q + 3] += f.w * xv[4 * q + 3]; }
            }
#pragma unroll
            for (int q = 0; q < 4; ++q) *(LAS f32x4*)(XC + t * 132 + cc0 + 4 * q) = (f32x4){y[4 * q], y[4 * q + 1], y[4 * q + 2], y[4 * q + 3]};
            *(LAS u32x4*)(XB + t * 136 + cc0) = pack8(y); *(LAS u32x4*)(XB + t * 136 + cc0 + 8) = pack8(y + 8);
        }
        if (j > 0 && !dry) {
#pragma unroll
            for (int q = 0; q < 2; ++q) {
                const int idx = tid + 512 * q, r = idx >> 4, ch = idx & 15;
                *(u32x4*)(Z1 + (size_t)(rowt - 64 + r) * ZW + g * 128 + ch * 8) = *(const LAS u32x4*)(HS + r * 136 + ch * 8);
            }
        }
        __syncthreads();
        f32x4 R[4], I[4];
#pragma unroll
        for (int mt = 0; mt < 4; ++mt) {
            bf16x8 fx[4];
#pragma unroll
            for (int ks = 0; ks < 4; ++ks) fx[ks] = *(const LAS bf16x8*)(XB + (16 * mt + fr) * 136 + 32 * ks + 8 * fq);
            __builtin_amdgcn_sched_barrier(0);
            R[mt] = (f32x4){0.f, 0.f, 0.f, 0.f}; I[mt] = (f32x4){0.f, 0.f, 0.f, 0.f};
#pragma unroll
            for (int ks = 0; ks < 4; ++ks) {
                R[mt] = __builtin_amdgcn_mfma_f32_16x16x32_bf16(fx[ks], Bwa[ks], R[mt], 0, 0, 0);
                I[mt] = __builtin_amdgcn_mfma_f32_16x16x32_bf16(fx[ks], Bwx[ks], I[mt], 0, 0, 0);
            }
            __builtin_amdgcn_sched_barrier(0);
        }
        float xc_[4][4];
#pragma unroll
        for (int mt = 0; mt < 4; ++mt)
#pragma unroll
            for (int r = 0; r < 4; ++r) xc_[mt][r] = XC[(16 * mt + 4 * fq + r) * 132 + c];
        __builtin_amdgcn_sched_barrier(0);
        float av[4][4], bv[4][4], Al[4], Bl[4];
#pragma unroll
        for (int mt = 0; mt < 4; ++mt) {
            Al[mt] = 1.f; Bl[mt] = 0.f;
#pragma unroll
            for (int r = 0; r < 4; ++r) {
                const int i = 16 * mt + 4 * fq + r;
                const float rr = sigmoidf_(R[mt][r] + ba);
                const float ig = sigmoidf_(I[mt][r] + bx);
                const float la = 8.f * rr * ls;
                float aa = __expf(la), mult = __builtin_amdgcn_sqrtf(fmaxf(fmaf(-aa, aa, 1.f), 0.f));
                if (!smp && j == 0 && i == 0) { aa = 0.f; mult = 1.f; }
                av[mt][r] = aa; bv[mt][r] = mult * ig * xc_[mt][r];
                Bl[mt] = aa * Bl[mt] + bv[mt][r]; Al[mt] *= aa;
            }
        }
        float Ag[4][4], Bg[4][4];
#pragma unroll
        for (int mt = 0; mt < 4; ++mt)
#pragma unroll
            for (int q = 0; q < 4; ++q) { Ag[mt][q] = __shfl(Al[mt], fr + 16 * q); Bg[mt][q] = __shfl(Bl[mt], fr + 16 * q); }
        float h0v[4] = {0.f, 0.f, 0.f, 0.f};
        if (smp) {
#pragma unroll
            for (int mt = 0; mt < 4; ++mt) h0v[mt] = a.in[3][(size_t)(bidx * 8 + 2 * mt + (fq >> 1)) * 1024 + col];
        }
#pragma unroll
        for (int mt = 0; mt < 4; ++mt) {
            float hin;
            if (smp) {
                hin = h0v[mt];
                const float A_ = (fq == 1) ? Ag[mt][0] : Ag[mt][2], B_ = (fq == 1) ? Bg[mt][0] : Bg[mt][2];
                hin = (fq & 1) ? A_ * hin + B_ : hin;
            } else {
                hin = carry;
#pragma unroll
                for (int q = 0; q < 3; ++q) hin = (q < fq) ? Ag[mt][q] * hin + Bg[mt][q] : hin;
#pragma unroll
                for (int q = 0; q < 4; ++q) carry = Ag[mt][q] * carry + Bg[mt][q];
            }
#pragma unroll
            for (int r = 0; r < 4; ++r) { hin = av[mt][r] * hin + bv[mt][r]; HS[(16 * mt + 4 * fq + r) * 136 + c] = f2bf(hin); }
            if (smp) { if (fq & 1) a.out[O_SLH + (size_t)(bidx * 8 + 2 * mt + (fq >> 1)) * 1024 + col] = hin; }
            else if (j == ntile - 1 && mt == 3 && fq == 3) a.out[O_PLH + (size_t)bidx * 1024 + col] = hin;
        }
        if (j + 1 < ntile) {
            LAS bf16_t* RWn = (j & 1) ? RW : RW2;
            *(LAS u32x4*)(RWn + (3 + t) * 136 + cc0) = nx0; *(LAS u32x4*)(RWn + (3 + t) * 136 + cc0 + 8) = nx1;
            if (t >= 61) { *(LAS u32x4*)(RWn + (t - 61) * 136 + cc0) = pv0; *(LAS u32x4*)(RWn + (t - 61) * 136 + cc0 + 8) = pv1; }
            pv0 = nx0; pv1 = nx1;
            if (j + 2 < ntile) { nx0 = *(const u32x4*)(Z1 + (size_t)(rowt + 128 + t) * ZW + gc0); nx1 = *(const u32x4*)(Z1 + (size_t)(rowt + 128 + t) * ZW + gc0 + 8); }
        }
    }
    __syncthreads();
    {
        const int rowl = row00 + 64 * (ntile - 1);
#pragma unroll
        for (int q = 0; q < 2; ++q) {
            const int idx = tid + 512 * q, r = idx >> 4, ch = idx & 15;
            if (!dry) *(u32x4*)(Z1 + (size_t)(rowl + r) * ZW + g * 128 + ch * 8) = *(const LAS u32x4*)(HS + r * 136 + ch * 8);
        }
    }
    __syncthreads();
}

#define XB_TMO      128
#define XB_XCNT(j)  (256  + 64 * (j))
#define XB_XSUB(j)  (1280 + 64 * (j))
#define XB_XGEN(j)  (2304 + 64 * (j))
#define XB_TOP      3328
#define XB_TOPGEN   3392
#define XCD_BAR_WORDS 3456
#define XB_SPIN_CAP (1u << 22)
__device__ __forceinline__ unsigned xb_ld(unsigned* p)              { return __hip_atomic_load(p, __ATOMIC_RELAXED, __HIP_MEMORY_SCOPE_AGENT); }
__device__ __forceinline__ unsigned xb_add(unsigned* p, unsigned v) { return __hip_atomic_fetch_add(p, v, __ATOMIC_RELAXED, __HIP_MEMORY_SCOPE_AGENT); }
__device__ __forceinline__ unsigned xb_xcc_id() { return (unsigned)__builtin_amdgcn_s_getreg((3 << 11) | 20) & 0xFu; }
#define XB_SPIN(cond, bar) do { unsigned _sp = 0; while (cond) { __builtin_amdgcn_s_sleep(1); \
    if ((++_sp & 255u) == 0u) { if (xb_ld(&(bar)[XB_TMO])) break; if (_sp > XB_SPIN_CAP) { atomicAdd(&(bar)[XB_TMO], 1u); break; } } } } while (0)
struct XcdBarrier { unsigned* bar; unsigned x; volatile LAS unsigned* st; unsigned G; };
__device__ __forceinline__ XcdBarrier xcd_barrier_post(unsigned* bar, volatile LAS unsigned* st) {
    XcdBarrier b; b.bar = bar; b.x = xb_xcc_id(); b.st = st; b.G = 0u;
    if (threadIdx.x == 0) (void)xb_add(&bar[XB_XCNT(b.x)], 1u);
    return b;
}
__device__ __forceinline__ void xcd_barrier_complete(unsigned* bar, unsigned x, unsigned& nloc, unsigned& nx, const unsigned G) {
    unsigned sum, cnt, mine, sp = 0u;
    for (;;) {
        sum = 0u; cnt = 0u; mine = 0u;
#pragma unroll
        for (unsigned j = 0; j < 16; ++j) { const unsigned c = xb_ld(&bar[XB_XCNT(j)]); sum += c; cnt += (c > 0u) ? 1u : 0u; mine = (j == x) ? c : mine; }
        if (sum == G) break;
        __builtin_amdgcn_s_sleep(1);
        if ((++sp & 255u) == 0u) { if (xb_ld(&bar[XB_TMO])) break; if (sp > XB_SPIN_CAP) { atomicAdd(&bar[XB_TMO], 1u); break; } }
    }
    nloc = mine > 0u ? mine : 1u; nx = cnt > 0u ? cnt : 1u;
}
__device__ __forceinline__ void xcd_barrier(const XcdBarrier& b) {
    asm volatile("s_waitcnt vmcnt(0)" ::: "memory");
    __syncthreads();
    if (threadIdx.x == 0) {
        unsigned* bar = b.bar;
        __builtin_amdgcn_s_waitcnt(0);
        unsigned nloc = b.st[0], nx = b.st[1];
        if (nloc == 0u) { xcd_barrier_complete(bar, b.x, nloc, nx, b.G); b.st[0] = nloc; b.st[1] = nx; }
        const unsigned old = xb_add(&bar[XB_XSUB(b.x)], 1u);
        const unsigned gen = old / nloc;
        if (old + 1u == (gen + 1u) * nloc) {
            __builtin_amdgcn_fence(__ATOMIC_RELEASE, "agent");
            asm volatile("s_waitcnt vmcnt(0)" ::: "memory");
            const unsigned og = xb_add(&bar[XB_TOP], 1u);
            const unsigned tg = og / nx;
            if (og + 1u == (tg + 1u) * nx) xb_add(&bar[XB_TOPGEN], 1u);
            else XB_SPIN(xb_ld(&bar[XB_TOPGEN]) == tg, bar);
            __builtin_amdgcn_fence(__ATOMIC_ACQUIRE, "agent");
            xb_add(&bar[XB_XGEN(b.x)], 1u);
            asm volatile("s_waitcnt vmcnt(0)" ::: "memory");
        } else {
            XB_SPIN(xb_ld(&bar[XB_XGEN(b.x)]) == gen, bar);
            __builtin_amdgcn_fence(__ATOMIC_ACQUIRE, "agent");
            asm volatile("s_waitcnt vmcnt(0)" ::: "memory");
        }
    }
    __syncthreads();
}

#ifndef DRY3_SKIP
#define DRY3_SKIP 0
#endif
__device__ __forceinline__ void p3_scans(const Args& a, LAS unsigned char* L, const bool dry) {
    if (!(dry && (DRY3_SKIP & 1))) for (int u = blockIdx.x; u < 64; u += gridDim.x) gdn_scan_unit<4>(a, L, u >> 3, u & 7, dry);
    if (!(dry && (DRY3_SKIP & 2))) for (int u = blockIdx.x; u < 128; u += gridDim.x) if (u >= 64) lru_unit(a, L, false, (u - 64) >> 3, (u - 64) & 7, dry);
    if (gridDim.x >= 256) {
        const int nb = gridDim.x - 128, b = blockIdx.x - 128;
        if (b >= 0) {
#define SUBBAR() do { XcdBarrier xb_; xb_.bar = (unsigned*)(a.ws + WS_BAR) + 4096; xb_.x = xb_xcc_id(); xb_.st = (volatile LAS unsigned*)(L + LDS_BYTES - 56); xb_.G = 128u; xcd_barrier(xb_); } while (0)
            if (b < 64) {
                const pg8::Gemm g1{(const bf16_t*)(a.ws + WS_U), (const bf16_t*)(a.ws + WS_W1T), NROWS, 4096, 1024, 1024};
                const pg8::Epi<0> E1{(bf16_t*)(a.ws + WS_Z1), (bf16_t*)(a.ws + WS_HALO), a.out};
                const pg8::SeqOrder S1{b, 0, 1, 2};
                pg8::gemm_phase(L, g1, S1, E1);
            }
            SUBBAR();
            p2_gdn_local(a, L, false, 2048 + b, 128, 1);
            SUBBAR();
#undef SUBBAR
            if (!(dry && (DRY3_SKIP & 8))) for (int u = b; u < 128; u += nb) lru_unit(a, L, true, u >> 3, u & 7, dry);
            if (!(dry && (DRY3_SKIP & 4))) for (int u = b; u < 1024; u += nb) gdn_scan_unit<1>(a, L, u >> 3, u & 7, dry);
            pg8::Gemm gm{(const bf16_t*)(a.ws + WS_U), (const bf16_t*)(a.ws + WS_W2T) + (size_t)2048 * 1024, NROWS, 1280, 1024, 1024};
            pg8::StaticOrder Sm; Sm.init(NROWS, 1280, nb, b);
            pg8::Epi<5> Em{nullptr, nullptr, a.out};
            pg8::gemm_phase(L, gm, Sm, Em);
        }
    } else {
        {
            pg8::Gemm gm{(const bf16_t*)(a.ws + WS_U), (const bf16_t*)(a.ws + WS_W2T) + (size_t)2048 * 1024, NROWS, 1280, 1024, 1024};
            pg8::StaticOrder Sm; Sm.init(NROWS, 1280, gridDim.x, blockIdx.x);
            pg8::Epi<5> Em{nullptr, nullptr, a.out};
            pg8::gemm_phase(L, gm, Sm, Em);
        }
        for (int u = blockIdx.x; u < 1152; u += gridDim.x) if (u >= 128) gdn_scan_unit<1>(a, L, (u - 128) >> 3, (u - 128) & 7, dry);
        for (int u = blockIdx.x; u < 1280; u += gridDim.x) if (u >= 1152) lru_unit(a, L, true, (u - 1152) >> 3, (u - 1152) & 7, dry);
    }
}

__device__ __forceinline__ void p7_final(const Args& a, const int row_lo, const int row_hi, const int wblk, const int nblk) {
    const int tid = threadIdx.x, lane = tid & 63, wave = tid >> 6;
    const int gw = row_lo + wblk * 8 + wave, NGW = nblk * 8;
    const float* gain = a.in[7];
    f32x4 gn[4];
#pragma unroll
    for (int j = 0; j < 4; ++j) gn[j] = ((const f32x4*)gain)[lane + 64 * j];
    for (int m = gw; m < row_hi; m += NGW) {
        const float* xr = (m < NPROMPT) ? a.in[0] + (size_t)m * DM : a.in[1] + (size_t)(m - NPROMPT) * DM;
        float* yr = a.out + (size_t)m * DM;
        f32x4 v[4]; float s = 0.f;
#pragma unroll
        for (int j = 0; j < 4; ++j) { v[j] = ((const f32x4*)yr)[lane + 64 * j]; s += (v[j].x * v[j].x + v[j].y * v[j].y) + (v[j].z * v[j].z + v[j].w * v[j].w); }
        const float rs = rsqrtf(wave_sum(s) * (1.f / DM) + EPS);
#pragma unroll
        for (int j = 0; j < 4; ++j) { const f32x4 x = ((const f32x4*)xr)[lane + 64 * j]; ((f32x4*)yr)[lane + 64 * j] = x + v[j] * rs * gn[j]; }
    }
}


__global__ void __launch_bounds__(512, 2) hawk_gdn_fwd(Args a) {
    extern __shared__ __attribute__((aligned(16))) unsigned char lds_raw[];
    LAS unsigned char* L = (LAS unsigned char*)lds_raw;
    cg::grid_group grid = cg::this_grid();
    volatile LAS unsigned* xst = (volatile LAS unsigned*)(L + LDS_BYTES - 64);
    if (threadIdx.x < 4) xst[threadIdx.x] = 0u;
    __syncthreads();
    (void)xcd_barrier_post((unsigned*)(a.ws + WS_BAR), xst);
    if (blockIdx.x >= 128) (void)xcd_barrier_post((unsigned*)(a.ws + WS_BAR) + 4096, xst + 2);
    if (a.flags == 0x7fffffff) grid.sync();
    unsigned char* ws = a.ws;
    bf16_t* Z1 = (bf16_t*)(ws + WS_Z1); bf16_t* U = (bf16_t*)(ws + WS_U);
    const int lo = a.ph_lo, hi = a.ph_hi;
#ifndef PH_MASK
#define PH_MASK 0xff
#endif
#define IN(k) (((PH_MASK >> (k)) & 1) && lo <= (k) && (k) < hi)
#define SEAM(k) do { if (IN(k) && IN((k) + 1)) { XcdBarrier xb_; xb_.bar = (unsigned*)(a.ws + WS_BAR); xb_.x = xb_xcc_id(); xb_.st = (volatile LAS unsigned*)(L + LDS_BYTES - 64); xb_.G = gridDim.x; xcd_barrier(xb_); } } while (0)
#ifndef REP0
#define REP0 1
#endif
#ifndef REP1
#define REP1 1
#endif
#ifndef REP6
#define REP6 1
#endif
    if (IN(0)) p0_prologue(a, L);
    SEAM(0);
    if (IN(1)) {
        pg8::Gemm g{U, (const bf16_t*)(ws + WS_W1T), NROWS, 4096, 1024, 1024}; pg8::StaticOrder S; S.init(NPROMPT, 4096, gridDim.x, blockIdx.x);
        pg8::Epi<0> E{Z1, (bf16_t*)(ws + WS_HALO), a.out};
        pg8::gemm_phase(L, g, S, E);
    }
    SEAM(1);
    if (IN(2)) p2_gdn_local(a, L, false, blockIdx.x, 256, 8);
    SEAM(2);
    if (IN(3)) p3_scans(a, L, false);
    SEAM(3);
    if (IN(4)) {
        pg8::Gemm g{U, (const bf16_t*)(ws + WS_W2T), NROWS, 2048, 1024, 1024}; pg8::StaticOrder S; S.init(NROWS, 2048, gridDim.x, blockIdx.x);
        pg8::Epi<1> E{Z1, nullptr, a.out};
        pg8::gemm_phase(L, g, S, E);
        if (blockIdx.x >= 32) {
            pg8::Gemm gm{U, (const bf16_t*)(ws + WS_W2T) + (size_t)(2048 + 1280) * 1024, NROWS, 768, 1024, 1024};
            pg8::StaticOrder Sm; Sm.init(NROWS, 768, gridDim.x - 32, blockIdx.x - 32);
            pg8::Epi<5> Em{nullptr, nullptr, (float*)((bf16_t*)a.out + 1280)};
            pg8::gemm_phase(L, gm, Sm, Em);
        }
    }
    SEAM(4);
    const int bid = blockIdx.x;
    const pg8::Gemm gA{Z1, (const bf16_t*)(ws + WS_WBL), NROWS, 1024, 1024, ZW};
    const pg8::Gemm gB{Z1 + 1024, (const bf16_t*)(ws + WS_WBG), NROWS, 1024, 1024, ZW};
    const pg8::Gemm gY{Z1 + 2048, (const bf16_t*)(ws + WS_WO), NROWS, 1024, 1024, ZW};
    const pg8::Epi<2> E2{Z1, nullptr, a.out}; const pg8::Epi<3> E3{Z1, nullptr, a.out}; const pg8::Epi<4> E4{Z1, nullptr, a.out};
    if (IN(5)) {
        const pg8::SeqOrder S{bid, 0, 1, 0};
        pg8::gemm_phase(L, gA, S, E2);
        pg8::gemm_phase(L, gB, S, E3);
    }
    SEAM(5);
    if (IN(6)) {
        if (bid < 16) { const pg8::SeqOrder S{bid, 0, 1, 1}; pg8::gemm_phase(L, gA, S, E2); pg8::gemm_phase(L, gB, S, E3); }
        else { const int d = bid - 16; const pg8::SeqOrder S{d, 240, (d < 16) ? 2 : 1, 0}; pg8::gemm_phase(L, gY, S, E4); }
    }
    SEAM(6);
    if (IN(7)) {
        if (bid < 16) { const pg8::SeqOrder S{bid, 0, 1, 1}; pg8::gemm_phase(L, gY, S, E4); }
        else p7_final(a, 0, NPROMPT, bid - 16, 240);
        { XcdBarrier xb_; xb_.bar = (unsigned*)(a.ws + WS_BAR); xb_.x = xb_xcc_id(); xb_.st = (volatile LAS unsigned*)(L + LDS_BYTES - 64); xb_.G = gridDim.x; xcd_barrier(xb_); }
        p7_final(a, NPROMPT, NROWS, bid, 256);
    }
#undef IN
#undef SEAM
}

#ifndef N_LAUNCHES
#define N_LAUNCHES 1
#endif

extern "C" void kernel_launch(void* const* d_in, const int* in_sizes, int n_in, void* d_out, int out_size, void* d_ws, size_t ws_size, hipStream_t stream) {
    static int grid = 0;
    if (grid == 0) {
        if (n_in != 23 || ws_size < WS_END) { fprintf(stderr, "kernel_launch: unexpected inputs (n_in %d, ws %zu)\n", n_in, ws_size); grid = -1; return; }
        int dev = 0, cus = 0, per_cu = 0;
        hipGetDevice(&dev);
        hipDeviceGetAttribute(&cus, hipDeviceAttributeMultiprocessorCount, dev);
        if (hipFuncSetAttribute((const void*)hawk_gdn_fwd, hipFuncAttributeMaxDynamicSharedMemorySize, LDS_BYTES) != hipSuccess) { fprintf(stderr, "kernel_launch: hipFuncSetAttribute failed\n"); }
        if (hipOccupancyMaxActiveBlocksPerMultiprocessor(&per_cu, (const void*)hawk_gdn_fwd, 512, LDS_BYTES) != hipSuccess || per_cu < 1) { fprintf(stderr, "kernel_launch: occupancy query says %d\n", per_cu); per_cu = 1; }
        (void)hipGetLastError();
        grid = 256;
        if (grid <= 0) grid = 256;
    }
    if (grid < 0) return;
    if (hipMemsetAsync((char*)d_ws + WS_BAR, 0, 32768, stream) != hipSuccess) { fprintf(stderr, "kernel_launch: memset of barrier words failed\n"); return; }
    Args a{};
    for (int i = 0; i < 23; ++i) a.in[i] = (const float*)d_in[i];
    a.out = (float*)d_out; a.ws = (unsigned char*)d_ws;
#ifndef PLAN
#define PLAN {0, 8, 0}
#endif
    const int plan[] = PLAN;
    const int nl = (int)(sizeof(plan) / sizeof(int)) / 3;
    for (int li = 0; li < nl; ++li) {
        a.ph_lo = plan[3 * li]; a.ph_hi = plan[3 * li + 1]; a.flags = plan[3 * li + 2];
        void* args[] = {&a};
        hipError_t e = hipLaunchCooperativeKernel((const void*)hawk_gdn_fwd, dim3(grid), dim3(512), args, LDS_BYTES, stream);
        if (e != hipSuccess) { fprintf(stderr, "kernel_launch: cooperative launch failed: %s (grid %d)\n", hipGetErrorString(e), grid); break; }
    }
}
```

```cpp
#include <hip/hip_runtime.h>
#include <hip/hip_cooperative_groups.h>
#include <cstdio>
#include <cstdint>
namespace cg = cooperative_groups;

#define LAS __attribute__((address_space(3)))
typedef unsigned short bf16_t;
typedef short bf16x8 __attribute__((ext_vector_type(8)));
typedef short s16x4 __attribute__((ext_vector_type(4)));
typedef float f32x4 __attribute__((ext_vector_type(4)));
typedef unsigned u32x4 __attribute__((ext_vector_type(4)));
typedef unsigned u32x2 __attribute__((ext_vector_type(2)));

constexpr int DM = 1024, NROWS = 17408, NPROMPT = 16384, SEQ = 2048;
constexpr int ZW = 4096;
constexpr float EPS = 1e-6f;
constexpr size_t O_Y = 0, O_PLC = 17825792, O_PLH = 17850368, O_PGC = 17858560, O_PGS = 17932288,
                 O_SLC = 18980864, O_SLH = 19374080, O_SGC = 19505152, O_SGS = 20684800;
constexpr size_t MiB = 1u << 20;
constexpr size_t WS_W1T = 0, WS_W2T = 8 * MiB, WS_WBL = 16 * MiB, WS_WBG = 18 * MiB, WS_WO = 20 * MiB, WS_WA = 22 * MiB, WS_WX = 22 * MiB + 262144,
                 WS_BG = 23 * MiB, WS_GC = 25 * MiB, WS_HALO = 26 * MiB, WS_TINV = 31 * MiB, WS_AQK = 48 * MiB, WS_U = 65 * MiB, WS_Z1 = 99 * MiB, WS_BAR = 235 * MiB, WS_END = 236 * MiB;
constexpr int LDS_BYTES = 147456;

struct Args { const float* in[23]; float* out; unsigned char* ws; int ph_lo, ph_hi, flags, pad; };

typedef float f32x2_t __attribute__((ext_vector_type(2)));
typedef __bf16 bf16x2_t __attribute__((ext_vector_type(2)));
__device__ __forceinline__ unsigned cvt_pk_bf16(float lo, float hi) { f32x2_t v = {lo, hi}; bf16x2_t b = __builtin_convertvector(v, bf16x2_t); return __builtin_bit_cast(unsigned, b); }
__device__ __forceinline__ unsigned cvt_pk_bf16_asm(float lo, float hi) { unsigned r; asm volatile("v_cvt_pk_bf16_f32 %0, %1, %2" : "=v"(r) : "v"(lo), "v"(hi)); return r; }
__device__ __forceinline__ float bflo(unsigned w) { return __uint_as_float(w << 16); }
__device__ __forceinline__ float bfhi(unsigned w) { return __uint_as_float(w & 0xffff0000u); }
__device__ __forceinline__ float bf1(bf16_t b) { return __uint_as_float((unsigned)b << 16); }
__device__ __forceinline__ bf16_t f2bf(float f) { return (bf16_t)(cvt_pk_bf16(f, 0.f) & 0xffffu); }
__device__ __forceinline__ float sigmoidf_(float x) { return __builtin_amdgcn_rcpf(1.f + __expf(-x)); }
__device__ __forceinline__ float siluf_(float x) { return x * sigmoidf_(x); }
template <int CTRL> __device__ __forceinline__ float dpp_mov(float v) { return __int_as_float(__builtin_amdgcn_update_dpp(0, __float_as_int(v), CTRL, 0xF, 0xF, true)); }
__device__ __forceinline__ float row16_sum(float v) { v += dpp_mov<0xB1>(v); v += dpp_mov<0x4E>(v); v += dpp_mov<0x141>(v); v += dpp_mov<0x140>(v); return v; }
__device__ __forceinline__ float wave_sum(float v) {
    v = row16_sum(v);
    v += __shfl_xor(v, 16); v += __shfl_xor(v, 32);
    return v;
}
__device__ __forceinline__ void unpack8(const u32x4 w, float* f) {
    f[0] = bflo(w.x); f[1] = bfhi(w.x); f[2] = bflo(w.y); f[3] = bfhi(w.y); f[4] = bflo(w.z); f[5] = bfhi(w.z); f[6] = bflo(w.w); f[7] = bfhi(w.w);
}
__device__ __forceinline__ u32x4 pack8(const float* f) {
    u32x4 w; w.x = cvt_pk_bf16(f[0], f[1]); w.y = cvt_pk_bf16(f[2], f[3]); w.z = cvt_pk_bf16(f[4], f[5]); w.w = cvt_pk_bf16(f[6], f[7]); return w;
}
__device__ __forceinline__ bf16x8 pack_frag(const f32x4 a, const f32x4 b) {
    u32x4 w; w.x = cvt_pk_bf16(a[0], a[1]); w.y = cvt_pk_bf16(a[2], a[3]); w.z = cvt_pk_bf16(b[0], b[1]); w.w = cvt_pk_bf16(b[2], b[3]);
    return __builtin_bit_cast(bf16x8, w);
}
__device__ __forceinline__ bf16x8 lda_perm(const LAS bf16_t* rowp, int s, int fq, bool second) {
    if (second) return *(const LAS bf16x8*)(rowp + 32 * s + 8 * fq);
    const u32x2 lo = *(const LAS u32x2*)(rowp + 32 * s + 8 * fq);
    u32x4 w; w.x = lo.x; w.y = lo.y; w.z = 0u; w.w = 0u; return __builtin_bit_cast(bf16x8, w);
}
__device__ __forceinline__ void st_perm(LAS bf16_t* rowp, int ch, const u32x4 v) {
    const int c4 = ch & 3, f = 32 * (ch >> 2) + (c4 & 1) * 16 + (c4 >> 1) * 4;
    *(LAS u32x2*)(rowp + f) = (u32x2){v.x, v.y};
    *(LAS u32x2*)(rowp + f + 8) = (u32x2){v.z, v.w};
}
__device__ __forceinline__ s16x4 lds_tr(const LAS bf16_t* p) { return __builtin_bit_cast(s16x4, __builtin_amdgcn_ds_read_tr16_b64_v4i16((LAS s16x4*)p)); }

namespace pg8 {
constexpr int BM = 256, BK = 64, HALF = 128, HTB = HALF * BK * 2, STAGE_BYTES = 8 * HTB, NXCD = 8, WGM = 8;
__host__ __device__ __forceinline__ int lds_byte(int r, int c) { const int st = (r >> 4) * 2 + (c >> 5), rr = r & 15, cc = c & 31, ob = rr * 64 + cc * 2; return st * 1024 + (ob ^ (((ob >> 9) & 1) << 5)); }
__host__ __device__ __forceinline__ void stage_rc(int b, int& R, int& C) { const int st = b / 1024, sb = b % 1024, swz = sb ^ (((sb >> 9) & 1) << 5); R = (st >> 1) * 16 + swz / 64; C = (st & 1) * 32 + (swz % 64) / 2; }
__host__ __device__ __forceinline__ int perm32(int rho) { const int n = rho >> 4, i = rho & 15; return 8 * (i >> 2) + 4 * n + (i & 3); }
struct Unit { int pm, pn; };
struct Gemm { const bf16_t* A; const bf16_t* Bt; int M, N, K, lda; };
struct StaticOrder {
    int nM, nN, nwg, G, c, off, lim;
    __device__ void init(int M, int N, int G_, int c_) { nM = M / BM; nN = N / BM; nwg = nM * nN; G = G_; c = c_; off = 0; lim = 1 << 30; }
    __device__ bool next(int i, Unit& u) const {
        if (i >= lim) return false;
        const long L = (long)off + (long)i * G + c; if (L >= nwg) return false;
        int wgid = (int)L; { const int q = nwg / NXCD, r = nwg % NXCD, xcd = wgid % NXCD, off = wgid / NXCD; wgid = (xcd < r ? xcd * (q + 1) : r * (q + 1) + (xcd - r) * q) + off; }
        const int nig = WGM * nN, gid = wgid / nig, fm = gid * WGM, gsz = (nM - fm) < WGM ? (nM - fm) : WGM;
        u.pm = fm + ((wgid % nig) % gsz); u.pn = (wgid % nig) / gsz; return true;
    }
};
template <int MODE> struct Epi {
    static constexpr bool PERM = true;
    bf16_t* Z1; bf16_t* HALO; float* out;
    __device__ __forceinline__ void operator()(const f32x4 (&acc)[2][2][4][2], const Unit& u, int wr, int wc, int fr, int fq) const {
        const int col0 = u.pn * BM + wc * 32 + 8 * fq;
        if constexpr (MODE == 0 || MODE == 4 || MODE == 5) {
#pragma unroll
        for (int ai = 0; ai < 2; ++ai)
#pragma unroll
            for (int m = 0; m < 4; ++m) {
                const int row = u.pm * BM + ai * HALF + wr * 64 + m * 16 + fr;
                if constexpr (MODE == 0) {
                    bf16_t* rowp = Z1 + (size_t)row * ZW + col0;
                    const bool is_halo = (m == 3) && (fr >= 13) && (row < NPROMPT) && (u.pn >= 4);
                    int cs = -1; float* bl = nullptr; float* bg = nullptr;
                    if (row < NPROMPT) { const int t = row & (SEQ - 1); if (t >= SEQ - 3) { cs = t - (SEQ - 3); const int b = row >> 11; bl = out + O_PLC + (size_t)(b * 3 + cs) * 1024; bg = out + O_PGC + (size_t)(b * 3 + cs) * 3072; } }
                    else { const int t = row & 7; if (t >= 5) { cs = t - 5; const int s = (row - NPROMPT) >> 3; bl = out + O_SLC + (size_t)(s * 3 + cs) * 1024; bg = out + O_SGC + (size_t)(s * 3 + cs) * 3072; } }
#pragma unroll
                    for (int bj = 0; bj < 2; ++bj) {
                        const f32x4 v0 = acc[ai][bj][m][0], v1 = acc[ai][bj][m][1];
                        u32x4 w; w.x = cvt_pk_bf16(v0[0], v0[1]); w.y = cvt_pk_bf16(v0[2], v0[3]); w.z = cvt_pk_bf16(v1[0], v1[1]); w.w = cvt_pk_bf16(v1[2], v1[3]);
                        *(u32x4*)(rowp + bj * HALF) = w;
                        const int col = col0 + bj * HALF;
                        if (is_halo) *(u32x4*)(HALO + (size_t)((row >> 6) * 3 + (fr - 13)) * 3072 + (col - 1024)) = w;
                        if (cs >= 0) { float* d = (u.pn < 4) ? bl + col : bg + (col - 1024); *(f32x4*)d = v0; *(f32x4*)(d + 4) = v1; }
                    }
                } else if constexpr (MODE == 5) {
                    bf16_t* pp = (bf16_t*)out + (size_t)row * 2048 + col0;
#pragma unroll
                    for (int bj = 0; bj < 2; ++bj) {
                        const f32x4 v0 = acc[ai][bj][m][0], v1 = acc[ai][bj][m][1];
                        float o[8] = {v0[0], v0[1], v0[2], v0[3], v1[0], v1[1], v1[2], v1[3]};
#pragma unroll
                        for (int e = 0; e < 8; ++e) o[e] = sigmoidf_(o[e]);
                        *(u32x4*)(pp + bj * HALF) = pack8(o);
                    }
                } else {
                    float* rowp = out + (size_t)row * DM + col0;
#pragma unroll
                    for (int bj = 0; bj < 2; ++bj) { *(f32x4*)(rowp + bj * HALF) = acc[ai][bj][m][0]; *(f32x4*)(rowp + bj * HALF + 4) = acc[ai][bj][m][1]; }
                }
            }
        } else {
            const int cbase = (MODE == 1) ? col0 : 2048 + col0;
            const bool gate = (MODE == 1);
#pragma unroll
            for (int ai = 0; ai < 2; ++ai)
#pragma unroll
                for (int mh = 0; mh < 2; ++mh) {
                    u32x4 tv[2][2], sv[2][2];
#pragma unroll
                    for (int mm = 0; mm < 2; ++mm) {
                        const size_t rowi = (size_t)(u.pm * BM + ai * HALF + wr * 64 + (2 * mh + mm) * 16 + fr);
                        const bf16_t* rowp = Z1 + rowi * ZW + cbase;
                        const bf16_t* parkp = (const bf16_t*)out + rowi * 2048 + col0 + (MODE == 3 ? 1024 : 0);
#pragma unroll
                        for (int bj = 0; bj < 2; ++bj) {
                            if constexpr (MODE == 1) tv[mm][bj] = *(const u32x4*)(rowp + bj * HALF);
                            if constexpr (MODE == 2) tv[mm][bj] = *(const u32x4*)(parkp + bj * HALF);
                            if constexpr (MODE == 3) { tv[mm][bj] = *(const u32x4*)(rowp + bj * HALF); sv[mm][bj] = *(const u32x4*)(parkp + bj * HALF); }
                        }
                    }
#pragma unroll
                    for (int mm = 0; mm < 2; ++mm) {
                        const int m = 2 * mh + mm;
                        bf16_t* rowp = Z1 + (size_t)(u.pm * BM + ai * HALF + wr * 64 + m * 16 + fr) * ZW + cbase;
#pragma unroll
                        for (int bj = 0; bj < 2; ++bj) {
                            const f32x4 v0 = acc[ai][bj][m][0], v1 = acc[ai][bj][m][1];
                            float o[8] = {v0[0], v0[1], v0[2], v0[3], v1[0], v1[1], v1[2], v1[3]};
                            if constexpr (MODE == 1) {
                                if (gate) { float hf[8]; unpack8(tv[mm][bj], hf);
#pragma unroll
                                    for (int e = 0; e < 8; ++e) o[e] = siluf_(o[e]) * hf[e]; }
                                else {
#pragma unroll
                                    for (int e = 0; e < 8; ++e) o[e] = sigmoidf_(o[e]); }
                            } else if constexpr (MODE == 2) { float sf[8]; unpack8(tv[mm][bj], sf);
#pragma unroll
                                for (int e = 0; e < 8; ++e) o[e] *= sf[e];
                            } else { float tf[8], sf[8]; unpack8(tv[mm][bj], tf); unpack8(sv[mm][bj], sf);
#pragma unroll
                                for (int e = 0; e < 8; ++e) o[e] = tf[e] + sf[e] * o[e]; }
                            *(u32x4*)(rowp + bj * HALF) = pack8(o);
                        }
                    }
                }
        }
    }
};

struct SeqOrder {
    int base, step, n, smp;
    __device__ bool next(int i, Unit& u) const {
        if (i >= n) return false;
        const int t = base + i * step;
        if (smp == 2) { u.pm = 64 + (t >> 4); u.pn = t & 15; }
        else if (smp) { u.pm = 64 + (t >> 2); u.pn = t & 3; }
        else { u.pm = (t & 7) * 8 + ((t >> 3) >> 2); u.pn = (t >> 3) & 3; }
        return true;
    }
};
template <class EpiT, class SchedT>
__device__ __forceinline__ void gemm_phase(LAS unsigned char* lds, const Gemm g, const SchedT& S, const EpiT& E) {
    const int tid = threadIdx.x, wid = __builtin_amdgcn_readfirstlane(tid >> 6), lane = tid & 63, wr = wid >> 2, wc = wid & 3, fr = lane & 15, fq = lane >> 4;
    const int K = g.K, nt = K / BK, lda = g.lda;
    unsigned voffA[2], voffB[2];
#pragma unroll
    for (int i = 0; i < 2; ++i) { int R, C; stage_rc(tid * 16 + i * 8192, R, C); const int Rb = EpiT::PERM ? ((R & ~31) + perm32(R & 31)) : R;
        voffA[i] = (unsigned)(R * lda + C) * 2u; voffB[i] = (unsigned)(Rb * K + C) * 2u; }
    const size_t kstep = (size_t)(BK * 2);
    const size_t hsA = (size_t)HALF * lda * 2, hsB = (size_t)HALF * K * 2;
    const size_t tsA = 2 * hsA, tsB = 2 * hsB;
    const unsigned ldsw = (unsigned)wid * 1024u;
    const int aoff = lds_byte(wr * 64 + fr, fq * 8), boff = lds_byte(wc * 32 + fr, fq * 8);
#define PG8_SA(b, h) (((b) * 2 + (h)) * HTB)
#define PG8_SB(b, h) ((4 + (b) * 2 + (h)) * HTB)
#define PG8_STAGE(bufoff, gbase, voff) do { _Pragma("unroll") for (int _i = 0; _i < 2; ++_i) \
        __builtin_amdgcn_global_load_lds((const unsigned*)((const char*)(gbase) + (voff)[_i]), (LAS unsigned*)(lds + (bufoff) + ldsw + _i * 8192), 16, 0, 0); } while (0)
#define PG8_LDA(dst, b, h) do { _Pragma("unroll") for (int m = 0; m < 4; ++m) _Pragma("unroll") for (int k = 0; k < 2; ++k) dst[m][k] = *(const LAS bf16x8*)(lds + PG8_SA(b, h) + aoff + m * 2048 + k * 1024); } while (0)
#define PG8_LDB(dst, b, h) do { _Pragma("unroll") for (int n = 0; n < 2; ++n) _Pragma("unroll") for (int k = 0; k < 2; ++k) dst[n][k] = *(const LAS bf16x8*)(lds + PG8_SB(b, h) + boff + n * 2048 + k * 1024); } while (0)
#define PG8_MMA(ai, bj, At, Bt) do { __builtin_amdgcn_s_setprio(1); _Pragma("unroll") for (int m = 0; m < 4; ++m) _Pragma("unroll") for (int n = 0; n < 2; ++n) _Pragma("unroll") for (int k = 0; k < 2; ++k) \
        acc[ai][bj][m][n] = __builtin_amdgcn_mfma_f32_16x16x32_bf16(Bt[n][k], At[m][k], acc[ai][bj][m][n], 0, 0, 0); __builtin_amdgcn_s_setprio(0); } while (0)
#define PG8_WAIT_V(n) asm volatile("s_waitcnt vmcnt(" #n ")" ::: "memory")
#define PG8_WAIT_L(n) asm volatile("s_waitcnt lgkmcnt(" #n ")" ::: "memory")
#define PG8_BAR __builtin_amdgcn_s_barrier()
#define PG8_SCHED __builtin_amdgcn_sched_barrier(0)
    Unit cur, nxt; int ui = 0;
    if (!S.next(0, cur)) return;
    f32x4 acc[2][2][4][2];
#pragma unroll
    for (int a = 0; a < 2; ++a)
#pragma unroll
        for (int b = 0; b < 2; ++b)
#pragma unroll
            for (int m = 0; m < 4; ++m)
#pragma unroll
                for (int n = 0; n < 2; ++n) acc[a][b][m][n] = (f32x4){0.f, 0.f, 0.f, 0.f};
    bf16x8 At[4][2], B0[2][2], B1[2][2];
    const char* cA = (const char*)g.A + (size_t)cur.pm * tsA; const char* cB = (const char*)g.Bt + (size_t)cur.pn * tsB;
    PG8_STAGE(PG8_SB(0, 0), cB, voffB); PG8_STAGE(PG8_SB(0, 1), cB + hsB, voffB); PG8_STAGE(PG8_SA(0, 0), cA, voffA); PG8_STAGE(PG8_SA(0, 1), cA + hsA, voffA);
    if (wr == 1) PG8_BAR;
    PG8_WAIT_V(2); PG8_BAR;
    PG8_STAGE(PG8_SB(1, 0), cB + kstep, voffB); PG8_STAGE(PG8_SA(1, 0), cA + kstep, voffA); PG8_STAGE(PG8_SB(1, 1), cB + hsB + kstep, voffB);
    PG8_WAIT_V(6); PG8_BAR;
    for (;;) {
        const bool has_next = S.next(ui + 1, nxt);
        const char* nA = has_next ? (const char*)g.A + (size_t)nxt.pm * tsA : cA; const char* nB = has_next ? (const char*)g.Bt + (size_t)nxt.pn * tsB : cB;
        for (int t = 0; t < nt; t += 2) {
            const bool last = (t == nt - 2);
            const char* a1 = cA + (size_t)(t + 1) * kstep;
            const char* a2 = last ? nA : cA + (size_t)(t + 2) * kstep; const char* b2 = last ? nB : cB + (size_t)(t + 2) * kstep;
            const char* a3 = a2 + kstep; const char* b3 = b2 + kstep;
            PG8_LDB(B0, 0, 0); PG8_LDB(B1, 0, 1); PG8_SCHED; PG8_LDA(At, 0, 0); PG8_STAGE(PG8_SA(1, 1), a1 + hsA, voffA);
            PG8_WAIT_V(8); PG8_WAIT_L(0); PG8_BAR; PG8_MMA(0, 0, At, B0); PG8_MMA(0, 1, At, B1); PG8_BAR; PG8_SCHED;
            PG8_LDA(At, 0, 1); PG8_STAGE(PG8_SB(0, 0), b2, voffB); PG8_STAGE(PG8_SB(0, 1), b2 + hsB, voffB); PG8_STAGE(PG8_SA(0, 0), a2, voffA);
            PG8_WAIT_V(8); PG8_WAIT_L(0); PG8_BAR; PG8_MMA(1, 0, At, B0); PG8_MMA(1, 1, At, B1); PG8_BAR; PG8_SCHED;
            PG8_LDB(B0, 1, 0); PG8_LDB(B1, 1, 1); PG8_SCHED; PG8_LDA(At, 1, 0); PG8_STAGE(PG8_SA(0, 1), a2 + hsA, voffA);
            PG8_WAIT_V(8); PG8_WAIT_L(0); PG8_BAR; PG8_MMA(0, 0, At, B0); PG8_MMA(0, 1, At, B1); PG8_BAR; PG8_SCHED;
            PG8_LDA(At, 1, 1); PG8_STAGE(PG8_SB(1, 0), b3, voffB); PG8_STAGE(PG8_SB(1, 1), b3 + hsB, voffB); PG8_STAGE(PG8_SA(1, 0), a3, voffA);
            PG8_WAIT_V(8); PG8_WAIT_L(0); PG8_BAR; PG8_MMA(1, 0, At, B0); PG8_MMA(1, 1, At, B1); PG8_BAR; PG8_SCHED;
        }
        if (wr == 0) PG8_BAR;
        E(acc, cur, wr, wc, fr, fq);
        if (!has_next) break;
#pragma unroll
        for (int a = 0; a < 2; ++a)
#pragma unroll
            for (int b = 0; b < 2; ++b)
#pragma unroll
                for (int m = 0; m < 4; ++m)
#pragma unroll
                    for (int n = 0; n < 2; ++n) acc[a][b][m][n] = (f32x4){0.f, 0.f, 0.f, 0.f};
        cur = nxt; cA = nA; cB = nB; ++ui;
        if (wr == 1) PG8_BAR;
    }
    PG8_WAIT_V(0);
    PG8_BAR;
#undef PG8_SA
#undef PG8_SB
#undef PG8_STAGE
#undef PG8_LDA
#undef PG8_LDB
#undef PG8_MMA
#undef PG8_WAIT_V
#undef PG8_WAIT_L
#undef PG8_BAR
#undef PG8_SCHED
}
}

__device__ __forceinline__ void transpose_item(const float* W, int ldw, int src_col, bf16_t* WTrow, int k0, int lane) {
#pragma unroll
    for (int hf = 0; hf < 2; ++hf) {
        float v[32];
#pragma unroll
        for (int kk = 0; kk < 32; ++kk) v[kk] = W[(size_t)(k0 + hf * 32 + kk) * ldw + src_col + lane];
#pragma unroll
        for (int q = 0; q < 4; ++q) { u32x4 w; w.x = cvt_pk_bf16_asm(v[8 * q], v[8 * q + 1]); w.y = cvt_pk_bf16_asm(v[8 * q + 2], v[8 * q + 3]); w.z = cvt_pk_bf16_asm(v[8 * q + 4], v[8 * q + 5]); w.w = cvt_pk_bf16_asm(v[8 * q + 6], v[8 * q + 7]);
            *(u32x4*)(WTrow + k0 + hf * 32 + 8 * q) = w; }
    }
}
__device__ __forceinline__ void p0_prologue(const Args& a, LAS unsigned char* L) {
    const int tid = threadIdx.x, lane = tid & 63, wave = tid >> 6;
    const int gw = blockIdx.x * 8 + wave, NGW = gridDim.x * 8;
    unsigned char* ws = a.ws;
    const float* w_in = a.in[8];
    for (int it = gw; it < 2880; it += NGW) {
        if (it < 2048) {
            const int which = it >> 10, r = it & 1023, nb = r >> 4, kb = r & 15, n0 = nb * 64;
            int src;
            if (which == 0) src = (n0 < 1024) ? n0 : n0 + 1024;
            else src = (n0 < 1024) ? 1024 + n0 : (n0 < 2048) ? 5120 + (n0 - 1024) : (n0 < 3072) ? 6160 + (n0 - 2048) : 7184 + (n0 - 3072);
            bf16_t* WT = (bf16_t*)(ws + (which ? WS_W2T : WS_W1T));
            transpose_item(w_in, 8208, src, WT + (size_t)(n0 + lane) * 1024, kb * 64, lane);
        } else if (it < 2816) {
            const int r = it - 2048, which = r >> 8, q = r & 255, nb = q >> 4, kb = q & 15;
            const float* W = which == 0 ? a.in[20] : which == 1 ? a.in[21] : a.in[22];
            bf16_t* WT = (bf16_t*)(ws + (which == 0 ? WS_WBL : which == 1 ? WS_WBG : WS_WO));
            transpose_item(W, 1024, nb * 64, WT + (size_t)(nb * 64 + lane) * 1024, kb * 64, lane);
        } else {
            const int r = it - 2816, which = r >> 5, q = r & 31, g = q >> 2, nb = (q >> 1) & 1, kb = q & 1;
            const float* W = (which == 0 ? a.in[11] : a.in[13]) + (size_t)g * 16384;
            bf16_t* WT = (bf16_t*)(ws + (which == 0 ? WS_WA : WS_WX)) + (size_t)g * 16384;
            transpose_item(W, 128, nb * 64, WT + (size_t)(nb * 64 + lane) * 128, kb * 64, lane);
        }
    }
    LAS float* wT = (LAS float*)L;
    for (int idx = tid; idx < 16384; idx += 512) { const int k = idx >> 4, c = idx & 15; wT[c * 1024 + k] = w_in[(size_t)k * 8208 + 6144 + c]; }
    __syncthreads();
    const float* x_p = a.in[0]; const float* x_s = a.in[1]; const float* gain = a.in[6];
    bf16_t* U = (bf16_t*)(ws + WS_U); float* BG = (float*)(ws + WS_BG);
    f32x4 gn[4];
#pragma unroll
    for (int j = 0; j < 4; ++j) gn[j] = ((const f32x4*)gain)[lane + 64 * j];
    for (int m = gw; m < NROWS; m += NGW) {
        const float* xr = (m < NPROMPT) ? x_p + (size_t)m * DM : x_s + (size_t)(m - NPROMPT) * DM;
        f32x4 v[4]; float s = 0.f;
#pragma unroll
        for (int j = 0; j < 4; ++j) { v[j] = ((const f32x4*)xr)[lane + 64 * j]; s += (v[j].x * v[j].x + v[j].y * v[j].y) + (v[j].z * v[j].z + v[j].w * v[j].w); }
        const float rs = rsqrtf(wave_sum(s) * (1.f / DM) + EPS);
#pragma unroll
        for (int j = 0; j < 4; ++j) { v[j] = v[j] * rs * gn[j];
            u32x2 o; o.x = cvt_pk_bf16(v[j].x, v[j].y); o.y = cvt_pk_bf16(v[j].z, v[j].w);
            ((u32x2*)(U + (size_t)m * DM))[lane + 64 * j] = o; }
        float mine = 0.f;
#pragma unroll 1
        for (int c0 = 0; c0 < 16; c0 += 4) {
            float p[4];
#pragma unroll
            for (int cc = 0; cc < 4; ++cc) {
                p[cc] = 0.f;
#pragma unroll
                for (int j = 0; j < 4; ++j) { const f32x4 w = ((const LAS f32x4*)(wT + (c0 + cc) * 1024))[lane + 64 * j]; p[cc] += (v[j].x * w.x + v[j].y * w.y) + (v[j].z * w.z + v[j].w * w.w); }
            }
#pragma unroll
            for (int cc = 0; cc < 4; ++cc) p[cc] = row16_sum(p[cc]);
#pragma unroll
            for (int cc = 0; cc < 4; ++cc) p[cc] += __shfl_xor(p[cc], 16);
#pragma unroll
            for (int cc = 0; cc < 4; ++cc) p[cc] += __shfl_xor(p[cc], 32);
#pragma unroll
            for (int cc = 0; cc < 4; ++cc) if (lane == c0 + cc) mine = p[cc];
        }
        if (lane < 8) BG[(size_t)m * 16 + lane] = 1.f / (1.f + expf(-mine));
        else if (lane < 16) { const int h = lane - 8; const float xx = mine + a.in[18][h]; const float sp = xx > 20.f ? xx : log1pf(expf(xx)); BG[(size_t)m * 16 + lane] = -expf(a.in[17][h]) * sp; }
    }
}

#ifndef DRY_SKIP
#define DRY_SKIP 0
#endif
__device__ __forceinline__ void p2_gdn_local(const Args& a, LAS unsigned char* L, const bool dry, const int u0, const int ustep, const int un) {
    const int tid = threadIdx.x, lane = tid & 63, wave = __builtin_amdgcn_readfirstlane(tid >> 6), fr = lane & 15, fq = lane >> 4;
    LAS bf16_t* QS = (LAS bf16_t*)(L);
    LAS bf16_t* KS = (LAS bf16_t*)(L + 17408);
    LAS float* MS = (LAS float*)(L + 52224);
    LAS bf16_t* AS = (LAS bf16_t*)(L + 68864);
    LAS bf16_t* TS = (LAS bf16_t*)(L + 78080);
    LAS float* GCS = (LAS float*)(L + 87296);
    LAS float* BES = (LAS float*)(L + 87552);
    LAS bf16_t* RAW = (LAS bf16_t*)(L + 87808);
    LAS float* CW = (LAS float*)(L + 140336);
    LAS bf16_t* SH = (LAS bf16_t*)(L + 52224);
    bf16_t* Z1 = (bf16_t*)(a.ws + WS_Z1); const bf16_t* HALO = (const bf16_t*)(a.ws + WS_HALO);
    const float* BG = (const float*)(a.ws + WS_BG); float* GC = (float*)(a.ws + WS_GC);
    bf16_t* TINV = (bf16_t*)(a.ws + WS_TINV); bf16_t* AQK = (bf16_t*)(a.ws + WS_AQK);
    const float* st_gc = a.in[4]; const float* cw = a.in[16];
    u32x4 nr[7];
    int zo[7], lo[7];
#pragma unroll
    for (int k = 0; k < 7; ++k) {
        int q = tid + 512 * k; if (q > 3215) q = 3215;
        const int rr = q / 48, rem = q - rr * 48;
        zo[k] = (rr >= 3 ? rr - 3 : 0) * ZW + (rem >> 4) * 1024 + (rem & 15) * 8;
        lo[k] = rr * 392 + rem * 8;
    }
    const int rr0 = tid / 48;
    const int ho0 = rr0 * 3072 + ((tid - rr0 * 48) >> 4) * 1024 + ((tid - rr0 * 48) & 15) * 8;
    auto prefetch = [&](int u) {
        const int grp = u >> 3, h = u & 7; const bool smp = grp >= 256; const bool nohalo = smp || ((grp & 31) == 0);
        const bf16_t* zb = Z1 + (size_t)grp * 64 * ZW + 1024 + h * 128;
#pragma unroll
        for (int k = 0; k < 7; ++k) {
            const bf16_t* src = zb + zo[k];
            if (k == 0 && rr0 < 3 && !nohalo) src = HALO + (size_t)(grp - 1) * 3 * 3072 + h * 128 + ho0;
            u32x4 v = *(const u32x4*)src;
            if (k == 0 && rr0 < 3 && nohalo) v = (u32x4){0u, 0u, 0u, 0u};
            nr[k] = v;
        }
    };
    int hprev = -1;
    if (un > 0) prefetch(u0);
    for (int ui = 0; ui < un; ++ui) {
        const int u = u0 + ui * ustep;
        const int grp = u >> 3, h = u & 7; const bool smp = grp >= 256; const int row0 = grp * 64;
        const int t = tid >> 3, p = tid & 7;
        __syncthreads();
#pragma unroll
        for (int k = 0; k < 7; ++k) {
            const int q = tid + 512 * k;
            if (q < 3216) *(LAS u32x4*)(RAW + lo[k]) = nr[k];
        }
        if (h != hprev) {
#pragma unroll
            for (int k = 0; k < 3; ++k) { const int idx = tid + 512 * k, i = idx / 384, c = idx - i * 384; CW[idx] = cw[(size_t)i * 3072 + (c >> 7) * 1024 + h * 128 + (c & 127)]; }
            hprev = h;
        }
        if (smp) {
            for (int idx = tid; idx < 9216; idx += 512) { const int sr = idx / 384, c = idx - sr * 384;
                SH[sr * 392 + c] = f2bf(st_gc[(size_t)((grp - 256) * 24 + sr) * 3072 + (c >> 7) * 1024 + h * 128 + (c & 127)]); }
        }
        if (tid < 64) {
            float g = BG[(size_t)(row0 + tid) * 16 + 8 + h]; const float be = BG[(size_t)(row0 + tid) * 16 + h];
            const int li = smp ? (tid & 7) : tid;
#pragma unroll
            for (int d = 1; d < 64; d <<= 1) { const float o = __shfl_up(g, d); if (li >= d) g += o; }
            GCS[tid] = g; BES[tid] = be; GC[(size_t)(row0 + tid) * 8 + h] = g;
        }
        __syncthreads();
        if (ui + 1 < un) prefetch(u + ustep);
#pragma unroll 1
        for (int seg = (dry && (DRY_SKIP & 4)) ? 3 : 0; seg < 3; ++seg) {
            float av[16];
#pragma unroll
            for (int e = 0; e < 16; ++e) av[e] = 0.f;
#pragma unroll
            for (int i = 0; i < 4; ++i) {
                const int ts8 = (t & 7) - 3 + i;
                const LAS bf16_t* rp = (smp && ts8 < 0) ? SH + ((t >> 3) * 3 + ts8 + 3) * 392 : RAW + (t + i) * 392;
                rp += seg * 128 + 16 * p;
                float xv[16];
                const u32x4 w0 = *(const LAS u32x4*)rp, w1 = *(const LAS u32x4*)(rp + 8); unpack8(w0, xv); unpack8(w1, xv + 8);
                const LAS float* wp = CW + i * 384 + seg * 128 + 16 * p;
#pragma unroll
                for (int q = 0; q < 4; ++q) { const f32x4 f = *(const LAS f32x4*)(wp + 4 * q); av[4 * q] += f.x * xv[4 * q]; av[4 * q + 1] += f.y * xv[4 * q + 1]; av[4 * q + 2] += f.z * xv[4 * q + 2]; av[4 * q + 3] += f.w * xv[4 * q + 3]; }
            }
            float ss = 0.f;
#pragma unroll
            for (int e = 0; e < 16; ++e) { av[e] = siluf_(av[e]); ss += av[e] * av[e]; }
            ss += __shfl_xor(ss, 1); ss += __shfl_xor(ss, 2); ss += __shfl_xor(ss, 4);
            const float rs = (seg == 2) ? 1.f : rsqrtf(ss + EPS) * (seg == 0 ? 0.08838834764831845f : 1.f);
#pragma unroll
            for (int e = 0; e < 16; ++e) av[e] *= rs;
            LAS bf16_t* d = QS + seg * 8704 + t * 136 + 16 * p;
            *(LAS u32x4*)d = pack8(av); *(LAS u32x4*)(d + 8) = pack8(av + 8);
        }
        __syncthreads();
        if (!dry)
#pragma unroll
        for (int q = 0; q < 6; ++q) {
            const int idx = tid + 512 * q, seg = idx >> 10, r = (idx >> 4) & 63, ch = idx & 15;
            *(u32x4*)(Z1 + (size_t)(row0 + r) * ZW + 1024 + seg * 1024 + h * 128 + ch * 8) = *(const LAS u32x4*)(QS + seg * 8704 + r * 136 + ch * 8);
        }
        if (!(dry && (DRY_SKIP & 2)))
        {
            const int sel = wave >> 2, ti = wave & 3;
            const LAS bf16_t* XA = sel ? QS : KS;
            bf16x8 af[4], bfr[4][4]; float gi[4], bi[4], gj[4];
#pragma unroll
            for (int ks = 0; ks < 4; ++ks) af[ks] = *(const LAS bf16x8*)(XA + (16 * ti + fr) * 136 + 32 * ks + 8 * fq);
#pragma unroll
            for (int tj = 0; tj < 4; ++tj) {
                gj[tj] = GCS[16 * tj + fr];
#pragma unroll
                for (int ks = 0; ks < 4; ++ks) bfr[tj][ks] = *(const LAS bf16x8*)(KS + (16 * tj + fr) * 136 + 32 * ks + 8 * fq);
            }
#pragma unroll
            for (int r = 0; r < 4; ++r) { gi[r] = GCS[16 * ti + 4 * fq + r]; bi[r] = BES[16 * ti + 4 * fq + r]; }
            __builtin_amdgcn_sched_barrier(0);
            f32x4 acc[4];
#pragma unroll
            for (int tj = 0; tj < 4; ++tj) {
                acc[tj] = (f32x4){0.f, 0.f, 0.f, 0.f};
                if (tj <= ti) {
#pragma unroll
                    for (int ks = 0; ks < 4; ++ks) acc[tj] = __builtin_amdgcn_mfma_f32_16x16x32_bf16(af[ks], bfr[tj][ks], acc[tj], 0, 0, 0);
                }
            }
            float ov[4][4];
#pragma unroll
            for (int tj = 0; tj < 4; ++tj)
#pragma unroll
                for (int r = 0; r < 4; ++r) {
                    const int i = 16 * ti + 4 * fq + r, j = 16 * tj + fr;
                    const bool same = smp ? ((i >> 3) == (j >> 3)) : true;
                    const float e = __expf(fminf(gi[r] - gj[tj], 0.f));
                    const bool keep = same && (sel == 0 ? (i > j) : (i >= j));
                    ov[tj][r] = keep ? (sel == 0 ? bi[r] : 1.f) * acc[tj][r] * e : 0.f;
                }
            if (sel == 0) {
#pragma unroll
                for (int tj = 0; tj < 4; ++tj)
#pragma unroll
                    for (int r = 0; r < 4; ++r) MS[(16 * ti + 4 * fq + r) * 65 + 16 * tj + fr] = ov[tj][r];
            } else {
#pragma unroll
                for (int tj = 0; tj < 4; ++tj)
#pragma unroll
                    for (int r = 0; r < 4; ++r) AS[(16 * ti + 4 * fq + r) * 72 + 16 * tj + fr] = f2bf(ov[tj][r]);
            }
        }
        __syncthreads();
        if (!(dry && (DRY_SKIP & 1)))
        {
            float mrow[64];
#pragma unroll
            for (int j = 0; j < 64; ++j) mrow[j] = MS[lane * 65 + j];
            float X[8];
#pragma unroll
            for (int cc = 0; cc < 8; ++cc) X[cc] = (lane == 8 * cc + wave) ? 1.f : 0.f;
#pragma unroll
            for (int j = 0; j < 64; ++j) {
                float sv[8];
#pragma unroll
                for (int cc = 0; cc < 8; ++cc) sv[cc] = (8 * cc <= j) ? __uint_as_float(__builtin_amdgcn_readlane(__float_as_uint(X[cc]), j)) : 0.f;
                const float nm = -mrow[j];
#pragma unroll
                for (int cc = 0; cc < 8; ++cc) if (8 * cc <= j) X[cc] = fmaf(nm, sv[cc], X[cc]);
            }
#pragma unroll
            for (int cc = 0; cc < 8; ++cc) TS[lane * 72 + 8 * cc + wave] = f2bf(X[cc]);
        }
        __syncthreads();
        {
            const int r = tid >> 3, ch = tid & 7;
            const size_t o = ((size_t)u * 64 + r) * 64 + ch * 8;
            *(u32x4*)(TINV + o) = *(const LAS u32x4*)(TS + r * 72 + ch * 8);
            *(u32x4*)(AQK + o) = *(const LAS u32x4*)(AS + r * 72 + ch * 8);
        }
    }
    __syncthreads();
}

__device__ __forceinline__ u32x4 gdn_norm8(const u32x4 o8, const LAS float* part8, const LAS float* nw8) {
    const f32x4 p0 = *(const LAS f32x4*)part8, p1 = *(const LAS f32x4*)(part8 + 4);
    const float tot = ((p0[0] + p0[1]) + (p0[2] + p0[3])) + ((p1[0] + p1[1]) + (p1[2] + p1[3]));
    const float rs = rsqrtf(tot * (1.f / 128.f) + EPS);
    float f[8]; unpack8(o8, f);
#pragma unroll
    for (int e = 0; e < 8; ++e) f[e] = f[e] * rs * nw8[e];
    return pack8(f);
}

template <int MT>
__device__ __forceinline__ void gdn_scan_unit(const Args& a, LAS unsigned char* L, int sq, int h, const bool dry) {
    constexpr bool SMP = (MT == 1);
    constexpr int NR = MT * 16, NS2 = (MT + 1) / 2, NV = SMP ? 8 : 64;
    constexpr int BUFB = 71168;
    const int tid = threadIdx.x, lane = tid & 63, wave = __builtin_amdgcn_readfirstlane(tid >> 6), fr = lane & 15, fq = lane >> 4;
    LAS float* OSS = (LAS float*)(L + 2 * BUFB);
    bf16_t* Z1 = (bf16_t*)(a.ws + WS_Z1);
    const float* BG = (const float*)(a.ws + WS_BG); const float* GC = (const float*)(a.ws + WS_GC);
    const bf16_t* TINV = (const bf16_t*)(a.ws + WS_TINV); const bf16_t* AQK = (const bf16_t*)(a.ws + WS_AQK);
    const int dv = 16 * wave + fr;
    LAS float* NWS = (LAS float*)(L + 2 * BUFB + 2048);
    if (tid < 128) NWS[tid] = a.in[19][tid];
    const LAS float* nw8 = NWS + (tid & 15) * 8;
    f32x4 S[8];
    if (SMP) {
        const float* S0 = a.in[5] + (size_t)(sq * 8 + h) * 16384;
#pragma unroll
        for (int dt = 0; dt < 8; ++dt)
#pragma unroll
            for (int r = 0; r < 4; ++r) S[dt][r] = S0[(size_t)(16 * dt + 4 * fq + r) * 128 + dv];
    } else {
#pragma unroll
        for (int dt = 0; dt < 8; ++dt) S[dt] = (f32x4){0.f, 0.f, 0.f, 0.f};
    }
    const int nch = SMP ? 1 : 32;
    const int o8 = SMP ? (sq & 7) * 8 : 0;
    u32x4 pk[6], pt[2]; float pg = 0.f, pb = 0.f;
    auto load_chunk = [&](int c) {
        const int rowc = SMP ? NPROMPT + sq * 8 : sq * SEQ + 64 * c;
        const int grp = SMP ? 256 + (sq >> 3) : (sq * 32 + c);
#pragma unroll
        for (int q = 0; q < 2; ++q) {
            const int idx = tid + 512 * q, r = idx >> 4, ch = idx & 15;
            const bool ok = SMP ? ((idx < NR * 16) && (r < NV)) : true;
            const int rcl = ok ? r : 0;
#pragma unroll
            for (int seg = 0; seg < 3; ++seg) {
                u32x4 v = *(const u32x4*)(Z1 + (size_t)(rowc + rcl) * ZW + 1024 + seg * 1024 + h * 128 + ch * 8);
                if (!ok) v = (u32x4){0u, 0u, 0u, 0u};
                pk[q * 3 + seg] = v;
            }
        }
        {
            const int r = tid >> 3, ch = tid & 7;
            bool ok; size_t o;
            if (SMP) { ok = (r < 8) && (ch == 0); o = ((size_t)(grp * 8 + h) * 64 + o8 + (ok ? r : 0)) * 64 + o8; }
            else { ok = true; o = ((size_t)(grp * 8 + h) * 64 + r) * 64 + ch * 8; }
            u32x4 v0 = *(const u32x4*)(TINV + o), v1 = *(const u32x4*)(AQK + o);
            if (!ok) { v0 = (u32x4){0u, 0u, 0u, 0u}; v1 = v0; }
            pt[0] = v0; pt[1] = v1;
        }
        if (tid < 64) { const bool ok = tid < NV; const int tc = ok ? tid : 0; pg = GC[(size_t)(rowc + tc) * 8 + h]; pb = BG[(size_t)(rowc + tc) * 16 + h]; if (!ok) { pg = 0.f; pb = 0.f; } }
    };
    auto write_chunk = [&](LAS unsigned char* B) {
        LAS bf16_t* KSb = (LAS bf16_t*)(B); LAS bf16_t* QSb = (LAS bf16_t*)(B + 17408); LAS bf16_t* VSb = (LAS bf16_t*)(B + 34816);
        LAS bf16_t* TSb = (LAS bf16_t*)(B + 52224); LAS bf16_t* ASb = (LAS bf16_t*)(B + 61440);
#pragma unroll
        for (int q = 0; q < 2; ++q) {
            const int idx = tid + 512 * q, r = idx >> 4, ch = idx & 15;
            if (idx < NR * 16) {
                st_perm(QSb + r * 136, ch, pk[q * 3 + 0]);
                st_perm(KSb + r * 136, ch, pk[q * 3 + 1]);
                *(LAS u32x4*)(VSb + r * 136 + ch * 8) = pk[q * 3 + 2];
            }
        }
        { const int r = tid >> 3, ch = tid & 7; if (r < NR) { st_perm(TSb + r * 72, ch, pt[0]); st_perm(ASb + r * 72, ch, pt[1]); } }
        if (tid < 64) { ((LAS float*)(B + 70656))[tid] = pg; ((LAS float*)(B + 70912))[tid] = pb; }
    };
    load_chunk(0);
    write_chunk(L);
    if (nch > 1) load_chunk(1);
#define SB_ __builtin_amdgcn_sched_barrier(0)
    for (int c = 0; c < nch; ++c) {
        const int rowc = SMP ? NPROMPT + sq * 8 : sq * SEQ + 64 * c;
        LAS unsigned char* B = L + (c & 1) * BUFB;
        LAS unsigned char* Bo = L + ((c & 1) ^ 1) * BUFB;
        LAS bf16_t* KS = (LAS bf16_t*)(B); LAS bf16_t* QS = (LAS bf16_t*)(B + 17408); LAS bf16_t* VS = (LAS bf16_t*)(B + 34816);
        LAS bf16_t* TS = (LAS bf16_t*)(B + 52224); LAS bf16_t* AS = (LAS bf16_t*)(B + 61440);
        LAS float* GCS = (LAS float*)(B + 70656); LAS float* BES = (LAS float*)(B + 70912);
        __syncthreads();
        if (c > 0 && !dry) {
            const LAS bf16_t* OSo = (const LAS bf16_t*)(Bo + 17408);
#pragma unroll
            for (int q = 0; q < 2; ++q) {
                const int idx = tid + 512 * q, r = idx >> 4, ch = idx & 15;
                *(u32x4*)(Z1 + (size_t)(rowc - 64 + r) * ZW + 1024 + h * 128 + ch * 8) = gdn_norm8(*(const LAS u32x4*)(OSo + r * 136 + ch * 8), OSS + r * 8, nw8);
            }
        }

        const float gl = GCS[NV - 1];
        bf16x8 Sb[4];
#pragma unroll
        for (int s = 0; s < 4; ++s) Sb[s] = pack_frag(S[2 * s], S[2 * s + 1]);
        f32x4 R[MT], P[MT];
#pragma unroll
        for (int mt = 0; mt < MT; ++mt) {
            bf16x8 fk[4];
#pragma unroll
            for (int s = 0; s < 4; ++s) fk[s] = lda_perm(KS + (16 * mt + fr) * 136, s, fq, true);
            SB_;
            R[mt] = (f32x4){0.f, 0.f, 0.f, 0.f}; P[mt] = (f32x4){0.f, 0.f, 0.f, 0.f};
#pragma unroll
            for (int s = 0; s < 4; ++s) R[mt] = __builtin_amdgcn_mfma_f32_16x16x32_bf16(fk[s], Sb[s], R[mt], 0, 0, 0);
            SB_;
#pragma unroll
            for (int s = 0; s < 4; ++s) fk[s] = lda_perm(QS + (16 * mt + fr) * 136, s, fq, true);
            SB_;
#pragma unroll
            for (int s = 0; s < 4; ++s) P[mt] = __builtin_amdgcn_mfma_f32_16x16x32_bf16(fk[s], Sb[s], P[mt], 0, 0, 0);
            SB_;
        }
        __syncthreads();
        if (c + 1 < nch) write_chunk(Bo);
        SB_;
#pragma unroll
        for (int m0 = 0; m0 < MT; m0 += 2) {
            float gi_[2][4], vi_[2][4], bi_[2][4];
#pragma unroll
            for (int mm = 0; mm < 2; ++mm) if (m0 + mm < MT) {
#pragma unroll
                for (int r = 0; r < 4; ++r) { const int i = 16 * (m0 + mm) + 4 * fq + r; gi_[mm][r] = GCS[i]; bi_[mm][r] = BES[i]; vi_[mm][r] = bf1(VS[i * 136 + dv]); }
            }
            SB_;
#pragma unroll
            for (int mm = 0; mm < 2; ++mm) if (m0 + mm < MT) {
#pragma unroll
                for (int r = 0; r < 4; ++r) {
                    const float e = __expf(gi_[mm][r]);
                    R[m0 + mm][r] = bi_[mm][r] * (vi_[mm][r] - e * R[m0 + mm][r]);
                    P[m0 + mm][r] *= e;
                }
            }
            SB_;
        }
        bf16x8 rb[NS2];
#pragma unroll
        for (int s2 = 0; s2 < NS2; ++s2) rb[s2] = pack_frag(R[2 * s2], (2 * s2 + 1 < MT) ? R[(2 * s2 + 1 < MT) ? 2 * s2 + 1 : 0] : (f32x4){0.f, 0.f, 0.f, 0.f});
        f32x4 Vn[MT];
#pragma unroll
        for (int m0 = 0; m0 < MT; m0 += 2) {
            bf16x8 ft[2][NS2];
#pragma unroll
            for (int mm = 0; mm < 2; ++mm) if (m0 + mm < MT) {
#pragma unroll
                for (int s2 = 0; s2 < NS2; ++s2) ft[mm][s2] = lda_perm(TS + (16 * (m0 + mm) + fr) * 72, s2, fq, 2 * s2 + 1 < MT);
            }
            SB_;
#pragma unroll
            for (int mm = 0; mm < 2; ++mm) if (m0 + mm < MT) {
                Vn[m0 + mm] = (f32x4){0.f, 0.f, 0.f, 0.f};
#pragma unroll
                for (int s2 = 0; s2 < NS2; ++s2) Vn[m0 + mm] = __builtin_amdgcn_mfma_f32_16x16x32_bf16(ft[mm][s2], rb[s2], Vn[m0 + mm], 0, 0, 0);
            }
            SB_;
        }
        const int q4 = fr >> 2, p4 = fr & 3;
        bf16x8 fs[1][2][NS2];
        auto ld_tr = [&](int set, int dt) {
#pragma unroll
            for (int s2 = 0; s2 < NS2; ++s2) {
                const s16x4 lo = lds_tr(KS + (32 * s2 + 4 * fq + q4) * 136 + 32 * (dt >> 1) + 8 * p4 + 4 * (dt & 1));
                s16x4 hi = (s16x4){0, 0, 0, 0};
                if (2 * s2 + 1 < MT) hi = lds_tr(KS + (32 * s2 + 16 + 4 * fq + q4) * 136 + 32 * (dt >> 1) + 8 * p4 + 4 * (dt & 1));
                bf16x8 af; af[0] = lo[0]; af[1] = lo[1]; af[2] = lo[2]; af[3] = lo[3]; af[4] = hi[0]; af[5] = hi[1]; af[6] = hi[2]; af[7] = hi[3];
                fs[set][dt & 1][s2] = af;
            }
        };
        bf16x8 vb[NS2], vdb[NS2];
#pragma unroll
        for (int s2 = 0; s2 < NS2; ++s2) {
            const int m1 = (2 * s2 + 1 < MT) ? 2 * s2 + 1 : 0;
            const f32x4 z = (f32x4){0.f, 0.f, 0.f, 0.f};
            vb[s2] = pack_frag(Vn[2 * s2], (2 * s2 + 1 < MT) ? Vn[m1] : z);
            f32x4 d0, d1;
#pragma unroll
            for (int r = 0; r < 4; ++r) { d0[r] = Vn[2 * s2][r] * __expf(gl - GCS[32 * s2 + 4 * fq + r]); d1[r] = (2 * s2 + 1 < MT) ? Vn[m1][r] * __expf(gl - GCS[32 * s2 + 16 + 4 * fq + r]) : 0.f; }
            vdb[s2] = pack_frag(d0, d1);
        }
#pragma unroll
        for (int m0 = 0; m0 < MT; m0 += 2) {
            bf16x8 fa2[2][NS2];
#pragma unroll
            for (int mm = 0; mm < 2; ++mm) if (m0 + mm < MT) {
#pragma unroll
                for (int s2 = 0; s2 < NS2; ++s2) fa2[mm][s2] = lda_perm(AS + (16 * (m0 + mm) + fr) * 72, s2, fq, 2 * s2 + 1 < MT);
            }
            SB_;
#pragma unroll
            for (int mm = 0; mm < 2; ++mm) if (m0 + mm < MT) {
#pragma unroll
                for (int s2 = 0; s2 < NS2; ++s2) P[m0 + mm] = __builtin_amdgcn_mfma_f32_16x16x32_bf16(fa2[mm][s2], vb[s2], P[m0 + mm], 0, 0, 0);
            }
            SB_;
        }
        {
            const float eg = __expf(gl);
#pragma unroll
            for (int d0 = 0; d0 < 8; d0 += 2) {
                ld_tr(0, d0); ld_tr(0, d0 + 1);
                SB_;
#pragma unroll
                for (int dt = d0; dt < d0 + 2; ++dt) {
                    S[dt] = S[dt] * eg;
#pragma unroll
                    for (int s2 = 0; s2 < NS2; ++s2) S[dt] = __builtin_amdgcn_mfma_f32_16x16x32_bf16(fs[0][dt & 1][s2], vdb[s2], S[dt], 0, 0, 0);
                }
                SB_;
            }
        }
#pragma unroll
        for (int mt = 0; mt < MT; ++mt) {
            f32x4 qv;
#pragma unroll
            for (int r = 0; r < 4; ++r) { qv[r] = row16_sum(P[mt][r] * P[mt][r]); QS[(16 * mt + 4 * fq + r) * 136 + dv] = f2bf(P[mt][r]); }
            if (fr < 4) OSS[(16 * mt + 4 * fq + fr) * 8 + wave] = (fr == 0) ? qv[0] : (fr == 1) ? qv[1] : (fr == 2) ? qv[2] : qv[3];
        }
        if (c + 2 < nch) load_chunk(c + 2);
    }
#undef SB_
    __syncthreads();
    {
        const int rowl = SMP ? NPROMPT + sq * 8 : sq * SEQ + 64 * (nch - 1);
        const LAS bf16_t* OSl = (const LAS bf16_t*)(L + ((nch - 1) & 1) * BUFB + 17408);
#pragma unroll
        for (int q = 0; q < 2; ++q) {
            const int idx = tid + 512 * q, r = idx >> 4, ch = idx & 15;
            if (idx < NR * 16 && r < NV && !dry) *(u32x4*)(Z1 + (size_t)(rowl + r) * ZW + 1024 + h * 128 + ch * 8) = gdn_norm8(*(const LAS u32x4*)(OSl + r * 136 + ch * 8), OSS + r * 8, nw8);
        }
    }
    float* So = a.out + (SMP ? O_SGS : O_PGS) + (size_t)(sq * 8 + h) * 16384;
#pragma unroll
    for (int dt = 0; dt < 8; ++dt)
#pragma unroll
        for (int r = 0; r < 4; ++r) So[(size_t)(16 * dt + 4 * fq + r) * 128 + dv] = S[dt][r];
    __syncthreads();
}

__device__ __forceinline__ void lru_unit(const Args& a, LAS unsigned char* L, bool smp, int bidx, int g, const bool dry) {
    const int tid = threadIdx.x, lane = tid & 63, wave = __builtin_amdgcn_readfirstlane(tid >> 6), fr = lane & 15, fq = lane >> 4;
    LAS float* XC = (LAS float*)(L);
    LAS bf16_t* XB = (LAS bf16_t*)(L + 33792);
    LAS bf16_t* HS = (LAS bf16_t*)(L + 51200);
    LAS bf16_t* RW = (LAS bf16_t*)(L + 68608);
    LAS bf16_t* SH = (LAS bf16_t*)(L + 86832);
    LAS float* CWL = (LAS float*)(L + 93360);
    bf16_t* Z1 = (bf16_t*)(a.ws + WS_Z1);
    const bf16_t* WAT = (const bf16_t*)(a.ws + WS_WA) + (size_t)g * 16384;
    const bf16_t* WXT = (const bf16_t*)(a.ws + WS_WX) + (size_t)g * 16384;
    const float* cw = a.in[9]; const float* cb = a.in[10];
    const int c = 16 * wave + fr, col = g * 128 + c;
    const float ba = a.in[12][col], bx = a.in[14][col];
    const float al = a.in[15][col];
    const float ls = -(al > 0.f ? log1pf(expf(-al)) : (log1pf(expf(al)) - al));
    bf16x8 Bwa[4], Bwx[4];
#pragma unroll
    for (int ks = 0; ks < 4; ++ks) { Bwa[ks] = *(const bf16x8*)(WAT + (size_t)c * 128 + 32 * ks + 8 * fq); Bwx[ks] = *(const bf16x8*)(WXT + (size_t)c * 128 + 32 * ks + 8 * fq); }
    const int ntile = smp ? 1 : 32;
    float carry = 0.f;
    const int t = tid >> 3, p = tid & 7, cc0 = 16 * p, gc0 = g * 128 + cc0;
    for (int idx = tid; idx < 640; idx += 512) { const int i = idx >> 7, cc = idx & 127; CWL[idx] = (i < 4) ? cw[(size_t)i * 1024 + g * 128 + cc] : cb[g * 128 + cc]; }
    if (smp) { for (int idx = tid; idx < 3072; idx += 512) { const int sr = idx >> 7, cc = idx & 127; SH[sr * 136 + cc] = f2bf(a.in[2][(size_t)(bidx * 24 + sr) * 1024 + g * 128 + cc]); } }
    const int row00 = smp ? NPROMPT + bidx * 64 : bidx * SEQ;
    LAS bf16_t* RW2 = (LAS bf16_t*)(L + 95920);
    u32x4 nx0 = *(const u32x4*)(Z1 + (size_t)(row00 + t) * ZW + gc0), nx1 = *(const u32x4*)(Z1 + (size_t)(row00 + t) * ZW + gc0 + 8);
    u32x4 pv0 = (u32x4){0u, 0u, 0u, 0u}, pv1 = pv0;
    *(LAS u32x4*)(RW + (3 + t) * 136 + cc0) = nx0; *(LAS u32x4*)(RW + (3 + t) * 136 + cc0 + 8) = nx1;
    if (t >= 61) { *(LAS u32x4*)(RW + (t - 61) * 136 + cc0) = pv0; *(LAS u32x4*)(RW + (t - 61) * 136 + cc0 + 8) = pv1; }
    pv0 = nx0; pv1 = nx1;
    if (ntile > 1) { nx0 = *(const u32x4*)(Z1 + (size_t)(row00 + 64 + t) * ZW + gc0); nx1 = *(const u32x4*)(Z1 + (size_t)(row00 + 64 + t) * ZW + gc0 + 8); }
    for (int j = 0; j < ntile; ++j) {
        const int rowt = row00 + 64 * j;
        const LAS bf16_t* RWc = (j & 1) ? RW2 : RW;
        __syncthreads();
        {
            float y[16];
#pragma unroll
            for (int q = 0; q < 4; ++q) { const f32x4 f = *(const LAS f32x4*)(CWL + 512 + cc0 + 4 * q); y[4 * q] = f.x; y[4 * q + 1] = f.y; y[4 * q + 2] = f.z; y[4 * q + 3] = f.w; }
#pragma unroll
            for (int i = 0; i < 4; ++i) {
                const int ts8 = (t & 7) - 3 + i;
                const LAS bf16_t* rp = ((smp && ts8 < 0) ? SH + ((t >> 3) * 3 + ts8 + 3) * 136 : RWc + (t + i) * 136) + cc0;
                float xv[16];
                const u32x4 w0 = *(const LAS u32x4*)rp, w1 = *(const LAS u32x4*)(rp + 8); unpack8(w0, xv); unpack8(w1, xv + 8);
#pragma unroll
                for (int q = 0; q < 4; ++q) { const f32x4 f = *(const LAS f32x4*)(CWL + i * 128 + cc0 + 4 * q); y[4 * q] += f.x * xv[4 * q]; y[4 * q + 1] += f.y * xv[4 * q + 1]; y[4 * q + 2] += f.z * xv[4 * q + 2]; y[4 * q + 3] += f.w * xv[4 * q + 3]; }
            }
#pragma unroll
            for (int q = 0; q < 4; ++q) *(LAS f32x4*)(XC + t * 132 + cc0 + 4 * q) = (f32x4){y[4 * q], y[4 * q + 1], y[4 * q + 2], y[4 * q + 3]};
            *(LAS u32x4*)(XB + t * 136 + cc0) = pack8(y); *(LAS u32x4*)(XB + t * 136 + cc0 + 8) = pack8(y + 8);
        }
        if (j > 0 && !dry) {
#pragma unroll
            for (int q = 0; q < 2; ++q) {
                const int idx = tid + 512 * q, r = idx >> 4, ch = idx & 15;
                *(u32x4*)(Z1 + (size_t)(rowt - 64 + r) * ZW + g * 128 + ch * 8) = *(const LAS u32x4*)(HS + r * 136 + ch * 8);
            }
        }
        __syncthreads();
        f32x4 R[4], I[4];
#pragma unroll
        for (int mt = 0; mt < 4; ++mt) {
            bf16x8 fx[4];
#pragma unroll
            for (int ks = 0; ks < 4; ++ks) fx[ks] = *(const LAS bf16x8*)(XB + (16 * mt + fr) * 136 + 32 * ks + 8 * fq);
            __builtin_amdgcn_sched_barrier(0);
            R[mt] = (f32x4){0.f, 0.f, 0.f, 0.f}; I[mt] = (f32x4){0.f, 0.f, 0.f, 0.f};
#pragma unroll
            for (int ks = 0; ks < 4; ++ks) {
                R[mt] = __builtin_amdgcn_mfma_f32_16x16x32_bf16(fx[ks], Bwa[ks], R[mt], 0, 0, 0);
                I[mt] = __builtin_amdgcn_mfma_f32_16x16x32_bf16(fx[ks], Bwx[ks], I[mt], 0, 0, 0);
            }
            __builtin_amdgcn_sched_barrier(0);
        }
        float xc_[4][4];
#pragma unroll
        for (int mt = 0; mt < 4; ++mt)
#pragma unroll
            for (int r = 0; r < 4; ++r) xc_[mt][r] = XC[(16 * mt + 4 * fq + r) * 132 + c];
        __builtin_amdgcn_sched_barrier(0);
        float av[4][4], bv[4][4], Al[4], Bl[4];
#pragma unroll
        for (int mt = 0; mt < 4; ++mt) {
            Al[mt] = 1.f; Bl[mt] = 0.f;
#pragma unroll
            for (int r = 0; r < 4; ++r) {
                const int i = 16 * mt + 4 * fq + r;
                const float rr = sigmoidf_(R[mt][r] + ba);
                const float ig = sigmoidf_(I[mt][r] + bx);
                const float la = 8.f * rr * ls;
                float aa = __expf(la), mult = __builtin_amdgcn_sqrtf(fmaxf(fmaf(-aa, aa, 1.f), 0.f));
                if (!smp && j == 0 && i == 0) { aa = 0.f; mult = 1.f; }
                av[mt][r] = aa; bv[mt][r] = mult * ig * xc_[mt][r];
                Bl[mt] = aa * Bl[mt] + bv[mt][r]; Al[mt] *= aa;
            }
        }
        float Ag[4][4], Bg[4][4];
#pragma unroll
        for (int mt = 0; mt < 4; ++mt)
#pragma unroll
            for (int q = 0; q < 4; ++q) { Ag[mt][q] = __shfl(Al[mt], fr + 16 * q); Bg[mt][q] = __shfl(Bl[mt], fr + 16 * q); }
        float h0v[4] = {0.f, 0.f, 0.f, 0.f};
        if (smp) {
#pragma unroll
            for (int mt = 0; mt < 4; ++mt) h0v[mt] = a.in[3][(size_t)(bidx * 8 + 2 * mt + (fq >> 1)) * 1024 + col];
        }
#pragma unroll
        for (int mt = 0; mt < 4; ++mt) {
            float hin;
            if (smp) {
                hin = h0v[mt];
                const float A_ = (fq == 1) ? Ag[mt][0] : Ag[mt][2], B_ = (fq == 1) ? Bg[mt][0] : Bg[mt][2];
                hin = (fq & 1) ? A_ * hin + B_ : hin;
            } else {
                hin = carry;
#pragma unroll
                for (int q = 0; q < 3; ++q) hin = (q < fq) ? Ag[mt][q] * hin + Bg[mt][q] : hin;
#pragma unroll
                for (int q = 0; q < 4; ++q) carry = Ag[mt][q] * carry + Bg[mt][q];
            }
#pragma unroll
            for (int r = 0; r < 4; ++r) { hin = av[mt][r] * hin + bv[mt][r]; HS[(16 * mt + 4 * fq + r) * 136 + c] = f2bf(hin); }
            if (smp) { if (fq & 1) a.out[O_SLH + (size_t)(bidx * 8 + 2 * mt + (fq >> 1)) * 1024 + col] = hin; }
            else if (j == ntile - 1 && mt == 3 && fq == 3) a.out[O_PLH + (size_t)bidx * 1024 + col] = hin;
        }
        if (j + 1 < ntile) {
            LAS bf16_t* RWn = (j & 1) ? RW : RW2;
            *(LAS u32x4*)(RWn + (3 + t) * 136 + cc0) = nx0; *(LAS u32x4*)(RWn + (3 + t) * 136 + cc0 + 8) = nx1;
            if (t >= 61) { *(LAS u32x4*)(RWn + (t - 61) * 136 + cc0) = pv0; *(LAS u32x4*)(RWn + (t - 61) * 136 + cc0 + 8) = pv1; }
            pv0 = nx0; pv1 = nx1;
            if (j + 2 < ntile) { nx0 = *(const u32x4*)(Z1 + (size_t)(rowt + 128 + t) * ZW + gc0); nx1 = *(const u32x4*)(Z1 + (size_t)(rowt + 128 + t) * ZW + gc0 + 8); }
        }
    }
    __syncthreads();
    {
        const int rowl = row00 + 64 * (ntile - 1);
#pragma unroll
        for (int q = 0; q < 2; ++q) {
            const int idx = tid + 512 * q, r = idx >> 4, ch = idx & 15;
            if (!dry) *(u32x4*)(Z1 + (size_t)(rowl + r) * ZW + g * 128 + ch * 8) = *(const LAS u32x4*)(HS + r * 136 + ch * 8);
        }
    }
    __syncthreads();
}

#define XB_TMO      128
#define XB_XCNT(j)  (256  + 64 * (j))
#define XB_XSUB(j)  (1280 + 64 * (j))
#define XB_XGEN(j)  (2304 + 64 * (j))
#define XB_TOP      3328
#define XB_TOPGEN   3392
#define XCD_BAR_WORDS 3456
#define XB_SPIN_CAP (1u << 22)
__device__ __forceinline__ unsigned xb_ld(unsigned* p)              { return __hip_atomic_load(p, __ATOMIC_RELAXED, __HIP_MEMORY_SCOPE_AGENT); }
__device__ __forceinline__ unsigned xb_add(unsigned* p, unsigned v) { return __hip_atomic_fetch_add(p, v, __ATOMIC_RELAXED, __HIP_MEMORY_SCOPE_AGENT); }
__device__ __forceinline__ unsigned xb_xcc_id() { return (unsigned)__builtin_amdgcn_s_getreg((3 << 11) | 20) & 0xFu; }
#define XB_SPIN(cond, bar) do { unsigned _sp = 0; while (cond) { __builtin_amdgcn_s_sleep(1); \
    if ((++_sp & 255u) == 0u) { if (xb_ld(&(bar)[XB_TMO])) break; if (_sp > XB_SPIN_CAP) { atomicAdd(&(bar)[XB_TMO], 1u); break; } } } } while (0)
struct XcdBarrier { unsigned* bar; unsigned x; volatile LAS unsigned* st; unsigned G; };
__device__ __forceinline__ XcdBarrier xcd_barrier_post(unsigned* bar, volatile LAS unsigned* st) {
    XcdBarrier b; b.bar = bar; b.x = xb_xcc_id(); b.st = st; b.G = 0u;
    if (threadIdx.x == 0) (void)xb_add(&bar[XB_XCNT(b.x)], 1u);
    return b;
}
__device__ __forceinline__ void xcd_barrier_complete(unsigned* bar, unsigned x, unsigned& nloc, unsigned& nx, const unsigned G) {
    unsigned sum, cnt, mine, sp = 0u;
    for (;;) {
        sum = 0u; cnt = 0u; mine = 0u;
#pragma unroll
        for (unsigned j = 0; j < 16; ++j) { const unsigned c = xb_ld(&bar[XB_XCNT(j)]); sum += c; cnt += (c > 0u) ? 1u : 0u; mine = (j == x) ? c : mine; }
        if (sum == G) break;
        __builtin_amdgcn_s_sleep(1);
        if ((++sp & 255u) == 0u) { if (xb_ld(&bar[XB_TMO])) break; if (sp > XB_SPIN_CAP) { atomicAdd(&bar[XB_TMO], 1u); break; } }
    }
    nloc = mine > 0u ? mine : 1u; nx = cnt > 0u ? cnt : 1u;
}
__device__ __forceinline__ void xcd_barrier(const XcdBarrier& b) {
    asm volatile("s_waitcnt vmcnt(0)" ::: "memory");
    __syncthreads();
    if (threadIdx.x == 0) {
        unsigned* bar = b.bar;
        __builtin_amdgcn_s_waitcnt(0);
        unsigned nloc = b.st[0], nx = b.st[1];
        if (nloc == 0u) { xcd_barrier_complete(bar, b.x, nloc, nx, b.G); b.st[0] = nloc; b.st[1] = nx; }
        const unsigned old = xb_add(&bar[XB_XSUB(b.x)], 1u);
        const unsigned gen = old / nloc;
        if (old + 1u == (gen + 1u) * nloc) {
            __builtin_amdgcn_fence(__ATOMIC_RELEASE, "agent");
            asm volatile("s_waitcnt vmcnt(0)" ::: "memory");
            const unsigned og = xb_add(&bar[XB_TOP], 1u);
            const unsigned tg = og / nx;
            if (og + 1u == (tg + 1u) * nx) xb_add(&bar[XB_TOPGEN], 1u);
            else XB_SPIN(xb_ld(&bar[XB_TOPGEN]) == tg, bar);
            __builtin_amdgcn_fence(__ATOMIC_ACQUIRE, "agent");
            xb_add(&bar[XB_XGEN(b.x)], 1u);
            asm volatile("s_waitcnt vmcnt(0)" ::: "memory");
        } else {
            XB_SPIN(xb_ld(&bar[XB_XGEN(b.x)]) == gen, bar);
            __builtin_amdgcn_fence(__ATOMIC_ACQUIRE, "agent");
            asm volatile("s_waitcnt vmcnt(0)" ::: "memory");
        }
    }
    __syncthreads();
}

#ifndef DRY3_SKIP
#define DRY3_SKIP 0
#endif
__device__ __forceinline__ void p3_scans(const Args& a, LAS unsigned char* L, const bool dry) {
    if (!(dry && (DRY3_SKIP & 1))) for (int u = blockIdx.x; u < 64; u += gridDim.x) gdn_scan_unit<4>(a, L, u >> 3, u & 7, dry);
    if (!(dry && (DRY3_SKIP & 2))) for (int u = blockIdx.x; u < 128; u += gridDim.x) if (u >= 64) lru_unit(a, L, false, (u - 64) >> 3, (u - 64) & 7, dry);
    if (gridDim.x >= 256) {
        const int nb = gridDim.x - 128, b = blockIdx.x - 128;
        if (b >= 0) {
#define SUBBAR() do { XcdBarrier xb_; xb_.bar = (unsigned*)(a.ws + WS_BAR) + 4096; xb_.x = xb_xcc_id(); xb_.st = (volatile LAS unsigned*)(L + LDS_BYTES - 56); xb_.G = 128u; xcd_barrier(xb_); } while (0)
            if (b < 64) {
                const pg8::Gemm g1{(const bf16_t*)(a.ws + WS_U), (const bf16_t*)(a.ws + WS_W1T), NROWS, 4096, 1024, 1024};
                const pg8::Epi<0> E1{(bf16_t*)(a.ws + WS_Z1), (bf16_t*)(a.ws + WS_HALO), a.out};
                const pg8::SeqOrder S1{b, 0, 1, 2};
                pg8::gemm_phase(L, g1, S1, E1);
            } else {
                pg8::Gemm gm0{(const bf16_t*)(a.ws + WS_U), (const bf16_t*)(a.ws + WS_W2T) + (size_t)2048 * 1024, NROWS, 1280, 1024, 1024};
                pg8::StaticOrder Sm0; Sm0.init(NROWS, 1280, 128, b - 64); Sm0.lim = 1;
                pg8::Epi<5> Em0{nullptr, nullptr, a.out};
                pg8::gemm_phase(L, gm0, Sm0, Em0);
            }
            SUBBAR();
            p2_gdn_local(a, L, false, 2048 + b, 128, 1);
            SUBBAR();
#undef SUBBAR
            if (!(dry && (DRY3_SKIP & 8))) for (int u = b; u < 128; u += nb) lru_unit(a, L, true, u >> 3, u & 7, dry);
            if (!(dry && (DRY3_SKIP & 4))) for (int u = b; u < 1024; u += nb) gdn_scan_unit<1>(a, L, u >> 3, u & 7, dry);
            pg8::Gemm gm{(const bf16_t*)(a.ws + WS_U), (const bf16_t*)(a.ws + WS_W2T) + (size_t)2048 * 1024, NROWS, 1280, 1024, 1024};
            pg8::StaticOrder Sm; Sm.init(NROWS, 1280, nb, b); Sm.off = 64; Sm.lim = 2;
            pg8::Epi<5> Em{nullptr, nullptr, a.out};
            pg8::gemm_phase(L, gm, Sm, Em);
        }
    } else {
        {
            pg8::Gemm gm{(const bf16_t*)(a.ws + WS_U), (const bf16_t*)(a.ws + WS_W2T) + (size_t)2048 * 1024, NROWS, 1280, 1024, 1024};
            pg8::StaticOrder Sm; Sm.init(NROWS, 1280, gridDim.x, blockIdx.x);
            pg8::Epi<5> Em{nullptr, nullptr, a.out};
            pg8::gemm_phase(L, gm, Sm, Em);
        }
        for (int u = blockIdx.x; u < 1152; u += gridDim.x) if (u >= 128) gdn_scan_unit<1>(a, L, (u - 128) >> 3, (u - 128) & 7, dry);
        for (int u = blockIdx.x; u < 1280; u += gridDim.x) if (u >= 1152) lru_unit(a, L, true, (u - 1152) >> 3, (u - 1152) & 7, dry);
    }
}

__device__ __forceinline__ void p7_final(const Args& a, const int row_lo, const int row_hi, const int wblk, const int nblk) {
    const int tid = threadIdx.x, lane = tid & 63, wave = tid >> 6;
    const int gw = row_lo + wblk * 8 + wave, NGW = nblk * 8;
    const float* gain = a.in[7];
    f32x4 gn[4];
#pragma unroll
    for (int j = 0; j < 4; ++j) gn[j] = ((const f32x4*)gain)[lane + 64 * j];
    for (int m = gw; m < row_hi; m += NGW) {
        const float* xr = (m < NPROMPT) ? a.in[0] + (size_t)m * DM : a.in[1] + (size_t)(m - NPROMPT) * DM;
        float* yr = a.out + (size_t)m * DM;
        f32x4 v[4]; float s = 0.f;
#pragma unroll
        for (int j = 0; j < 4; ++j) { v[j] = ((const f32x4*)yr)[lane + 64 * j]; s += (v[j].x * v[j].x + v[j].y * v[j].y) + (v[j].z * v[j].z + v[j].w * v[j].w); }
        const float rs = rsqrtf(wave_sum(s) * (1.f / DM) + EPS);
#pragma unroll
        for (int j = 0; j < 4; ++j) { const f32x4 x = ((const f32x4*)xr)[lane + 64 * j]; ((f32x4*)yr)[lane + 64 * j] = x + v[j] * rs * gn[j]; }
    }
}


__global__ void __launch_bounds__(512, 2) hawk_gdn_fwd(Args a) {
    extern __shared__ __attribute__((aligned(16))) unsigned char lds_raw[];
    LAS unsigned char* L = (LAS unsigned char*)lds_raw;
    cg::grid_group grid = cg::this_grid();
    volatile LAS unsigned* xst = (volatile LAS unsigned*)(L + LDS_BYTES - 64);
    if (threadIdx.x < 4) xst[threadIdx.x] = 0u;
    __syncthreads();
    (void)xcd_barrier_post((unsigned*)(a.ws + WS_BAR), xst);
    if (blockIdx.x >= 128) (void)xcd_barrier_post((unsigned*)(a.ws + WS_BAR) + 4096, xst + 2);
    if (a.flags == 0x7fffffff) grid.sync();
    unsigned char* ws = a.ws;
    bf16_t* Z1 = (bf16_t*)(ws + WS_Z1); bf16_t* U = (bf16_t*)(ws + WS_U);
    const int lo = a.ph_lo, hi = a.ph_hi;
#ifndef PH_MASK
#define PH_MASK 0xff
#endif
#define IN(k) (((PH_MASK >> (k)) & 1) && lo <= (k) && (k) < hi)
#define SEAM(k) do { if (IN(k) && IN((k) + 1)) { XcdBarrier xb_; xb_.bar = (unsigned*)(a.ws + WS_BAR); xb_.x = xb_xcc_id(); xb_.st = (volatile LAS unsigned*)(L + LDS_BYTES - 64); xb_.G = gridDim.x; xcd_barrier(xb_); } } while (0)
#ifndef REP0
#define REP0 1
#endif
#ifndef REP1
#define REP1 1
#endif
#ifndef REP6
#define REP6 1
#endif
    if (IN(0)) p0_prologue(a, L);
    SEAM(0);
    if (IN(1)) {
        pg8::Gemm g{U, (const bf16_t*)(ws + WS_W1T), NROWS, 4096, 1024, 1024}; pg8::StaticOrder S; S.init(NPROMPT, 4096, gridDim.x, blockIdx.x);
        pg8::Epi<0> E{Z1, (bf16_t*)(ws + WS_HALO), a.out};
        pg8::gemm_phase(L, g, S, E);
    }
    SEAM(1);
    if (IN(2)) p2_gdn_local(a, L, false, blockIdx.x, 256, 8);
    SEAM(2);
    if (IN(3)) p3_scans(a, L, false);
    SEAM(3);
    if (IN(4)) {
        pg8::Gemm g{U, (const bf16_t*)(ws + WS_W2T), NROWS, 2048, 1024, 1024}; pg8::StaticOrder S; S.init(NROWS, 2048, gridDim.x, blockIdx.x);
        pg8::Epi<1> E{Z1, nullptr, a.out};
        pg8::gemm_phase(L, g, S, E);
        if (blockIdx.x >= 32) {
            pg8::Gemm gm{U, (const bf16_t*)(ws + WS_W2T) + (size_t)(2048 + 1280) * 1024, NROWS, 768, 1024, 1024};
            pg8::StaticOrder Sm; Sm.init(NROWS, 768, gridDim.x - 32, blockIdx.x - 32);
            pg8::Epi<5> Em{nullptr, nullptr, (float*)((bf16_t*)a.out + 1280)};
            pg8::gemm_phase(L, gm, Sm, Em);
            if (blockIdx.x >= 236) {
                pg8::Gemm gm2{U, (const bf16_t*)(ws + WS_W2T) + (size_t)2048 * 1024, NROWS, 1280, 1024, 1024};
                pg8::StaticOrder Sm2; Sm2.init(NROWS, 1280, 1, blockIdx.x - 236); Sm2.off = 320; Sm2.lim = 1;
                pg8::Epi<5> Em2{nullptr, nullptr, a.out};
                pg8::gemm_phase(L, gm2, Sm2, Em2);
            }
        }
    }
    SEAM(4);
    const int bid = blockIdx.x;
    const pg8::Gemm gA{Z1, (const bf16_t*)(ws + WS_WBL), NROWS, 1024, 1024, ZW};
    const pg8::Gemm gB{Z1 + 1024, (const bf16_t*)(ws + WS_WBG), NROWS, 1024, 1024, ZW};
    const pg8::Gemm gY{Z1 + 2048, (const bf16_t*)(ws + WS_WO), NROWS, 1024, 1024, ZW};
    const pg8::Epi<2> E2{Z1, nullptr, a.out}; const pg8::Epi<3> E3{Z1, nullptr, a.out}; const pg8::Epi<4> E4{Z1, nullptr, a.out};
    if (IN(5)) {
        const pg8::SeqOrder S{bid, 0, 1, 0};
        pg8::gemm_phase(L, gA, S, E2);
        pg8::gemm_phase(L, gB, S, E3);
    }
    SEAM(5);
    if (IN(6)) {
        if (bid < 16) { const pg8::SeqOrder S{bid, 0, 1, 1}; pg8::gemm_phase(L, gA, S, E2); pg8::gemm_phase(L, gB, S, E3); }
        else { const int d = bid - 16; const pg8::SeqOrder S{d, 240, (d < 16) ? 2 : 1, 0}; pg8::gemm_phase(L, gY, S, E4); }
    }
    SEAM(6);
    if (IN(7)) {
        if (bid < 16) { const pg8::SeqOrder S{bid, 0, 1, 1}; pg8::gemm_phase(L, gY, S, E4); }
        else p7_final(a, 0, NPROMPT, bid - 16, 240);
        { XcdBarrier xb_; xb_.bar = (unsigned*)(a.ws + WS_BAR); xb_.x = xb_xcc_id(); xb_.st = (volatile LAS unsigned*)(L + LDS_BYTES - 64); xb_.G = gridDim.x; xcd_barrier(xb_); }
        p7_final(a, NPROMPT, NROWS, bid, 256);
    }
#undef IN
#undef SEAM
}

#ifndef N_LAUNCHES
#define N_LAUNCHES 1
#endif

extern "C" void kernel_launch(void* const* d_in, const int* in_sizes, int n_in, void* d_out, int out_size, void* d_ws, size_t ws_size, hipStream_t stream) {
    static int grid = 0;
    if (grid == 0) {
        if (n_in != 23 || ws_size < WS_END) { fprintf(stderr, "kernel_launch: unexpected inputs (n_in %d, ws %zu)\n", n_in, ws_size); grid = -1; return; }
        int dev = 0, cus = 0, per_cu = 0;
        hipGetDevice(&dev);
        hipDeviceGetAttribute(&cus, hipDeviceAttributeMultiprocessorCount, dev);
        if (hipFuncSetAttribute((const void*)hawk_gdn_fwd, hipFuncAttributeMaxDynamicSharedMemorySize, LDS_BYTES) != hipSuccess) { fprintf(stderr, "kernel_launch: hipFuncSetAttribute failed\n"); }
        if (hipOccupancyMaxActiveBlocksPerMultiprocessor(&per_cu, (const void*)hawk_gdn_fwd, 512, LDS_BYTES) != hipSuccess || per_cu < 1) { fprintf(stderr, "kernel_launch: occupancy query says %d\n", per_cu); per_cu = 1; }
        (void)hipGetLastError();
        grid = 256;
        if (grid <= 0) grid = 256;
    }
    if (grid < 0) return;
    if (hipMemsetAsync((char*)d_ws + WS_BAR, 0, 32768, stream) != hipSuccess) { fprintf(stderr, "kernel_launch: memset of barrier words failed\n"); return; }
    Args a{};
    for (int i = 0; i < 23; ++i) a.in[i] = (const float*)d_in[i];
    a.out = (float*)d_out; a.ws = (unsigned char*)d_ws;
#ifndef PLAN
#define PLAN {0, 8, 0}
#endif
    const int plan[] = PLAN;
    const int nl = (int)(sizeof(plan) / sizeof(int)) / 3;
    for (int li = 0; li < nl; ++li) {
        a.ph_lo = plan[3 * li]; a.ph_hi = plan[3 * li + 1]; a.flags = plan[3 * li + 2];
        void* args[] = {&a};
        hipError_t e = hipLaunchCooperativeKernel((const void*)hawk_gdn_fwd, dim3(grid), dim3(512), args, LDS_BYTES, stream);
        if (e != hipSuccess) { fprintf(stderr, "kernel_launch: cooperative launch failed: %s (grid %d)\n", hipGetErrorString(e), grid); break; }
    }
}
```

```cpp
#include <hip/hip_runtime.h>
#include <hip/hip_cooperative_groups.h>
#include <cstdio>
#include <cstdint>
namespace cg = cooperative_groups;

#define LAS __attribute__((address_space(3)))
typedef unsigned short bf16_t;
typedef short bf16x8 __attribute__((ext_vector_type(8)));
typedef short s16x4 __attribute__((ext_vector_type(4)));
typedef float f32x4 __attribute__((ext_vector_type(4)));
typedef unsigned u32x4 __attribute__((ext_vector_type(4)));
typedef unsigned u32x2 __attribute__((ext_vector_type(2)));

constexpr int DM = 1024, NROWS = 17408, NPROMPT = 16384, SEQ = 2048;
constexpr int ZW = 4096;
constexpr float EPS = 1e-6f;
constexpr size_t O_Y = 0, O_PLC = 17825792, O_PLH = 17850368, O_PGC = 17858560, O_PGS = 17932288,
                 O_SLC = 18980864, O_SLH = 19374080, O_SGC = 19505152, O_SGS = 20684800;
constexpr size_t MiB = 1u << 20;
constexpr size_t WS_W1T = 0, WS_W2T = 8 * MiB, WS_WBL = 16 * MiB, WS_WBG = 18 * MiB, WS_WO = 20 * MiB, WS_WA = 22 * MiB, WS_WX = 22 * MiB + 262144,
                 WS_BG = 23 * MiB, WS_GC = 25 * MiB, WS_HALO = 26 * MiB, WS_TINV = 31 * MiB, WS_AQK = 48 * MiB, WS_U = 65 * MiB, WS_Z1 = 99 * MiB, WS_BAR = 235 * MiB, WS_END = 236 * MiB;
constexpr int LDS_BYTES = 147456;

struct Args { const float* in[23]; float* out; unsigned char* ws; int ph_lo, ph_hi, flags, pad; };

typedef float f32x2_t __attribute__((ext_vector_type(2)));
typedef __bf16 bf16x2_t __attribute__((ext_vector_type(2)));
__device__ __forceinline__ unsigned cvt_pk_bf16(float lo, float hi) { f32x2_t v = {lo, hi}; bf16x2_t b = __builtin_convertvector(v, bf16x2_t); return __builtin_bit_cast(unsigned, b); }
__device__ __forceinline__ unsigned cvt_pk_bf16_asm(float lo, float hi) { unsigned r; asm volatile("v_cvt_pk_bf16_f32 %0, %1, %2" : "=v"(r) : "v"(lo), "v"(hi)); return r; }
__device__ __forceinline__ float bflo(unsigned w) { return __uint_as_float(w << 16); }
__device__ __forceinline__ float bfhi(unsigned w) { return __uint_as_float(w & 0xffff0000u); }
__device__ __forceinline__ float bf1(bf16_t b) { return __uint_as_float((unsigned)b << 16); }
__device__ __forceinline__ bf16_t f2bf(float f) { return (bf16_t)(cvt_pk_bf16(f, 0.f) & 0xffffu); }
__device__ __forceinline__ float sigmoidf_(float x) { return __builtin_amdgcn_rcpf(1.f + __expf(-x)); }
__device__ __forceinline__ float siluf_(float x) { return x * sigmoidf_(x); }
template <int CTRL> __device__ __forceinline__ float dpp_mov(float v) { return __int_as_float(__builtin_amdgcn_update_dpp(0, __float_as_int(v), CTRL, 0xF, 0xF, true)); }
__device__ __forceinline__ float row16_sum(float v) { v += dpp_mov<0xB1>(v); v += dpp_mov<0x4E>(v); v += dpp_mov<0x141>(v); v += dpp_mov<0x140>(v); return v; }
__device__ __forceinline__ float wave_sum(float v) {
    v = row16_sum(v);
    v += __shfl_xor(v, 16); v += __shfl_xor(v, 32);
    return v;
}
__device__ __forceinline__ void unpack8(const u32x4 w, float* f) {
    f[0] = bflo(w.x); f[1] = bfhi(w.x); f[2] = bflo(w.y); f[3] = bfhi(w.y); f[4] = bflo(w.z); f[5] = bfhi(w.z); f[6] = bflo(w.w); f[7] = bfhi(w.w);
}
__device__ __forceinline__ u32x4 pack8(const float* f) {
    u32x4 w; w.x = cvt_pk_bf16(f[0], f[1]); w.y = cvt_pk_bf16(f[2], f[3]); w.z = cvt_pk_bf16(f[4], f[5]); w.w = cvt_pk_bf16(f[6], f[7]); return w;
}
__device__ __forceinline__ bf16x8 pack_frag(const f32x4 a, const f32x4 b) {
    u32x4 w; w.x = cvt_pk_bf16(a[0], a[1]); w.y = cvt_pk_bf16(a[2], a[3]); w.z = cvt_pk_bf16(b[0], b[1]); w.w = cvt_pk_bf16(b[2], b[3]);
    return __builtin_bit_cast(bf16x8, w);
}
__device__ __forceinline__ bf16x8 lda_perm(const LAS bf16_t* rowp, int s, int fq, bool second) {
    if (second) return *(const LAS bf16x8*)(rowp + 32 * s + 8 * fq);
    const u32x2 lo = *(const LAS u32x2*)(rowp + 32 * s + 8 * fq);
    u32x4 w; w.x = lo.x; w.y = lo.y; w.z = 0u; w.w = 0u; return __builtin_bit_cast(bf16x8, w);
}
__device__ __forceinline__ void st_perm(LAS bf16_t* rowp, int ch, const u32x4 v) {
    const int c4 = ch & 3, f = 32 * (ch >> 2) + (c4 & 1) * 16 + (c4 >> 1) * 4;
    *(LAS u32x2*)(rowp + f) = (u32x2){v.x, v.y};
    *(LAS u32x2*)(rowp + f + 8) = (u32x2){v.z, v.w};
}
__device__ __forceinline__ s16x4 lds_tr(const LAS bf16_t* p) { return __builtin_bit_cast(s16x4, __builtin_amdgcn_ds_read_tr16_b64_v4i16((LAS s16x4*)p)); }

namespace pg8 {
constexpr int BM = 256, BK = 64, HALF = 128, HTB = HALF * BK * 2, STAGE_BYTES = 8 * HTB, NXCD = 8, WGM = 8;
__host__ __device__ __forceinline__ int lds_byte(int r, int c) { const int st = (r >> 4) * 2 + (c >> 5), rr = r & 15, cc = c & 31, ob = rr * 64 + cc * 2; return st * 1024 + (ob ^ (((ob >> 9) & 1) << 5)); }
__host__ __device__ __forceinline__ void stage_rc(int b, int& R, int& C) { const int st = b / 1024, sb = b % 1024, swz = sb ^ (((sb >> 9) & 1) << 5); R = (st >> 1) * 16 + swz / 64; C = (st & 1) * 32 + (swz % 64) / 2; }
__host__ __device__ __forceinline__ int perm32(int rho) { const int n = rho >> 4, i = rho & 15; return 8 * (i >> 2) + 4 * n + (i & 3); }
struct Unit { int pm, pn; };
struct Gemm { const bf16_t* A; const bf16_t* Bt; int M, N, K, lda; };
struct StaticOrder {
    int nM, nN, nwg, G, c, off, lim;
    __device__ void init(int M, int N, int G_, int c_) { nM = M / BM; nN = N / BM; nwg = nM * nN; G = G_; c = c_; off = 0; lim = 1 << 30; }
    __device__ bool next(int i, Unit& u) const {
        if (i >= lim) return false;
        const long L = (long)off + (long)i * G + c; if (L >= nwg) return false;
        int wgid = (int)L; { const int q = nwg / NXCD, r = nwg % NXCD, xcd = wgid % NXCD, off = wgid / NXCD; wgid = (xcd < r ? xcd * (q + 1) : r * (q + 1) + (xcd - r) * q) + off; }
        const int nig = WGM * nN, gid = wgid / nig, fm = gid * WGM, gsz = (nM - fm) < WGM ? (nM - fm) : WGM;
        u.pm = fm + ((wgid % nig) % gsz); u.pn = (wgid % nig) / gsz; return true;
    }
};
template <int MODE> struct Epi {
    static constexpr bool PERM = true;
    bf16_t* Z1; bf16_t* HALO; float* out;
    __device__ __forceinline__ void operator()(const f32x4 (&acc)[2][2][4][2], const Unit& u, int wr, int wc, int fr, int fq) const {
        const int col0 = u.pn * BM + wc * 32 + 8 * fq;
        if constexpr (MODE == 0 || MODE == 4 || MODE == 5) {
#pragma unroll
        for (int ai = 0; ai < 2; ++ai)
#pragma unroll
            for (int m = 0; m < 4; ++m) {
                const int row = u.pm * BM + ai * HALF + wr * 64 + m * 16 + fr;
                if constexpr (MODE == 0) {
                    bf16_t* rowp = Z1 + (size_t)row * ZW + col0;
                    const bool is_halo = (m == 3) && (fr >= 13) && (row < NPROMPT) && (u.pn >= 4);
                    int cs = -1; float* bl = nullptr; float* bg = nullptr;
                    if (row < NPROMPT) { const int t = row & (SEQ - 1); if (t >= SEQ - 3) { cs = t - (SEQ - 3); const int b = row >> 11; bl = out + O_PLC + (size_t)(b * 3 + cs) * 1024; bg = out + O_PGC + (size_t)(b * 3 + cs) * 3072; } }
                    else { const int t = row & 7; if (t >= 5) { cs = t - 5; const int s = (row - NPROMPT) >> 3; bl = out + O_SLC + (size_t)(s * 3 + cs) * 1024; bg = out + O_SGC + (size_t)(s * 3 + cs) * 3072; } }
#pragma unroll
                    for (int bj = 0; bj < 2; ++bj) {
                        const f32x4 v0 = acc[ai][bj][m][0], v1 = acc[ai][bj][m][1];
                        u32x4 w; w.x = cvt_pk_bf16(v0[0], v0[1]); w.y = cvt_pk_bf16(v0[2], v0[3]); w.z = cvt_pk_bf16(v1[0], v1[1]); w.w = cvt_pk_bf16(v1[2], v1[3]);
                        *(u32x4*)(rowp + bj * HALF) = w;
                        const int col = col0 + bj * HALF;
                        if (is_halo) *(u32x4*)(HALO + (size_t)((row >> 6) * 3 + (fr - 13)) * 3072 + (col - 1024)) = w;
                        if (cs >= 0) { float* d = (u.pn < 4) ? bl + col : bg + (col - 1024); *(f32x4*)d = v0; *(f32x4*)(d + 4) = v1; }
                    }
                } else if constexpr (MODE == 5) {
                    bf16_t* pp = (bf16_t*)out + (size_t)row * 2048 + col0;
#pragma unroll
                    for (int bj = 0; bj < 2; ++bj) {
                        const f32x4 v0 = acc[ai][bj][m][0], v1 = acc[ai][bj][m][1];
                        float o[8] = {v0[0], v0[1], v0[2], v0[3], v1[0], v1[1], v1[2], v1[3]};
#pragma unroll
                        for (int e = 0; e < 8; ++e) o[e] = sigmoidf_(o[e]);
                        *(u32x4*)(pp + bj * HALF) = pack8(o);
                    }
                } else {
                    bf16_t* rowp = (bf16_t*)out + (size_t)row * 2048 + col0;
#pragma unroll
                    for (int bj = 0; bj < 2; ++bj) {
                        const f32x4 v0 = acc[ai][bj][m][0], v1 = acc[ai][bj][m][1];
                        u32x4 w; w.x = cvt_pk_bf16(v0[0], v0[1]); w.y = cvt_pk_bf16(v0[2], v0[3]); w.z = cvt_pk_bf16(v1[0], v1[1]); w.w = cvt_pk_bf16(v1[2], v1[3]);
                        *(u32x4*)(rowp + bj * HALF) = w;
                    }
                }
            }
        } else {
            const int cbase = (MODE == 1) ? col0 : 2048 + col0;
            const bool gate = (MODE == 1);
#pragma unroll
            for (int ai = 0; ai < 2; ++ai)
#pragma unroll
                for (int mh = 0; mh < 2; ++mh) {
                    u32x4 tv[2][2], sv[2][2];
#pragma unroll
                    for (int mm = 0; mm < 2; ++mm) {
                        const size_t rowi = (size_t)(u.pm * BM + ai * HALF + wr * 64 + (2 * mh + mm) * 16 + fr);
                        const bf16_t* rowp = Z1 + rowi * ZW + cbase;
                        const bf16_t* parkp = (const bf16_t*)out + rowi * 2048 + col0 + (MODE == 3 ? 1024 : 0);
#pragma unroll
                        for (int bj = 0; bj < 2; ++bj) {
                            if constexpr (MODE == 1) tv[mm][bj] = *(const u32x4*)(rowp + bj * HALF);
                            if constexpr (MODE == 2) tv[mm][bj] = *(const u32x4*)(parkp + bj * HALF);
                            if constexpr (MODE == 3) { tv[mm][bj] = *(const u32x4*)(rowp + bj * HALF); sv[mm][bj] = *(const u32x4*)(parkp + bj * HALF); }
                        }
                    }
#pragma unroll
                    for (int mm = 0; mm < 2; ++mm) {
                        const int m = 2 * mh + mm;
                        bf16_t* rowp = Z1 + (size_t)(u.pm * BM + ai * HALF + wr * 64 + m * 16 + fr) * ZW + cbase;
#pragma unroll
                        for (int bj = 0; bj < 2; ++bj) {
                            const f32x4 v0 = acc[ai][bj][m][0], v1 = acc[ai][bj][m][1];
                            float o[8] = {v0[0], v0[1], v0[2], v0[3], v1[0], v1[1], v1[2], v1[3]};
                            if constexpr (MODE == 1) {
                                if (gate) { float hf[8]; unpack8(tv[mm][bj], hf);
#pragma unroll
                                    for (int e = 0; e < 8; ++e) o[e] = siluf_(o[e]) * hf[e]; }
                                else {
#pragma unroll
                                    for (int e = 0; e < 8; ++e) o[e] = sigmoidf_(o[e]); }
                            } else if constexpr (MODE == 2) { float sf[8]; unpack8(tv[mm][bj], sf);
#pragma unroll
                                for (int e = 0; e < 8; ++e) o[e] *= sf[e];
                            } else { float tf[8], sf[8]; unpack8(tv[mm][bj], tf); unpack8(sv[mm][bj], sf);
#pragma unroll
                                for (int e = 0; e < 8; ++e) o[e] = tf[e] + sf[e] * o[e]; }
                            *(u32x4*)(rowp + bj * HALF) = pack8(o);
                        }
                    }
                }
        }
    }
};

struct SeqOrder {
    int base, step, n, smp;
    __device__ bool next(int i, Unit& u) const {
        if (i >= n) return false;
        const int t = base + i * step;
        if (smp == 2) { u.pm = 64 + (t >> 4); u.pn = t & 15; }
        else if (smp) { u.pm = 64 + (t >> 2); u.pn = t & 3; }
        else { u.pm = (t & 7) * 8 + ((t >> 3) >> 2); u.pn = (t >> 3) & 3; }
        return true;
    }
};
template <class EpiT, class SchedT>
__device__ __forceinline__ void gemm_phase(LAS unsigned char* lds, const Gemm g, const SchedT& S, const EpiT& E) {
    const int tid = threadIdx.x, wid = __builtin_amdgcn_readfirstlane(tid >> 6), lane = tid & 63, wr = wid >> 2, wc = wid & 3, fr = lane & 15, fq = lane >> 4;
    const int K = g.K, nt = K / BK, lda = g.lda;
    unsigned voffA[2], voffB[2];
#pragma unroll
    for (int i = 0; i < 2; ++i) { int R, C; stage_rc(tid * 16 + i * 8192, R, C); const int Rb = EpiT::PERM ? ((R & ~31) + perm32(R & 31)) : R;
        voffA[i] = (unsigned)(R * lda + C) * 2u; voffB[i] = (unsigned)(Rb * K + C) * 2u; }
    const size_t kstep = (size_t)(BK * 2);
    const size_t hsA = (size_t)HALF * lda * 2, hsB = (size_t)HALF * K * 2;
    const size_t tsA = 2 * hsA, tsB = 2 * hsB;
    const unsigned ldsw = (unsigned)wid * 1024u;
    const int aoff = lds_byte(wr * 64 + fr, fq * 8), boff = lds_byte(wc * 32 + fr, fq * 8);
#define PG8_SA(b, h) (((b) * 2 + (h)) * HTB)
#define PG8_SB(b, h) ((4 + (b) * 2 + (h)) * HTB)
#define PG8_STAGE(bufoff, gbase, voff) do { _Pragma("unroll") for (int _i = 0; _i < 2; ++_i) \
        __builtin_amdgcn_global_load_lds((const unsigned*)((const char*)(gbase) + (voff)[_i]), (LAS unsigned*)(lds + (bufoff) + ldsw + _i * 8192), 16, 0, 0); } while (0)
#define PG8_LDA(dst, b, h) do { _Pragma("unroll") for (int m = 0; m < 4; ++m) _Pragma("unroll") for (int k = 0; k < 2; ++k) dst[m][k] = *(const LAS bf16x8*)(lds + PG8_SA(b, h) + aoff + m * 2048 + k * 1024); } while (0)
#define PG8_LDB(dst, b, h) do { _Pragma("unroll") for (int n = 0; n < 2; ++n) _Pragma("unroll") for (int k = 0; k < 2; ++k) dst[n][k] = *(const LAS bf16x8*)(lds + PG8_SB(b, h) + boff + n * 2048 + k * 1024); } while (0)
#define PG8_MMA(ai, bj, At, Bt) do { __builtin_amdgcn_s_setprio(1); _Pragma("unroll") for (int m = 0; m < 4; ++m) _Pragma("unroll") for (int n = 0; n < 2; ++n) _Pragma("unroll") for (int k = 0; k < 2; ++k) \
        acc[ai][bj][m][n] = __builtin_amdgcn_mfma_f32_16x16x32_bf16(Bt[n][k], At[m][k], acc[ai][bj][m][n], 0, 0, 0); __builtin_amdgcn_s_setprio(0); } while (0)
#define PG8_WAIT_V(n) asm volatile("s_waitcnt vmcnt(" #n ")" ::: "memory")
#define PG8_WAIT_L(n) asm volatile("s_waitcnt lgkmcnt(" #n ")" ::: "memory")
#define PG8_BAR __builtin_amdgcn_s_barrier()
#define PG8_SCHED __builtin_amdgcn_sched_barrier(0)
    Unit cur, nxt; int ui = 0;
    if (!S.next(0, cur)) return;
    f32x4 acc[2][2][4][2];
#pragma unroll
    for (int a = 0; a < 2; ++a)
#pragma unroll
        for (int b = 0; b < 2; ++b)
#pragma unroll
            for (int m = 0; m < 4; ++m)
#pragma unroll
                for (int n = 0; n < 2; ++n) acc[a][b][m][n] = (f32x4){0.f, 0.f, 0.f, 0.f};
    bf16x8 At[4][2], B0[2][2], B1[2][2];
    const char* cA = (const char*)g.A + (size_t)cur.pm * tsA; const char* cB = (const char*)g.Bt + (size_t)cur.pn * tsB;
    PG8_STAGE(PG8_SB(0, 0), cB, voffB); PG8_STAGE(PG8_SB(0, 1), cB + hsB, voffB); PG8_STAGE(PG8_SA(0, 0), cA, voffA); PG8_STAGE(PG8_SA(0, 1), cA + hsA, voffA);
    if (wr == 1) PG8_BAR;
    PG8_WAIT_V(2); PG8_BAR;
    PG8_STAGE(PG8_SB(1, 0), cB + kstep, voffB); PG8_STAGE(PG8_SA(1, 0), cA + kstep, voffA); PG8_STAGE(PG8_SB(1, 1), cB + hsB + kstep, voffB);
    PG8_WAIT_V(6); PG8_BAR;
    for (;;) {
        const bool has_next = S.next(ui + 1, nxt);
        const char* nA = has_next ? (const char*)g.A + (size_t)nxt.pm * tsA : cA; const char* nB = has_next ? (const char*)g.Bt + (size_t)nxt.pn * tsB : cB;
        for (int t = 0; t < nt; t += 2) {
            const bool last = (t == nt - 2);
            const char* a1 = cA + (size_t)(t + 1) * kstep;
            const char* a2 = last ? nA : cA + (size_t)(t + 2) * kstep; const char* b2 = last ? nB : cB + (size_t)(t + 2) * kstep;
            const char* a3 = a2 + kstep; const char* b3 = b2 + kstep;
            PG8_LDB(B0, 0, 0); PG8_LDB(B1, 0, 1); PG8_SCHED; PG8_LDA(At, 0, 0); PG8_STAGE(PG8_SA(1, 1), a1 + hsA, voffA);
            PG8_WAIT_V(8); PG8_WAIT_L(0); PG8_BAR; PG8_MMA(0, 0, At, B0); PG8_MMA(0, 1, At, B1); PG8_BAR; PG8_SCHED;
            PG8_LDA(At, 0, 1); PG8_STAGE(PG8_SB(0, 0), b2, voffB); PG8_STAGE(PG8_SB(0, 1), b2 + hsB, voffB); PG8_STAGE(PG8_SA(0, 0), a2, voffA);
            PG8_WAIT_V(8); PG8_WAIT_L(0); PG8_BAR; PG8_MMA(1, 0, At, B0); PG8_MMA(1, 1, At, B1); PG8_BAR; PG8_SCHED;
            PG8_LDB(B0, 1, 0); PG8_LDB(B1, 1, 1); PG8_SCHED; PG8_LDA(At, 1, 0); PG8_STAGE(PG8_SA(0, 1), a2 + hsA, voffA);
            PG8_WAIT_V(8); PG8_WAIT_L(0); PG8_BAR; PG8_MMA(0, 0, At, B0); PG8_MMA(0, 1, At, B1); PG8_BAR; PG8_SCHED;
            PG8_LDA(At, 1, 1); PG8_STAGE(PG8_SB(1, 0), b3, voffB); PG8_STAGE(PG8_SB(1, 1), b3 + hsB, voffB); PG8_STAGE(PG8_SA(1, 0), a3, voffA);
            PG8_WAIT_V(8); PG8_WAIT_L(0); PG8_BAR; PG8_MMA(1, 0, At, B0); PG8_MMA(1, 1, At, B1); PG8_BAR; PG8_SCHED;
        }
        if (wr == 0) PG8_BAR;
        E(acc, cur, wr, wc, fr, fq);
        if (!has_next) break;
#pragma unroll
        for (int a = 0; a < 2; ++a)
#pragma unroll
            for (int b = 0; b < 2; ++b)
#pragma unroll
                for (int m = 0; m < 4; ++m)
#pragma unroll
                    for (int n = 0; n < 2; ++n) acc[a][b][m][n] = (f32x4){0.f, 0.f, 0.f, 0.f};
        cur = nxt; cA = nA; cB = nB; ++ui;
        if (wr == 1) PG8_BAR;
    }
    PG8_WAIT_V(0);
    PG8_BAR;
#undef PG8_SA
#undef PG8_SB
#undef PG8_STAGE
#undef PG8_LDA
#undef PG8_LDB
#undef PG8_MMA
#undef PG8_WAIT_V
#undef PG8_WAIT_L
#undef PG8_BAR
#undef PG8_SCHED
}
}

__device__ __forceinline__ void transpose_item(const float* W, int ldw, int src_col, bf16_t* WTrow, int k0, int lane) {
#pragma unroll
    for (int hf = 0; hf < 2; ++hf) {
        float v[32];
#pragma unroll
        for (int kk = 0; kk < 32; ++kk) v[kk] = W[(size_t)(k0 + hf * 32 + kk) * ldw + src_col + lane];
#pragma unroll
        for (int q = 0; q < 4; ++q) { u32x4 w; w.x = cvt_pk_bf16_asm(v[8 * q], v[8 * q + 1]); w.y = cvt_pk_bf16_asm(v[8 * q + 2], v[8 * q + 3]); w.z = cvt_pk_bf16_asm(v[8 * q + 4], v[8 * q + 5]); w.w = cvt_pk_bf16_asm(v[8 * q + 6], v[8 * q + 7]);
            *(u32x4*)(WTrow + k0 + hf * 32 + 8 * q) = w; }
    }
}
__device__ __forceinline__ void p0_prologue(const Args& a, LAS unsigned char* L) {
    const int tid = threadIdx.x, lane = tid & 63, wave = tid >> 6;
    const int gw = blockIdx.x * 8 + wave, NGW = gridDim.x * 8;
    unsigned char* ws = a.ws;
    const float* w_in = a.in[8];
    for (int it = gw; it < 2880; it += NGW) {
        if (it < 2048) {
            const int which = it >> 10, r = it & 1023, nb = r >> 4, kb = r & 15, n0 = nb * 64;
            int src;
            if (which == 0) src = (n0 < 1024) ? n0 : n0 + 1024;
            else src = (n0 < 1024) ? 1024 + n0 : (n0 < 2048) ? 5120 + (n0 - 1024) : (n0 < 3072) ? 6160 + (n0 - 2048) : 7184 + (n0 - 3072);
            bf16_t* WT = (bf16_t*)(ws + (which ? WS_W2T : WS_W1T));
            transpose_item(w_in, 8208, src, WT + (size_t)(n0 + lane) * 1024, kb * 64, lane);
        } else if (it < 2816) {
            const int r = it - 2048, which = r >> 8, q = r & 255, nb = q >> 4, kb = q & 15;
            const float* W = which == 0 ? a.in[20] : which == 1 ? a.in[21] : a.in[22];
            bf16_t* WT = (bf16_t*)(ws + (which == 0 ? WS_WBL : which == 1 ? WS_WBG : WS_WO));
            transpose_item(W, 1024, nb * 64, WT + (size_t)(nb * 64 + lane) * 1024, kb * 64, lane);
        } else {
            const int r = it - 2816, which = r >> 5, q = r & 31, g = q >> 2, nb = (q >> 1) & 1, kb = q & 1;
            const float* W = (which == 0 ? a.in[11] : a.in[13]) + (size_t)g * 16384;
            bf16_t* WT = (bf16_t*)(ws + (which == 0 ? WS_WA : WS_WX)) + (size_t)g * 16384;
            transpose_item(W, 128, nb * 64, WT + (size_t)(nb * 64 + lane) * 128, kb * 64, lane);
        }
    }
    LAS float* wT = (LAS float*)L;
    for (int idx = tid; idx < 16384; idx += 512) { const int k = idx >> 4, c = idx & 15; wT[c * 1024 + k] = w_in[(size_t)k * 8208 + 6144 + c]; }
    __syncthreads();
    const float* x_p = a.in[0]; const float* x_s = a.in[1]; const float* gain = a.in[6];
    bf16_t* U = (bf16_t*)(ws + WS_U); float* BG = (float*)(ws + WS_BG);
    f32x4 gn[4];
#pragma unroll
    for (int j = 0; j < 4; ++j) gn[j] = ((const f32x4*)gain)[lane + 64 * j];
    for (int m = gw; m < NROWS; m += NGW) {
        const float* xr = (m < NPROMPT) ? x_p + (size_t)m * DM : x_s + (size_t)(m - NPROMPT) * DM;
        f32x4 v[4]; float s = 0.f;
#pragma unroll
        for (int j = 0; j < 4; ++j) { v[j] = ((const f32x4*)xr)[lane + 64 * j]; s += (v[j].x * v[j].x + v[j].y * v[j].y) + (v[j].z * v[j].z + v[j].w * v[j].w); }
        const float rs = rsqrtf(wave_sum(s) * (1.f / DM) + EPS);
#pragma unroll
        for (int j = 0; j < 4; ++j) { v[j] = v[j] * rs * gn[j];
            u32x2 o; o.x = cvt_pk_bf16(v[j].x, v[j].y); o.y = cvt_pk_bf16(v[j].z, v[j].w);
            ((u32x2*)(U + (size_t)m * DM))[lane + 64 * j] = o; }
        float mine = 0.f;
#pragma unroll 1
        for (int c0 = 0; c0 < 16; c0 += 4) {
            float p[4];
#pragma unroll
            for (int cc = 0; cc < 4; ++cc) {
                p[cc] = 0.f;
#pragma unroll
                for (int j = 0; j < 4; ++j) { const f32x4 w = ((const LAS f32x4*)(wT + (c0 + cc) * 1024))[lane + 64 * j]; p[cc] += (v[j].x * w.x + v[j].y * w.y) + (v[j].z * w.z + v[j].w * w.w); }
            }
#pragma unroll
            for (int cc = 0; cc < 4; ++cc) p[cc] = row16_sum(p[cc]);
#pragma unroll
            for (int cc = 0; cc < 4; ++cc) p[cc] += __shfl_xor(p[cc], 16);
#pragma unroll
            for (int cc = 0; cc < 4; ++cc) p[cc] += __shfl_xor(p[cc], 32);
#pragma unroll
            for (int cc = 0; cc < 4; ++cc) if (lane == c0 + cc) mine = p[cc];
        }
        if (lane < 8) BG[(size_t)m * 16 + lane] = 1.f / (1.f + expf(-mine));
        else if (lane < 16) { const int h = lane - 8; const float xx = mine + a.in[18][h]; const float sp = xx > 20.f ? xx : log1pf(expf(xx)); BG[(size_t)m * 16 + lane] = -expf(a.in[17][h]) * sp; }
    }
}

#ifndef DRY_SKIP
#define DRY_SKIP 0
#endif
__device__ __forceinline__ void p2_gdn_local(const Args& a, LAS unsigned char* L, const bool dry, const int u0, const int ustep, const int un) {
    const int tid = threadIdx.x, lane = tid & 63, wave = __builtin_amdgcn_readfirstlane(tid >> 6), fr = lane & 15, fq = lane >> 4;
    LAS bf16_t* QS = (LAS bf16_t*)(L);
    LAS bf16_t* KS = (LAS bf16_t*)(L + 17408);
    LAS float* MS = (LAS float*)(L + 52224);
    LAS bf16_t* AS = (LAS bf16_t*)(L + 68864);
    LAS bf16_t* TS = (LAS bf16_t*)(L + 78080);
    LAS float* GCS = (LAS float*)(L + 87296);
    LAS float* BES = (LAS float*)(L + 87552);
    LAS bf16_t* RAW = (LAS bf16_t*)(L + 87808);
    LAS float* CW = (LAS float*)(L + 140336);
    LAS bf16_t* SH = (LAS bf16_t*)(L + 52224);
    bf16_t* Z1 = (bf16_t*)(a.ws + WS_Z1); const bf16_t* HALO = (const bf16_t*)(a.ws + WS_HALO);
    const float* BG = (const float*)(a.ws + WS_BG); float* GC = (float*)(a.ws + WS_GC);
    bf16_t* TINV = (bf16_t*)(a.ws + WS_TINV); bf16_t* AQK = (bf16_t*)(a.ws + WS_AQK);
    const float* st_gc = a.in[4]; const float* cw = a.in[16];
    u32x4 nr[7];
    int zo[7], lo[7];
#pragma unroll
    for (int k = 0; k < 7; ++k) {
        int q = tid + 512 * k; if (q > 3215) q = 3215;
        const int rr = q / 48, rem = q - rr * 48;
        zo[k] = (rr >= 3 ? rr - 3 : 0) * ZW + (rem >> 4) * 1024 + (rem & 15) * 8;
        lo[k] = rr * 392 + rem * 8;
    }
    const int rr0 = tid / 48;
    const int ho0 = rr0 * 3072 + ((tid - rr0 * 48) >> 4) * 1024 + ((tid - rr0 * 48) & 15) * 8;
    auto prefetch = [&](int u) {
        const int grp = u >> 3, h = u & 7; const bool smp = grp >= 256; const bool nohalo = smp || ((grp & 31) == 0);
        const bf16_t* zb = Z1 + (size_t)grp * 64 * ZW + 1024 + h * 128;
#pragma unroll
        for (int k = 0; k < 7; ++k) {
            const bf16_t* src = zb + zo[k];
            if (k == 0 && rr0 < 3 && !nohalo) src = HALO + (size_t)(grp - 1) * 3 * 3072 + h * 128 + ho0;
            u32x4 v = *(const u32x4*)src;
            if (k == 0 && rr0 < 3 && nohalo) v = (u32x4){0u, 0u, 0u, 0u};
            nr[k] = v;
        }
    };
    int hprev = -1;
    if (un > 0) prefetch(u0);
    for (int ui = 0; ui < un; ++ui) {
        const int u = u0 + ui * ustep;
        const int grp = u >> 3, h = u & 7; const bool smp = grp >= 256; const int row0 = grp * 64;
        const int t = tid >> 3, p = tid & 7;
        __syncthreads();
#pragma unroll
        for (int k = 0; k < 7; ++k) {
            const int q = tid + 512 * k;
            if (q < 3216) *(LAS u32x4*)(RAW + lo[k]) = nr[k];
        }
        if (h != hprev) {
#pragma unroll
            for (int k = 0; k < 3; ++k) { const int idx = tid + 512 * k, i = idx / 384, c = idx - i * 384; CW[idx] = cw[(size_t)i * 3072 + (c >> 7) * 1024 + h * 128 + (c & 127)]; }
            hprev = h;
        }
        if (smp) {
            for (int idx = tid; idx < 9216; idx += 512) { const int sr = idx / 384, c = idx - sr * 384;
                SH[sr * 392 + c] = f2bf(st_gc[(size_t)((grp - 256) * 24 + sr) * 3072 + (c >> 7) * 1024 + h * 128 + (c & 127)]); }
        }
        if (tid < 64) {
            float g = BG[(size_t)(row0 + tid) * 16 + 8 + h]; const float be = BG[(size_t)(row0 + tid) * 16 + h];
            const int li = smp ? (tid & 7) : tid;
#pragma unroll
            for (int d = 1; d < 64; d <<= 1) { const float o = __shfl_up(g, d); if (li >= d) g += o; }
            GCS[tid] = g; BES[tid] = be; GC[(size_t)(row0 + tid) * 8 + h] = g;
        }
        __syncthreads();
        if (ui + 1 < un) prefetch(u + ustep);
#pragma unroll 1
        for (int seg = (dry && (DRY_SKIP & 4)) ? 3 : 0; seg < 3; ++seg) {
            float av[16];
#pragma unroll
            for (int e = 0; e < 16; ++e) av[e] = 0.f;
#pragma unroll
            for (int i = 0; i < 4; ++i) {
                const int ts8 = (t & 7) - 3 + i;
                const LAS bf16_t* rp = (smp && ts8 < 0) ? SH + ((t >> 3) * 3 + ts8 + 3) * 392 : RAW + (t + i) * 392;
                rp += seg * 128 + 16 * p;
                float xv[16];
                const u32x4 w0 = *(const LAS u32x4*)rp, w1 = *(const LAS u32x4*)(rp + 8); unpack8(w0, xv); unpack8(w1, xv + 8);
                const LAS float* wp = CW + i * 384 + seg * 128 + 16 * p;
#pragma unroll
                for (int q = 0; q < 4; ++q) { const f32x4 f = *(const LAS f32x4*)(wp + 4 * q); av[4 * q] += f.x * xv[4 * q]; av[4 * q + 1] += f.y * xv[4 * q + 1]; av[4 * q + 2] += f.z * xv[4 * q + 2]; av[4 * q + 3] += f.w * xv[4 * q + 3]; }
            }
            float ss = 0.f;
#pragma unroll
            for (int e = 0; e < 16; ++e) { av[e] = siluf_(av[e]); ss += av[e] * av[e]; }
            ss += __shfl_xor(ss, 1); ss += __shfl_xor(ss, 2); ss += __shfl_xor(ss, 4);
            const float rs = (seg == 2) ? 1.f : rsqrtf(ss + EPS) * (seg == 0 ? 0.08838834764831845f : 1.f);
#pragma unroll
            for (int e = 0; e < 16; ++e) av[e] *= rs;
            LAS bf16_t* d = QS + seg * 8704 + t * 136 + 16 * p;
            *(LAS u32x4*)d = pack8(av); *(LAS u32x4*)(d + 8) = pack8(av + 8);
        }
        __syncthreads();
        if (!dry)
#pragma unroll
        for (int q = 0; q < 6; ++q) {
            const int idx = tid + 512 * q, seg = idx >> 10, r = (idx >> 4) & 63, ch = idx & 15;
            *(u32x4*)(Z1 + (size_t)(row0 + r) * ZW + 1024 + seg * 1024 + h * 128 + ch * 8) = *(const LAS u32x4*)(QS + seg * 8704 + r * 136 + ch * 8);
        }
        if (!(dry && (DRY_SKIP & 2)))
        {
            const int sel = wave >> 2, ti = wave & 3;
            const LAS bf16_t* XA = sel ? QS : KS;
            bf16x8 af[4], bfr[4][4]; float gi[4], bi[4], gj[4];
#pragma unroll
            for (int ks = 0; ks < 4; ++ks) af[ks] = *(const LAS bf16x8*)(XA + (16 * ti + fr) * 136 + 32 * ks + 8 * fq);
#pragma unroll
            for (int tj = 0; tj < 4; ++tj) {
                gj[tj] = GCS[16 * tj + fr];
#pragma unroll
                for (int ks = 0; ks < 4; ++ks) bfr[tj][ks] = *(const LAS bf16x8*)(KS + (16 * tj + fr) * 136 + 32 * ks + 8 * fq);
            }
#pragma unroll
            for (int r = 0; r < 4; ++r) { gi[r] = GCS[16 * ti + 4 * fq + r]; bi[r] = BES[16 * ti + 4 * fq + r]; }
            __builtin_amdgcn_sched_barrier(0);
            f32x4 acc[4];
#pragma unroll
            for (int tj = 0; tj < 4; ++tj) {
                acc[tj] = (f32x4){0.f, 0.f, 0.f, 0.f};
                if (tj <= ti) {
#pragma unroll
                    for (int ks = 0; ks < 4; ++ks) acc[tj] = __builtin_amdgcn_mfma_f32_16x16x32_bf16(af[ks], bfr[tj][ks], acc[tj], 0, 0, 0);
                }
            }
            float ov[4][4];
#pragma unroll
            for (int tj = 0; tj < 4; ++tj)
#pragma unroll
                for (int r = 0; r < 4; ++r) {
                    const int i = 16 * ti + 4 * fq + r, j = 16 * tj + fr;
                    const bool same = smp ? ((i >> 3) == (j >> 3)) : true;
                    const float e = __expf(fminf(gi[r] - gj[tj], 0.f));
                    const bool keep = same && (sel == 0 ? (i > j) : (i >= j));
                    ov[tj][r] = keep ? (sel == 0 ? bi[r] : 1.f) * acc[tj][r] * e : 0.f;
                }
            if (sel == 0) {
#pragma unroll
                for (int tj = 0; tj < 4; ++tj)
#pragma unroll
                    for (int r = 0; r < 4; ++r) MS[(16 * ti + 4 * fq + r) * 65 + 16 * tj + fr] = ov[tj][r];
            } else {
#pragma unroll
                for (int tj = 0; tj < 4; ++tj)
#pragma unroll
                    for (int r = 0; r < 4; ++r) AS[(16 * ti + 4 * fq + r) * 72 + 16 * tj + fr] = f2bf(ov[tj][r]);
            }
        }
        __syncthreads();
        if (!(dry && (DRY_SKIP & 1)))
        {
            float mrow[64];
#pragma unroll
            for (int j = 0; j < 64; ++j) mrow[j] = MS[lane * 65 + j];
            float X[8];
#pragma unroll
            for (int cc = 0; cc < 8; ++cc) X[cc] = (lane == 8 * cc + wave) ? 1.f : 0.f;
#pragma unroll
            for (int j = 0; j < 64; ++j) {
                float sv[8];
#pragma unroll
                for (int cc = 0; cc < 8; ++cc) sv[cc] = (8 * cc <= j) ? __uint_as_float(__builtin_amdgcn_readlane(__float_as_uint(X[cc]), j)) : 0.f;
                const float nm = -mrow[j];
#pragma unroll
                for (int cc = 0; cc < 8; ++cc) if (8 * cc <= j) X[cc] = fmaf(nm, sv[cc], X[cc]);
            }
#pragma unroll
            for (int cc = 0; cc < 8; ++cc) TS[lane * 72 + 8 * cc + wave] = f2bf(X[cc]);
        }
        __syncthreads();
        {
            const int r = tid >> 3, ch = tid & 7;
            const size_t o = ((size_t)u * 64 + r) * 64 + ch * 8;
            *(u32x4*)(TINV + o) = *(const LAS u32x4*)(TS + r * 72 + ch * 8);
            *(u32x4*)(AQK + o) = *(const LAS u32x4*)(AS + r * 72 + ch * 8);
        }
    }
    __syncthreads();
}

__device__ __forceinline__ u32x4 gdn_norm8(const u32x4 o8, const LAS float* part8, const LAS float* nw8) {
    const f32x4 p0 = *(const LAS f32x4*)part8, p1 = *(const LAS f32x4*)(part8 + 4);
    const float tot = ((p0[0] + p0[1]) + (p0[2] + p0[3])) + ((p1[0] + p1[1]) + (p1[2] + p1[3]));
    const float rs = rsqrtf(tot * (1.f / 128.f) + EPS);
    float f[8]; unpack8(o8, f);
#pragma unroll
    for (int e = 0; e < 8; ++e) f[e] = f[e] * rs * nw8[e];
    return pack8(f);
}

template <int MT>
__device__ __forceinline__ void gdn_scan_unit(const Args& a, LAS unsigned char* L, int sq, int h, const bool dry) {
    constexpr bool SMP = (MT == 1);
    constexpr int NR = MT * 16, NS2 = (MT + 1) / 2, NV = SMP ? 8 : 64;
    constexpr int BUFB = 71168;
    const int tid = threadIdx.x, lane = tid & 63, wave = __builtin_amdgcn_readfirstlane(tid >> 6), fr = lane & 15, fq = lane >> 4;
    LAS float* OSS = (LAS float*)(L + 2 * BUFB);
    bf16_t* Z1 = (bf16_t*)(a.ws + WS_Z1);
    const float* BG = (const float*)(a.ws + WS_BG); const float* GC = (const float*)(a.ws + WS_GC);
    const bf16_t* TINV = (const bf16_t*)(a.ws + WS_TINV); const bf16_t* AQK = (const bf16_t*)(a.ws + WS_AQK);
    const int dv = 16 * wave + fr;
    LAS float* NWS = (LAS float*)(L + 2 * BUFB + 2048);
    if (tid < 128) NWS[tid] = a.in[19][tid];
    const LAS float* nw8 = NWS + (tid & 15) * 8;
    f32x4 S[8];
    if (SMP) {
        const float* S0 = a.in[5] + (size_t)(sq * 8 + h) * 16384;
#pragma unroll
        for (int dt = 0; dt < 8; ++dt)
#pragma unroll
            for (int r = 0; r < 4; ++r) S[dt][r] = S0[(size_t)(16 * dt + 4 * fq + r) * 128 + dv];
    } else {
#pragma unroll
        for (int dt = 0; dt < 8; ++dt) S[dt] = (f32x4){0.f, 0.f, 0.f, 0.f};
    }
    const int nch = SMP ? 1 : 32;
    const int o8 = SMP ? (sq & 7) * 8 : 0;
    u32x4 pk[6], pt[2]; float pg = 0.f, pb = 0.f;
    auto load_chunk = [&](int c) {
        const int rowc = SMP ? NPROMPT + sq * 8 : sq * SEQ + 64 * c;
        const int grp = SMP ? 256 + (sq >> 3) : (sq * 32 + c);
#pragma unroll
        for (int q = 0; q < 2; ++q) {
            const int idx = tid + 512 * q, r = idx >> 4, ch = idx & 15;
            const bool ok = SMP ? ((idx < NR * 16) && (r < NV)) : true;
            const int rcl = ok ? r : 0;
#pragma unroll
            for (int seg = 0; seg < 3; ++seg) {
                u32x4 v = *(const u32x4*)(Z1 + (size_t)(rowc + rcl) * ZW + 1024 + seg * 1024 + h * 128 + ch * 8);
                if (!ok) v = (u32x4){0u, 0u, 0u, 0u};
                pk[q * 3 + seg] = v;
            }
        }
        {
            const int r = tid >> 3, ch = tid & 7;
            bool ok; size_t o;
            if (SMP) { ok = (r < 8) && (ch == 0); o = ((size_t)(grp * 8 + h) * 64 + o8 + (ok ? r : 0)) * 64 + o8; }
            else { ok = true; o = ((size_t)(grp * 8 + h) * 64 + r) * 64 + ch * 8; }
            u32x4 v0 = *(const u32x4*)(TINV + o), v1 = *(const u32x4*)(AQK + o);
            if (!ok) { v0 = (u32x4){0u, 0u, 0u, 0u}; v1 = v0; }
            pt[0] = v0; pt[1] = v1;
        }
        if (tid < 64) { const bool ok = tid < NV; const int tc = ok ? tid : 0; pg = GC[(size_t)(rowc + tc) * 8 + h]; pb = BG[(size_t)(rowc + tc) * 16 + h]; if (!ok) { pg = 0.f; pb = 0.f; } }
    };
    auto write_chunk = [&](LAS unsigned char* B) {
        LAS bf16_t* KSb = (LAS bf16_t*)(B); LAS bf16_t* QSb = (LAS bf16_t*)(B + 17408); LAS bf16_t* VSb = (LAS bf16_t*)(B + 34816);
        LAS bf16_t* TSb = (LAS bf16_t*)(B + 52224); LAS bf16_t* ASb = (LAS bf16_t*)(B + 61440);
#pragma unroll
        for (int q = 0; q < 2; ++q) {
            const int idx = tid + 512 * q, r = idx >> 4, ch = idx & 15;
            if (idx < NR * 16) {
                st_perm(QSb + r * 136, ch, pk[q * 3 + 0]);
                st_perm(KSb + r * 136, ch, pk[q * 3 + 1]);
                *(LAS u32x4*)(VSb + r * 136 + ch * 8) = pk[q * 3 + 2];
            }
        }
        { const int r = tid >> 3, ch = tid & 7; if (r < NR) { st_perm(TSb + r * 72, ch, pt[0]); st_perm(ASb + r * 72, ch, pt[1]); } }
        if (tid < 64) { ((LAS float*)(B + 70656))[tid] = pg; ((LAS float*)(B + 70912))[tid] = pb; }
    };
    load_chunk(0);
    write_chunk(L);
    if (nch > 1) load_chunk(1);
#define SB_ __builtin_amdgcn_sched_barrier(0)
    for (int c = 0; c < nch; ++c) {
        const int rowc = SMP ? NPROMPT + sq * 8 : sq * SEQ + 64 * c;
        LAS unsigned char* B = L + (c & 1) * BUFB;
        LAS unsigned char* Bo = L + ((c & 1) ^ 1) * BUFB;
        LAS bf16_t* KS = (LAS bf16_t*)(B); LAS bf16_t* QS = (LAS bf16_t*)(B + 17408); LAS bf16_t* VS = (LAS bf16_t*)(B + 34816);
        LAS bf16_t* TS = (LAS bf16_t*)(B + 52224); LAS bf16_t* AS = (LAS bf16_t*)(B + 61440);
        LAS float* GCS = (LAS float*)(B + 70656); LAS float* BES = (LAS float*)(B + 70912);
        __syncthreads();
        if (c > 0 && !dry) {
            const LAS bf16_t* OSo = (const LAS bf16_t*)(Bo + 17408);
#pragma unroll
            for (int q = 0; q < 2; ++q) {
                const int idx = tid + 512 * q, r = idx >> 4, ch = idx & 15;
                *(u32x4*)(Z1 + (size_t)(rowc - 64 + r) * ZW + 1024 + h * 128 + ch * 8) = gdn_norm8(*(const LAS u32x4*)(OSo + r * 136 + ch * 8), OSS + r * 8, nw8);
            }
        }

        const float gl = GCS[NV - 1];
        bf16x8 Sb[4];
#pragma unroll
        for (int s = 0; s < 4; ++s) Sb[s] = pack_frag(S[2 * s], S[2 * s + 1]);
        f32x4 R[MT], P[MT];
#pragma unroll
        for (int mt = 0; mt < MT; ++mt) {
            bf16x8 fk[4];
#pragma unroll
            for (int s = 0; s < 4; ++s) fk[s] = lda_perm(KS + (16 * mt + fr) * 136, s, fq, true);
            SB_;
            R[mt] = (f32x4){0.f, 0.f, 0.f, 0.f}; P[mt] = (f32x4){0.f, 0.f, 0.f, 0.f};
#pragma unroll
            for (int s = 0; s < 4; ++s) R[mt] = __builtin_amdgcn_mfma_f32_16x16x32_bf16(fk[s], Sb[s], R[mt], 0, 0, 0);
            SB_;
#pragma unroll
            for (int s = 0; s < 4; ++s) fk[s] = lda_perm(QS + (16 * mt + fr) * 136, s, fq, true);
            SB_;
#pragma unroll
            for (int s = 0; s < 4; ++s) P[mt] = __builtin_amdgcn_mfma_f32_16x16x32_bf16(fk[s], Sb[s], P[mt], 0, 0, 0);
            SB_;
        }
        __syncthreads();
        if (c + 1 < nch) write_chunk(Bo);
        SB_;
#pragma unroll
        for (int m0 = 0; m0 < MT; m0 += 2) {
            float gi_[2][4], vi_[2][4], bi_[2][4];
#pragma unroll
            for (int mm = 0; mm < 2; ++mm) if (m0 + mm < MT) {
#pragma unroll
                for (int r = 0; r < 4; ++r) { const int i = 16 * (m0 + mm) + 4 * fq + r; gi_[mm][r] = GCS[i]; bi_[mm][r] = BES[i]; vi_[mm][r] = bf1(VS[i * 136 + dv]); }
            }
            SB_;
#pragma unroll
            for (int mm = 0; mm < 2; ++mm) if (m0 + mm < MT) {
#pragma unroll
                for (int r = 0; r < 4; ++r) {
                    const float e = __expf(gi_[mm][r]);
                    R[m0 + mm][r] = bi_[mm][r] * (vi_[mm][r] - e * R[m0 + mm][r]);
                    P[m0 + mm][r] *= e;
                }
            }
            SB_;
        }
        bf16x8 rb[NS2];
#pragma unroll
        for (int s2 = 0; s2 < NS2; ++s2) rb[s2] = pack_frag(R[2 * s2], (2 * s2 + 1 < MT) ? R[(2 * s2 + 1 < MT) ? 2 * s2 + 1 : 0] : (f32x4){0.f, 0.f, 0.f, 0.f});
        f32x4 Vn[MT];
#pragma unroll
        for (int m0 = 0; m0 < MT; m0 += 2) {
            bf16x8 ft[2][NS2];
#pragma unroll
            for (int mm = 0; mm < 2; ++mm) if (m0 + mm < MT) {
#pragma unroll
                for (int s2 = 0; s2 < NS2; ++s2) ft[mm][s2] = lda_perm(TS + (16 * (m0 + mm) + fr) * 72, s2, fq, 2 * s2 + 1 < MT);
            }
            SB_;
#pragma unroll
            for (int mm = 0; mm < 2; ++mm) if (m0 + mm < MT) {
                Vn[m0 + mm] = (f32x4){0.f, 0.f, 0.f, 0.f};
#pragma unroll
                for (int s2 = 0; s2 < NS2; ++s2) Vn[m0 + mm] = __builtin_amdgcn_mfma_f32_16x16x32_bf16(ft[mm][s2], rb[s2], Vn[m0 + mm], 0, 0, 0);
            }
            SB_;
        }
        const int q4 = fr >> 2, p4 = fr & 3;
        bf16x8 fs[1][2][NS2];
        auto ld_tr = [&](int set, int dt) {
#pragma unroll
            for (int s2 = 0; s2 < NS2; ++s2) {
                const s16x4 lo = lds_tr(KS + (32 * s2 + 4 * fq + q4) * 136 + 32 * (dt >> 1) + 8 * p4 + 4 * (dt & 1));
                s16x4 hi = (s16x4){0, 0, 0, 0};
                if (2 * s2 + 1 < MT) hi = lds_tr(KS + (32 * s2 + 16 + 4 * fq + q4) * 136 + 32 * (dt >> 1) + 8 * p4 + 4 * (dt & 1));
                bf16x8 af; af[0] = lo[0]; af[1] = lo[1]; af[2] = lo[2]; af[3] = lo[3]; af[4] = hi[0]; af[5] = hi[1]; af[6] = hi[2]; af[7] = hi[3];
                fs[set][dt & 1][s2] = af;
            }
        };
        bf16x8 vb[NS2], vdb[NS2];
#pragma unroll
        for (int s2 = 0; s2 < NS2; ++s2) {
            const int m1 = (2 * s2 + 1 < MT) ? 2 * s2 + 1 : 0;
            const f32x4 z = (f32x4){0.f, 0.f, 0.f, 0.f};
            vb[s2] = pack_frag(Vn[2 * s2], (2 * s2 + 1 < MT) ? Vn[m1] : z);
            f32x4 d0, d1;
#pragma unroll
            for (int r = 0; r < 4; ++r) { d0[r] = Vn[2 * s2][r] * __expf(gl - GCS[32 * s2 + 4 * fq + r]); d1[r] = (2 * s2 + 1 < MT) ? Vn[m1][r] * __expf(gl - GCS[32 * s2 + 16 + 4 * fq + r]) : 0.f; }
            vdb[s2] = pack_frag(d0, d1);
        }
#pragma unroll
        for (int m0 = 0; m0 < MT; m0 += 2) {
            bf16x8 fa2[2][NS2];
#pragma unroll
            for (int mm = 0; mm < 2; ++mm) if (m0 + mm < MT) {
#pragma unroll
                for (int s2 = 0; s2 < NS2; ++s2) fa2[mm][s2] = lda_perm(AS + (16 * (m0 + mm) + fr) * 72, s2, fq, 2 * s2 + 1 < MT);
            }
            SB_;
#pragma unroll
            for (int mm = 0; mm < 2; ++mm) if (m0 + mm < MT) {
#pragma unroll
                for (int s2 = 0; s2 < NS2; ++s2) P[m0 + mm] = __builtin_amdgcn_mfma_f32_16x16x32_bf16(fa2[mm][s2], vb[s2], P[m0 + mm], 0, 0, 0);
            }
            SB_;
        }
        {
            const float eg = __expf(gl);
#pragma unroll
            for (int d0 = 0; d0 < 8; d0 += 2) {
                ld_tr(0, d0); ld_tr(0, d0 + 1);
                SB_;
#pragma unroll
                for (int dt = d0; dt < d0 + 2; ++dt) {
                    S[dt] = S[dt] * eg;
#pragma unroll
                    for (int s2 = 0; s2 < NS2; ++s2) S[dt] = __builtin_amdgcn_mfma_f32_16x16x32_bf16(fs[0][dt & 1][s2], vdb[s2], S[dt], 0, 0, 0);
                }
                SB_;
            }
        }
#pragma unroll
        for (int mt = 0; mt < MT; ++mt) {
            f32x4 qv;
#pragma unroll
            for (int r = 0; r < 4; ++r) { qv[r] = row16_sum(P[mt][r] * P[mt][r]); QS[(16 * mt + 4 * fq + r) * 136 + dv] = f2bf(P[mt][r]); }
            if (fr < 4) OSS[(16 * mt + 4 * fq + fr) * 8 + wave] = (fr == 0) ? qv[0] : (fr == 1) ? qv[1] : (fr == 2) ? qv[2] : qv[3];
        }
        if (c + 2 < nch) load_chunk(c + 2);
    }
#undef SB_
    __syncthreads();
    {
        const int rowl = SMP ? NPROMPT + sq * 8 : sq * SEQ + 64 * (nch - 1);
        const LAS bf16_t* OSl = (const LAS bf16_t*)(L + ((nch - 1) & 1) * BUFB + 17408);
#pragma unroll
        for (int q = 0; q < 2; ++q) {
            const int idx = tid + 512 * q, r = idx >> 4, ch = idx & 15;
            if (idx < NR * 16 && r < NV && !dry) *(u32x4*)(Z1 + (size_t)(rowl + r) * ZW + 1024 + h * 128 + ch * 8) = gdn_norm8(*(const LAS u32x4*)(OSl + r * 136 + ch * 8), OSS + r * 8, nw8);
        }
    }
    float* So = a.out + (SMP ? O_SGS : O_PGS) + (size_t)(sq * 8 + h) * 16384;
#pragma unroll
    for (int dt = 0; dt < 8; ++dt)
#pragma unroll
        for (int r = 0; r < 4; ++r) So[(size_t)(16 * dt + 4 * fq + r) * 128 + dv] = S[dt][r];
    __syncthreads();
}

__device__ __forceinline__ void lru_unit(const Args& a, LAS unsigned char* L, bool smp, int bidx, int g, const bool dry) {
    const int tid = threadIdx.x, lane = tid & 63, wave = __builtin_amdgcn_readfirstlane(tid >> 6), fr = lane & 15, fq = lane >> 4;
    LAS float* XC = (LAS float*)(L);
    LAS bf16_t* XB = (LAS bf16_t*)(L + 33792);
    LAS bf16_t* HS = (LAS bf16_t*)(L + 51200);
    LAS bf16_t* RW = (LAS bf16_t*)(L + 68608);
    LAS bf16_t* SH = (LAS bf16_t*)(L + 86832);
    LAS float* CWL = (LAS float*)(L + 93360);
    bf16_t* Z1 = (bf16_t*)(a.ws + WS_Z1);
    const bf16_t* WAT = (const bf16_t*)(a.ws + WS_WA) + (size_t)g * 16384;
    const bf16_t* WXT = (const bf16_t*)(a.ws + WS_WX) + (size_t)g * 16384;
    const float* cw = a.in[9]; const float* cb = a.in[10];
    const int c = 16 * wave + fr, col = g * 128 + c;
    const float ba = a.in[12][col], bx = a.in[14][col];
    const float al = a.in[15][col];
    const float ls = -(al > 0.f ? log1pf(expf(-al)) : (log1pf(expf(al)) - al));
    bf16x8 Bwa[4], Bwx[4];
#pragma unroll
    for (int ks = 0; ks < 4; ++ks) { Bwa[ks] = *(const bf16x8*)(WAT + (size_t)c * 128 + 32 * ks + 8 * fq); Bwx[ks] = *(const bf16x8*)(WXT + (size_t)c * 128 + 32 * ks + 8 * fq); }
    const int ntile = smp ? 1 : 32;
    float carry = 0.f;
    const int t = tid >> 3, p = tid & 7, cc0 = 16 * p, gc0 = g * 128 + cc0;
    for (int idx = tid; idx < 640; idx += 512) { const int i = idx >> 7, cc = idx & 127; CWL[idx] = (i < 4) ? cw[(size_t)i * 1024 + g * 128 + cc] : cb[g * 128 + cc]; }
    if (smp) { for (int idx = tid; idx < 3072; idx += 512) { const int sr = idx >> 7, cc = idx & 127; SH[sr * 136 + cc] = f2bf(a.in[2][(size_t)(bidx * 24 + sr) * 1024 + g * 128 + cc]); } }
    const int row00 = smp ? NPROMPT + bidx * 64 : bidx * SEQ;
    LAS bf16_t* RW2 = (LAS bf16_t*)(L + 95920);
    u32x4 nx0 = *(const u32x4*)(Z1 + (size_t)(row00 + t) * ZW + gc0), nx1 = *(const u32x4*)(Z1 + (size_t)(row00 + t) * ZW + gc0 + 8);
    u32x4 pv0 = (u32x4){0u, 0u, 0u, 0u}, pv1 = pv0;
    *(LAS u32x4*)(RW + (3 + t) * 136 + cc0) = nx0; *(LAS u32x4*)(RW + (3 + t) * 136 + cc0 + 8) = nx1;
    if (t >= 61) { *(LAS u32x4*)(RW + (t - 61) * 136 + cc0) = pv0; *(LAS u32x4*)(RW + (t - 61) * 136 + cc0 + 8) = pv1; }
    pv0 = nx0; pv1 = nx1;
    if (ntile > 1) { nx0 = *(const u32x4*)(Z1 + (size_t)(row00 + 64 + t) * ZW + gc0); nx1 = *(const u32x4*)(Z1 + (size_t)(row00 + 64 + t) * ZW + gc0 + 8); }
    for (int j = 0; j < ntile; ++j) {
        const int rowt = row00 + 64 * j;
        const LAS bf16_t* RWc = (j & 1) ? RW2 : RW;
        __syncthreads();
        {
            float y[16];
#pragma unroll
            for (int q = 0; q < 4; ++q) { const f32x4 f = *(const LAS f32x4*)(CWL + 512 + cc0 + 4 * q); y[4 * q] = f.x; y[4 * q + 1] = f.y; y[4 * q + 2] = f.z; y[4 * q + 3] = f.w; }
#pragma unroll
            for (int i = 0; i < 4; ++i) {
                const int ts8 = (t & 7) - 3 + i;
                const LAS bf16_t* rp = ((smp && ts8 < 0) ? SH + ((t >> 3) * 3 + ts8 + 3) * 136 : RWc + (t + i) * 136) + cc0;
                float xv[16];
                const u32x4 w0 = *(const LAS u32x4*)rp, w1 = *(const LAS u32x4*)(rp + 8); unpack8(w0, xv); unpack8(w1, xv + 8);
#pragma unroll
                for (int q = 0; q < 4; ++q) { const f32x4 f = *(const LAS f32x4*)(CWL + i * 128 + cc0 + 4 * q); y[4 * q] += f.x * xv[4 * q]; y[4 * q + 1] += f.y * xv[4 * q + 1]; y[4 * q + 2] += f.z * xv[4 * q + 2]; y[4 * q + 3] += f.w * xv[4 * q + 3]; }
            }
#pragma unroll
            for (int q = 0; q < 4; ++q) *(LAS f32x4*)(XC + t * 132 + cc0 + 4 * q) = (f32x4){y[4 * q], y[4 * q + 1], y[4 * q + 2], y[4 * q + 3]};
            *(LAS u32x4*)(XB + t * 136 + cc0) = pack8(y); *(LAS u32x4*)(XB + t * 136 + cc0 + 8) = pack8(y + 8);
        }
        if (j > 0 && !dry) {
#pragma unroll
            for (int q = 0; q < 2; ++q) {
                const int idx = tid + 512 * q, r = idx >> 4, ch = idx & 15;
                *(u32x4*)(Z1 + (size_t)(rowt - 64 + r) * ZW + g * 128 + ch * 8) = *(const LAS u32x4*)(HS + r * 136 + ch * 8);
            }
        }
        __syncthreads();
        f32x4 R[4], I[4];
#pragma unroll
        for (int mt = 0; mt < 4; ++mt) {
            bf16x8 fx[4];
#pragma unroll
            for (int ks = 0; ks < 4; ++ks) fx[ks] = *(const LAS bf16x8*)(XB + (16 * mt + fr) * 136 + 32 * ks + 8 * fq);
            __builtin_amdgcn_sched_barrier(0);
            R[mt] = (f32x4){0.f, 0.f, 0.f, 0.f}; I[mt] = (f32x4){0.f, 0.f, 0.f, 0.f};
#pragma unroll
            for (int ks = 0; ks < 4; ++ks) {
                R[mt] = __builtin_amdgcn_mfma_f32_16x16x32_bf16(fx[ks], Bwa[ks], R[mt], 0, 0, 0);
                I[mt] = __builtin_amdgcn_mfma_f32_16x16x32_bf16(fx[ks], Bwx[ks], I[mt], 0, 0, 0);
            }
            __builtin_amdgcn_sched_barrier(0);
        }
        float xc_[4][4];
#pragma unroll
        for (int mt = 0; mt < 4; ++mt)
#pragma unroll
            for (int r = 0; r < 4; ++r) xc_[mt][r] = XC[(16 * mt + 4 * fq + r) * 132 + c];
        __builtin_amdgcn_sched_barrier(0);
        float av[4][4], bv[4][4], Al[4], Bl[4];
#pragma unroll
        for (int mt = 0; mt < 4; ++mt) {
            Al[mt] = 1.f; Bl[mt] = 0.f;
#pragma unroll
            for (int r = 0; r < 4; ++r) {
                const int i = 16 * mt + 4 * fq + r;
                const float rr = sigmoidf_(R[mt][r] + ba);
                const float ig = sigmoidf_(I[mt][r] + bx);
                const float la = 8.f * rr * ls;
                float aa = __expf(la), mult = __builtin_amdgcn_sqrtf(fmaxf(fmaf(-aa, aa, 1.f), 0.f));
                if (!smp && j == 0 && i == 0) { aa = 0.f; mult = 1.f; }
                av[mt][r] = aa; bv[mt][r] = mult * ig * xc_[mt][r];
                Bl[mt] = aa * Bl[mt] + bv[mt][r]; Al[mt] *= aa;
            }
        }
        float Ag[4][4], Bg[4][4];
#pragma unroll
        for (int mt = 0; mt < 4; ++mt)
#pragma unroll
            for (int q = 0; q < 4; ++q) { Ag[mt][q] = __shfl(Al[mt], fr + 16 * q); Bg[mt][q] = __shfl(Bl[mt], fr + 16 * q); }
        float h0v[4] = {0.f, 0.f, 0.f, 0.f};
        if (smp) {
#pragma unroll
            for (int mt = 0; mt < 4; ++mt) h0v[mt] = a.in[3][(size_t)(bidx * 8 + 2 * mt + (fq >> 1)) * 1024 + col];
        }
#pragma unroll
        for (int mt = 0; mt < 4; ++mt) {
            float hin;
            if (smp) {
                hin = h0v[mt];
                const float A_ = (fq == 1) ? Ag[mt][0] : Ag[mt][2], B_ = (fq == 1) ? Bg[mt][0] : Bg[mt][2];
                hin = (fq & 1) ? A_ * hin + B_ : hin;
            } else {
                hin = carry;
#pragma unroll
                for (int q = 0; q < 3; ++q) hin = (q < fq) ? Ag[mt][q] * hin + Bg[mt][q] : hin;
#pragma unroll
                for (int q = 0; q < 4; ++q) carry = Ag[mt][q] * carry + Bg[mt][q];
            }
#pragma unroll
            for (int r = 0; r < 4; ++r) { hin = av[mt][r] * hin + bv[mt][r]; HS[(16 * mt + 4 * fq + r) * 136 + c] = f2bf(hin); }
            if (smp) { if (fq & 1) a.out[O_SLH + (size_t)(bidx * 8 + 2 * mt + (fq >> 1)) * 1024 + col] = hin; }
            else if (j == ntile - 1 && mt == 3 && fq == 3) a.out[O_PLH + (size_t)bidx * 1024 + col] = hin;
        }
        if (j + 1 < ntile) {
            LAS bf16_t* RWn = (j & 1) ? RW : RW2;
            *(LAS u32x4*)(RWn + (3 + t) * 136 + cc0) = nx0; *(LAS u32x4*)(RWn + (3 + t) * 136 + cc0 + 8) = nx1;
            if (t >= 61) { *(LAS u32x4*)(RWn + (t - 61) * 136 + cc0) = pv0; *(LAS u32x4*)(RWn + (t - 61) * 136 + cc0 + 8) = pv1; }
            pv0 = nx0; pv1 = nx1;
            if (j + 2 < ntile) { nx0 = *(const u32x4*)(Z1 + (size_t)(rowt + 128 + t) * ZW + gc0); nx1 = *(const u32x4*)(Z1 + (size_t)(rowt + 128 + t) * ZW + gc0 + 8); }
        }
    }
    __syncthreads();
    {
        const int rowl = row00 + 64 * (ntile - 1);
#pragma unroll
        for (int q = 0; q < 2; ++q) {
            const int idx = tid + 512 * q, r = idx >> 4, ch = idx & 15;
            if (!dry) *(u32x4*)(Z1 + (size_t)(rowl + r) * ZW + g * 128 + ch * 8) = *(const LAS u32x4*)(HS + r * 136 + ch * 8);
        }
    }
    __syncthreads();
}

#define XB_TMO      128
#define XB_XCNT(j)  (256  + 64 * (j))
#define XB_XSUB(j)  (1280 + 64 * (j))
#define XB_XGEN(j)  (2304 + 64 * (j))
#define XB_TOP      3328
#define XB_TOPGEN   3392
#define XCD_BAR_WORDS 3456
#define XB_SPIN_CAP (1u << 22)
__device__ __forceinline__ unsigned xb_ld(unsigned* p)              { return __hip_atomic_load(p, __ATOMIC_RELAXED, __HIP_MEMORY_SCOPE_AGENT); }
__device__ __forceinline__ unsigned xb_add(unsigned* p, unsigned v) { return __hip_atomic_fetch_add(p, v, __ATOMIC_RELAXED, __HIP_MEMORY_SCOPE_AGENT); }
__device__ __forceinline__ unsigned xb_xcc_id() { return (unsigned)__builtin_amdgcn_s_getreg((3 << 11) | 20) & 0xFu; }
#define XB_SPIN(cond, bar) do { unsigned _sp = 0; while (cond) { __builtin_amdgcn_s_sleep(1); \
    if ((++_sp & 255u) == 0u) { if (xb_ld(&(bar)[XB_TMO])) break; if (_sp > XB_SPIN_CAP) { atomicAdd(&(bar)[XB_TMO], 1u); break; } } } } while (0)
struct XcdBarrier { unsigned* bar; unsigned x; volatile LAS unsigned* st; unsigned G; };
__device__ __forceinline__ XcdBarrier xcd_barrier_post(unsigned* bar, volatile LAS unsigned* st) {
    XcdBarrier b; b.bar = bar; b.x = xb_xcc_id(); b.st = st; b.G = 0u;
    if (threadIdx.x == 0) (void)xb_add(&bar[XB_XCNT(b.x)], 1u);
    return b;
}
__device__ __forceinline__ void xcd_barrier_complete(unsigned* bar, unsigned x, unsigned& nloc, unsigned& nx, const unsigned G) {
    unsigned sum, cnt, mine, sp = 0u;
    for (;;) {
        sum = 0u; cnt = 0u; mine = 0u;
#pragma unroll
        for (unsigned j = 0; j < 16; ++j) { const unsigned c = xb_ld(&bar[XB_XCNT(j)]); sum += c; cnt += (c > 0u) ? 1u : 0u; mine = (j == x) ? c : mine; }
        if (sum == G) break;
        __builtin_amdgcn_s_sleep(1);
        if ((++sp & 255u) == 0u) { if (xb_ld(&bar[XB_TMO])) break; if (sp > XB_SPIN_CAP) { atomicAdd(&bar[XB_TMO], 1u); break; } }
    }
    nloc = mine > 0u ? mine : 1u; nx = cnt > 0u ? cnt : 1u;
}
__device__ __forceinline__ void xcd_barrier(const XcdBarrier& b) {
    asm volatile("s_waitcnt vmcnt(0)" ::: "memory");
    __syncthreads();
    if (threadIdx.x == 0) {
        unsigned* bar = b.bar;
        __builtin_amdgcn_s_waitcnt(0);
        unsigned nloc = b.st[0], nx = b.st[1];
        if (nloc == 0u) { xcd_barrier_complete(bar, b.x, nloc, nx, b.G); b.st[0] = nloc; b.st[1] = nx; }
        const unsigned old = xb_add(&bar[XB_XSUB(b.x)], 1u);
        const unsigned gen = old / nloc;
        if (old + 1u == (gen + 1u) * nloc) {
            __builtin_amdgcn_fence(__ATOMIC_RELEASE, "agent");
            asm volatile("s_waitcnt vmcnt(0)" ::: "memory");
            const unsigned og = xb_add(&bar[XB_TOP], 1u);
            const unsigned tg = og / nx;
            if (og + 1u == (tg + 1u) * nx) xb_add(&bar[XB_TOPGEN], 1u);
            else XB_SPIN(xb_ld(&bar[XB_TOPGEN]) == tg, bar);
            __builtin_amdgcn_fence(__ATOMIC_ACQUIRE, "agent");
            xb_add(&bar[XB_XGEN(b.x)], 1u);
            asm volatile("s_waitcnt vmcnt(0)" ::: "memory");
        } else {
            XB_SPIN(xb_ld(&bar[XB_XGEN(b.x)]) == gen, bar);
            __builtin_amdgcn_fence(__ATOMIC_ACQUIRE, "agent");
            asm volatile("s_waitcnt vmcnt(0)" ::: "memory");
        }
    }
    __syncthreads();
}

#ifndef DRY3_SKIP
#define DRY3_SKIP 0
#endif
__device__ __forceinline__ void p3_scans(const Args& a, LAS unsigned char* L, const bool dry) {
    if (!(dry && (DRY3_SKIP & 1))) for (int u = blockIdx.x; u < 64; u += gridDim.x) gdn_scan_unit<4>(a, L, u >> 3, u & 7, dry);
    if (!(dry && (DRY3_SKIP & 2))) for (int u = blockIdx.x; u < 128; u += gridDim.x) if (u >= 64) lru_unit(a, L, false, (u - 64) >> 3, (u - 64) & 7, dry);
    if (gridDim.x >= 256) {
        const int nb = gridDim.x - 128, b = blockIdx.x - 128;
        if (b >= 0) {
#define SUBBAR() do { XcdBarrier xb_; xb_.bar = (unsigned*)(a.ws + WS_BAR) + 4096; xb_.x = xb_xcc_id(); xb_.st = (volatile LAS unsigned*)(L + LDS_BYTES - 56); xb_.G = 128u; xcd_barrier(xb_); } while (0)
            if (b < 64) {
                const pg8::Gemm g1{(const bf16_t*)(a.ws + WS_U), (const bf16_t*)(a.ws + WS_W1T), NROWS, 4096, 1024, 1024};
                const pg8::Epi<0> E1{(bf16_t*)(a.ws + WS_Z1), (bf16_t*)(a.ws + WS_HALO), a.out};
                const pg8::SeqOrder S1{b, 0, 1, 2};
                pg8::gemm_phase(L, g1, S1, E1);
            } else {
                pg8::Gemm gm0{(const bf16_t*)(a.ws + WS_U), (const bf16_t*)(a.ws + WS_W2T) + (size_t)2048 * 1024, NROWS, 1280, 1024, 1024};
                pg8::StaticOrder Sm0; Sm0.init(NROWS, 1280, 128, b - 64); Sm0.lim = 1;
                pg8::Epi<5> Em0{nullptr, nullptr, a.out};
                pg8::gemm_phase(L, gm0, Sm0, Em0);
            }
            SUBBAR();
            p2_gdn_local(a, L, false, 2048 + b, 128, 1);
            SUBBAR();
#undef SUBBAR
            if (!(dry && (DRY3_SKIP & 8))) for (int u = b; u < 128; u += nb) lru_unit(a, L, true, u >> 3, u & 7, dry);
            if (!(dry && (DRY3_SKIP & 4))) for (int u = b; u < 1024; u += nb) gdn_scan_unit<1>(a, L, u >> 3, u & 7, dry);
            pg8::Gemm gm{(const bf16_t*)(a.ws + WS_U), (const bf16_t*)(a.ws + WS_W2T) + (size_t)2048 * 1024, NROWS, 1280, 1024, 1024};
            pg8::StaticOrder Sm; Sm.init(NROWS, 1280, nb, b); Sm.off = 64; Sm.lim = 2;
            pg8::Epi<5> Em{nullptr, nullptr, a.out};
            pg8::gemm_phase(L, gm, Sm, Em);
        }
    } else {
        {
            pg8::Gemm gm{(const bf16_t*)(a.ws + WS_U), (const bf16_t*)(a.ws + WS_W2T) + (size_t)2048 * 1024, NROWS, 1280, 1024, 1024};
            pg8::StaticOrder Sm; Sm.init(NROWS, 1280, gridDim.x, blockIdx.x);
            pg8::Epi<5> Em{nullptr, nullptr, a.out};
            pg8::gemm_phase(L, gm, Sm, Em);
        }
        for (int u = blockIdx.x; u < 1152; u += gridDim.x) if (u >= 128) gdn_scan_unit<1>(a, L, (u - 128) >> 3, (u - 128) & 7, dry);
        for (int u = blockIdx.x; u < 1280; u += gridDim.x) if (u >= 1152) lru_unit(a, L, true, (u - 1152) >> 3, (u - 1152) & 7, dry);
    }
}

__device__ __forceinline__ void p7_final(const Args& a, const int row_lo, const int row_hi, const int wblk, const int nblk) {
    const int tid = threadIdx.x, lane = tid & 63, wave = tid >> 6;
    const int gw = row_lo + wblk * 8 + wave, NGW = nblk * 8;
    const float* gain = a.in[7];
    f32x4 gn[2][2];
#pragma unroll
    for (int jj = 0; jj < 2; ++jj) { gn[jj][0] = *(const f32x4*)(gain + 8 * (lane + 64 * jj)); gn[jj][1] = *(const f32x4*)(gain + 8 * (lane + 64 * jj) + 4); }
    for (int m = gw; m < row_hi; m += NGW) {
        const float* xr = (m < NPROMPT) ? a.in[0] + (size_t)m * DM : a.in[1] + (size_t)(m - NPROMPT) * DM;
        float* yr = a.out + (size_t)m * DM;
        const bf16_t* yb = (const bf16_t*)a.out + (size_t)m * 2048;
        float v[16]; f32x4 x[2][2]; float s = 0.f;
#pragma unroll
        for (int jj = 0; jj < 2; ++jj) {
            const u32x4 w = *(const u32x4*)(yb + 8 * (lane + 64 * jj)); unpack8(w, v + 8 * jj);
            x[jj][0] = *(const f32x4*)(xr + 8 * (lane + 64 * jj)); x[jj][1] = *(const f32x4*)(xr + 8 * (lane + 64 * jj) + 4);
        }
#pragma unroll
        for (int e = 0; e < 16; ++e) s += v[e] * v[e];
        const float rs = rsqrtf(wave_sum(s) * (1.f / DM) + EPS);
#pragma unroll
        for (int jj = 0; jj < 2; ++jj)
#pragma unroll
            for (int hh = 0; hh < 2; ++hh) {
                f32x4 o;
#pragma unroll
                for (int e = 0; e < 4; ++e) o[e] = x[jj][hh][e] + v[8 * jj + 4 * hh + e] * rs * gn[jj][hh][e];
                *(f32x4*)(yr + 8 * (lane + 64 * jj) + 4 * hh) = o;
            }
    }
}


__global__ void __launch_bounds__(512, 2) hawk_gdn_fwd(Args a) {
    extern __shared__ __attribute__((aligned(16))) unsigned char lds_raw[];
    LAS unsigned char* L = (LAS unsigned char*)lds_raw;
    cg::grid_group grid = cg::this_grid();
    volatile LAS unsigned* xst = (volatile LAS unsigned*)(L + LDS_BYTES - 64);
    if (threadIdx.x < 4) xst[threadIdx.x] = 0u;
    __syncthreads();
    (void)xcd_barrier_post((unsigned*)(a.ws + WS_BAR), xst);
    if (blockIdx.x >= 128) (void)xcd_barrier_post((unsigned*)(a.ws + WS_BAR) + 4096, xst + 2);
    if (a.flags == 0x7fffffff) grid.sync();
    unsigned char* ws = a.ws;
    bf16_t* Z1 = (bf16_t*)(ws + WS_Z1); bf16_t* U = (bf16_t*)(ws + WS_U);
    const int lo = a.ph_lo, hi = a.ph_hi;
#ifndef PH_MASK
#define PH_MASK 0xff
#endif
#define IN(k) (((PH_MASK >> (k)) & 1) && lo <= (k) && (k) < hi)
#define SEAM(k) do { if (IN(k) && IN((k) + 1)) { XcdBarrier xb_; xb_.bar = (unsigned*)(a.ws + WS_BAR); xb_.x = xb_xcc_id(); xb_.st = (volatile LAS unsigned*)(L + LDS_BYTES - 64); xb_.G = gridDim.x; xcd_barrier(xb_); } } while (0)
#ifndef REP0
#define REP0 1
#endif
#ifndef REP1
#define REP1 1
#endif
#ifndef REP6
#define REP6 1
#endif
    if (IN(0)) p0_prologue(a, L);
    SEAM(0);
    if (IN(1)) {
        pg8::Gemm g{U, (const bf16_t*)(ws + WS_W1T), NROWS, 4096, 1024, 1024}; pg8::StaticOrder S; S.init(NPROMPT, 4096, gridDim.x, blockIdx.x);
        pg8::Epi<0> E{Z1, (bf16_t*)(ws + WS_HALO), a.out};
        pg8::gemm_phase(L, g, S, E);
    }
    SEAM(1);
    if (IN(2)) p2_gdn_local(a, L, false, blockIdx.x, 256, 8);
    SEAM(2);
    if (IN(3)) p3_scans(a, L, false);
    SEAM(3);
    if (IN(4)) {
        pg8::Gemm g{U, (const bf16_t*)(ws + WS_W2T), NROWS, 2048, 1024, 1024}; pg8::StaticOrder S; S.init(NROWS, 2048, gridDim.x, blockIdx.x);
        pg8::Epi<1> E{Z1, nullptr, a.out};
        pg8::gemm_phase(L, g, S, E);
        if (blockIdx.x >= 32) {
            pg8::Gemm gm{U, (const bf16_t*)(ws + WS_W2T) + (size_t)(2048 + 1280) * 1024, NROWS, 768, 1024, 1024};
            pg8::StaticOrder Sm; Sm.init(NROWS, 768, gridDim.x - 32, blockIdx.x - 32);
            pg8::Epi<5> Em{nullptr, nullptr, (float*)((bf16_t*)a.out + 1280)};
            pg8::gemm_phase(L, gm, Sm, Em);
            if (blockIdx.x >= 236) {
                pg8::Gemm gm2{U, (const bf16_t*)(ws + WS_W2T) + (size_t)2048 * 1024, NROWS, 1280, 1024, 1024};
                pg8::StaticOrder Sm2; Sm2.init(NROWS, 1280, 1, blockIdx.x - 236); Sm2.off = 320; Sm2.lim = 1;
                pg8::Epi<5> Em2{nullptr, nullptr, a.out};
                pg8::gemm_phase(L, gm2, Sm2, Em2);
            }
        }
    }
    SEAM(4);
    const int bid = blockIdx.x;
    const pg8::Gemm gA{Z1, (const bf16_t*)(ws + WS_WBL), NROWS, 1024, 1024, ZW};
    const pg8::Gemm gB{Z1 + 1024, (const bf16_t*)(ws + WS_WBG), NROWS, 1024, 1024, ZW};
    const pg8::Gemm gY{Z1 + 2048, (const bf16_t*)(ws + WS_WO), NROWS, 1024, 1024, ZW};
    const pg8::Epi<2> E2{Z1, nullptr, a.out}; const pg8::Epi<3> E3{Z1, nullptr, a.out}; const pg8::Epi<4> E4{Z1, nullptr, a.out};
    if (IN(5)) {
        const pg8::SeqOrder S{bid, 0, 1, 0};
        pg8::gemm_phase(L, gA, S, E2);
        pg8::gemm_phase(L, gB, S, E3);
    }
    SEAM(5);
    if (IN(6)) {
        if (bid < 16) { const pg8::SeqOrder S{bid, 0, 1, 1}; pg8::gemm_phase(L, gA, S, E2); pg8::gemm_phase(L, gB, S, E3); }
        else { const int d = bid - 16; const pg8::SeqOrder S{d, 240, (d < 16) ? 2 : 1, 0}; pg8::gemm_phase(L, gY, S, E4); }
    }
    SEAM(6);
    if (IN(7)) {
        if (bid < 16) { const pg8::SeqOrder S{bid, 0, 1, 1}; pg8::gemm_phase(L, gY, S, E4); }
        else p7_final(a, 0, NPROMPT, bid - 16, 240);
        { XcdBarrier xb_; xb_.bar = (unsigned*)(a.ws + WS_BAR); xb_.x = xb_xcc_id(); xb_.st = (volatile LAS unsigned*)(L + LDS_BYTES - 64); xb_.G = gridDim.x; xcd_barrier(xb_); }
        p7_final(a, NPROMPT, NROWS, bid, 256);
    }
#undef IN
#undef SEAM
}

#ifndef N_LAUNCHES
#define N_LAUNCHES 1
#endif

extern "C" void kernel_launch(void* const* d_in, const int* in_sizes, int n_in, void* d_out, int out_size, void* d_ws, size_t ws_size, hipStream_t stream) {
    static int grid = 0;
    if (grid == 0) {
        if (n_in != 23 || ws_size < WS_END) { fprintf(stderr, "kernel_launch: unexpected inputs (n_in %d, ws %zu)\n", n_in, ws_size); grid = -1; return; }
        int dev = 0, cus = 0, per_cu = 0;
        hipGetDevice(&dev);
        hipDeviceGetAttribute(&cus, hipDeviceAttributeMultiprocessorCount, dev);
        if (hipFuncSetAttribute((const void*)hawk_gdn_fwd, hipFuncAttributeMaxDynamicSharedMemorySize, LDS_BYTES) != hipSuccess) { fprintf(stderr, "kernel_launch: hipFuncSetAttribute failed\n"); }
        if (hipOccupancyMaxActiveBlocksPerMultiprocessor(&per_cu, (const void*)hawk_gdn_fwd, 512, LDS_BYTES) != hipSuccess || per_cu < 1) { fprintf(stderr, "kernel_launch: occupancy query says %d\n", per_cu); per_cu = 1; }
        (void)hipGetLastError();
        grid = 256;
        if (grid <= 0) grid = 256;
    }
    if (grid < 0) return;
    if (hipMemsetAsync((char*)d_ws + WS_BAR, 0, 32768, stream) != hipSuccess) { fprintf(stderr, "kernel_launch: memset of barrier words failed\n"); return; }
    Args a{};
    for (int i = 0; i < 23; ++i) a.in[i] = (const float*)d_in[i];
    a.out = (float*)d_out; a.ws = (unsigned char*)d_ws;
#ifndef PLAN
#define PLAN {0, 8, 0}
#endif
    const int plan[] = PLAN;
    const int nl = (int)(sizeof(plan) / sizeof(int)) / 3;
    for (int li = 0; li < nl; ++li) {
        a.ph_lo = plan[3 * li]; a.ph_hi = plan[3 * li + 1]; a.flags = plan[3 * li + 2];
        void* args[] = {&a};
        hipError_t e = hipLaunchCooperativeKernel((const void*)hawk_gdn_fwd, dim3(grid), dim3(512), args, LDS_BYTES, stream);
        if (e != hipSuccess) { fprintf(stderr, "kernel_launch: cooperative launch failed: %s (grid %d)\n", hipGetErrorString(e), grid); break; }
    }
}
```
